# Optimizing an MI355X kernel written in HIP

```python
import math
import jax, jax.numpy as jnp
from jax import lax
import numpy as np


D_MODEL = 1024
BATCH = 16
SEQ = 2048
DEPTH = 2

N_Q_HEADS = 8
N_KV_HEADS = 2
Q_PER_KV = N_Q_HEADS // N_KV_HEADS
HEAD_DIM = D_MODEL // 16
WINDOW = 128
BLOCK = 128
BRANCH_WIDTH = D_MODEL // 2
KV_WIDTH = N_KV_HEADS * HEAD_DIM
LRU_BLOCKS = 8
LRU_BLOCK_DIM = BRANCH_WIDTH // LRU_BLOCKS
CONV_WIDTH = 4
CONV_PAD = (2, 1)
LRU_C = 8.0
SSM_GROUP = 16
SSM_GROUPS = BRANCH_WIDTH // SSM_GROUP
SSM_STATE = 64
N_BRANCH = 3
IN_COLS = BRANCH_WIDTH + 2 * KV_WIDTH + 3 * BRANCH_WIDTH + N_BRANCH * D_MODEL
N_GROUPS = 4
EXPERTS_PER_GROUP = 4
TOP_K = 2
D_EXPERT = D_MODEL // 4
NORM_EPS = 1e-6
MASK_VALUE = -1e30

kernel_name = 'hybrid_gated_swa_rglru_s5_hmoe'


def rms_norm(x, g):
    xf = x.astype(jnp.float32)
    y = xf * lax.rsqrt(jnp.mean(xf * xf, axis=-1, keepdims=True) + NORM_EPS)
    return (y * g.astype(jnp.float32)).astype(x.dtype)


def _linear_combine(e1, e2):
    a1, b1 = e1
    a2, b2 = e2
    return a1 * a2, a2 * b1 + b2


def _complex_combine(e1, e2):
    ar1, ai1, br1, bi1 = e1
    ar2, ai2, br2, bi2 = e2
    return (ar1 * ar2 - ai1 * ai2,
            ar1 * ai2 + ai1 * ar2,
            ar2 * br1 - ai2 * bi1 + br2,
            ar2 * bi1 + ai2 * br1 + bi2)


def alibi_slopes():
    return jnp.asarray(2.0 ** (-8.0 * (np.arange(N_Q_HEADS) + 1) / N_Q_HEADS), dtype=jnp.float32)


def window_attention(q, k, v, sink):
    b, l = q.shape[0], q.shape[1]
    nb = l // BLOCK
    qb = q.reshape(b, nb, BLOCK, N_KV_HEADS, Q_PER_KV, HEAD_DIM)

    def band(t):
        tp = jnp.pad(t, ((0, 0), (BLOCK, BLOCK), (0, 0), (0, 0)))
        tp = tp.reshape(b, nb + 2, BLOCK, N_KV_HEADS, HEAD_DIM)
        return jnp.concatenate([tp[:, :-2], tp[:, 1:-1], tp[:, 2:]], axis=2)

    kb, vb = band(k), band(v)
    s = jnp.einsum('bnqhgd,bnshd->bnhgqs', qb, kb,
                   preferred_element_type=jnp.float32) * (HEAD_DIM ** -0.5)
    qi = jnp.arange(BLOCK)
    kj = jnp.arange(3 * BLOCK)
    rel = qi[:, None] - kj[None, :] + BLOCK
    key_pos = jnp.arange(nb)[:, None] * BLOCK - BLOCK + kj[None, :]
    valid = (jnp.abs(rel) <= WINDOW)[None] & ((key_pos >= 0) & (key_pos < l))[:, None, :]
    dist = jnp.abs(rel).astype(jnp.float32)
    bias = (-alibi_slopes()[:, None, None] * dist).reshape(N_KV_HEADS, Q_PER_KV, BLOCK, 3 * BLOCK)
    s = jnp.where(valid[None, :, None, None], s + bias, MASK_VALUE)
    sk = sink.astype(jnp.float32).reshape(N_KV_HEADS, Q_PER_KV)[:, :, None, None]
    m = jnp.maximum(jnp.max(s, axis=-1, keepdims=True), sk)
    p = jnp.exp(s - m)
    probs = p / (jnp.sum(p, axis=-1, keepdims=True) + jnp.exp(sk - m))
    o = jnp.einsum('bnhgqs,bnshd->bnqhgd', probs, vb.astype(jnp.float32))
    return o.reshape(b, l, N_Q_HEADS * HEAD_DIM).astype(q.dtype)


def centred_dwconv(x, w, bias):
    y = lax.conv_general_dilated(x, w[:, None, :].astype(x.dtype), window_strides=(1,),
                                 padding=[CONV_PAD], dimension_numbers=('NWC', 'WIO', 'NWC'),
                                 feature_group_count=x.shape[-1])
    return y + bias.astype(x.dtype)


def rg_lru_dir(xc, w_r, b_r, w_i, b_i, lam, reverse):
    b, l, _ = xc.shape
    xb = xc.reshape(b, l, LRU_BLOCKS, LRU_BLOCK_DIM)
    r = jax.nn.sigmoid(jnp.einsum('blhi,hij->blhj', xb, w_r.astype(jnp.float32)).reshape(b, l, BRANCH_WIDTH) + b_r)
    i = jax.nn.sigmoid(jnp.einsum('blhi,hij->blhj', xb, w_i.astype(jnp.float32)).reshape(b, l, BRANCH_WIDTH) + b_i)
    log_a = -LRU_C * r * jax.nn.softplus(-lam)
    a = jnp.exp(log_a)
    u = jnp.sqrt(-jnp.expm1(2.0 * log_a)) * (i * xc)
    _, h = lax.associative_scan(_linear_combine, (a, u), axis=1, reverse=reverse)
    return h


def s5_dir(u, a_re, a_im, log_step, b_re, b_im, reverse):
    bsz, l = u.shape[0], u.shape[1]
    step = jnp.exp(log_step)[:, None]
    mag = jnp.exp(a_re * step)
    abar_r = mag * jnp.cos(a_im * step)
    abar_i = mag * jnp.sin(a_im * step)
    den = a_re * a_re + a_im * a_im
    nr = abar_r - 1.0
    sr = (nr * a_re + abar_i * a_im) / den
    si = (abar_i * a_re - nr * a_im) / den
    bbar_r = sr[..., None] * b_re - si[..., None] * b_im
    bbar_i = sr[..., None] * b_im + si[..., None] * b_re
    bu_r = jnp.einsum('blgc,gnc->blgn', u, bbar_r)
    bu_i = jnp.einsum('blgc,gnc->blgn', u, bbar_i)
    ar = jnp.broadcast_to(abar_r[None, None], (bsz, l, SSM_GROUPS, SSM_STATE))
    ai = jnp.broadcast_to(abar_i[None, None], (bsz, l, SSM_GROUPS, SSM_STATE))
    _, _, hr, hi = lax.associative_scan(_complex_combine, (ar, ai, bu_r, bu_i), axis=1, reverse=reverse)
    return hr, hi


def hybrid_mixer(h, w_in, attn_sink, conv_w, conv_b, w_r, b_r, w_i, b_i, lam,
                 a_re, a_im, log_step, b_re, b_im, c_re, c_im, d_skip, w_glu, b_glu,
                 w_branch, w_out):
    b, l, _ = h.shape
    f32 = jnp.float32
    z = h @ w_in
    cuts = [BRANCH_WIDTH, BRANCH_WIDTH + KV_WIDTH, BRANCH_WIDTH + 2 * KV_WIDTH,
            2 * BRANCH_WIDTH + 2 * KV_WIDTH, 3 * BRANCH_WIDTH + 2 * KV_WIDTH,
            4 * BRANCH_WIDTH + 2 * KV_WIDTH]
    q, k, v, xr, gr, u, gates = jnp.split(z, cuts, axis=-1)

    o_attn = window_attention(q.reshape(b, l, N_Q_HEADS, HEAD_DIM),
                              k.reshape(b, l, N_KV_HEADS, HEAD_DIM),
                              v.reshape(b, l, N_KV_HEADS, HEAD_DIM), attn_sink)

    xc = centred_dwconv(xr, conv_w, conv_b).astype(f32)
    h_f = rg_lru_dir(xc, w_r[0], b_r[0].astype(f32), w_i[0], b_i[0].astype(f32), lam[0].astype(f32), False)
    h_b = rg_lru_dir(xc, w_r[1], b_r[1].astype(f32), w_i[1], b_i[1].astype(f32), lam[1].astype(f32), True)
    o_lru = (jax.nn.gelu(gr.astype(f32)) * (h_f + h_b)).astype(h.dtype)

    uf = u.astype(f32).reshape(b, l, SSM_GROUPS, SSM_GROUP)
    hr_f, hi_f = s5_dir(uf, a_re[0].astype(f32), a_im[0].astype(f32), log_step[0].astype(f32),
                        b_re[0].astype(f32), b_im[0].astype(f32), False)
    hr_b, hi_b = s5_dir(uf, a_re[1].astype(f32), a_im[1].astype(f32), log_step[1].astype(f32),
                        b_re[1].astype(f32), b_im[1].astype(f32), True)
    hr = hr_f + hr_b
    hi = hi_f + hi_b
    y = (jnp.einsum('blgn,gcn->blgc', hr, c_re.astype(f32))
         - jnp.einsum('blgn,gcn->blgc', hi, c_im.astype(f32))
         + d_skip.astype(f32).reshape(SSM_GROUPS, SSM_GROUP) * uf)
    y = y.reshape(b, l, BRANCH_WIDTH)
    zg = jax.nn.gelu(y) @ w_glu.astype(f32) + b_glu.astype(f32)
    o_ssm = (zg[..., :BRANCH_WIDTH] * jax.nn.sigmoid(zg[..., BRANCH_WIDTH:])).astype(h.dtype)

    g = jax.nn.sigmoid(gates.reshape(b, l, N_BRANCH, D_MODEL))
    branches = jnp.stack([o_attn, o_lru, o_ssm], axis=2)
    proj = jnp.einsum('blkw,kwd->blkd', branches, w_branch)
    mixed = jnp.sum(proj * g, axis=2)
    return mixed @ w_out


def hier_moe(x, w_group, b_group, w_expert, b_expert, w1, w3, w2):
    b, l, d = x.shape
    t = b * l
    xt = x.reshape(t, d)
    g_logits = (xt @ w_group).astype(jnp.float32) + b_group.astype(jnp.float32)
    g_prob = jax.nn.softmax(g_logits, axis=-1)
    _, g_idx = lax.top_k(g_logits, 1)
    g_w = jnp.take_along_axis(g_prob, g_idx, axis=-1)
    e_logits = ((xt @ w_expert).astype(jnp.float32) + b_expert.astype(jnp.float32)).reshape(t, N_GROUPS, EXPERTS_PER_GROUP)
    g_onehot = jax.nn.one_hot(g_idx[:, 0], N_GROUPS, dtype=jnp.float32)
    e_sel = jnp.sum(e_logits * g_onehot[:, :, None], axis=1)
    top_v, top_i = lax.top_k(e_sel, TOP_K)
    top_w = jax.nn.softmax(top_v, axis=-1) * g_w
    w_e = jnp.sum(jax.nn.one_hot(top_i, EXPERTS_PER_GROUP, dtype=jnp.float32) * top_w[..., None], axis=1)
    combine = w_e[:, None, :] * g_onehot[:, :, None]
    y = jnp.zeros((t, d), jnp.float32)
    for gi in range(N_GROUPS):
        hg = jax.nn.silu(jnp.einsum('td,edf->tef', xt, w1[gi])) * jnp.einsum('td,edf->tef', xt, w3[gi])
        hg = hg.astype(jnp.float32) * combine[:, gi, :, None]
        y = y + jnp.einsum('tef,efd->td', hg, w2[gi].astype(jnp.float32))
    return y.reshape(b, l, d).astype(x.dtype)


def setup_inputs(seed: int = 0) -> dict:
    key = jax.random.key(seed)
    ks = iter(jax.random.split(key, 64))
    f32 = jnp.float32

    def nrm(shape, scale):
        return scale * jax.random.normal(next(ks), shape, f32)

    def unif(shape, lo, hi):
        return jax.random.uniform(next(ks), shape, f32, lo, hi)

    lam_u = unif((DEPTH, 2, BRANCH_WIDTH), 0.9, 0.999) ** (1.0 / LRU_C)
    lru_lambda = jnp.log(lam_u) - jnp.log1p(-lam_u)
    a_im_base = jnp.pi * jnp.arange(SSM_STATE, dtype=f32)
    return {
        'x': nrm((BATCH, SEQ, D_MODEL), 1.0),
        'norm1_g': 1.0 + nrm((DEPTH, D_MODEL), 0.01),
        'w_in': nrm((DEPTH, D_MODEL, IN_COLS), D_MODEL ** -0.5),
        'attn_sink': nrm((DEPTH, N_Q_HEADS), 0.5),
        'lru_conv_w': nrm((DEPTH, CONV_WIDTH, BRANCH_WIDTH), CONV_WIDTH ** -0.5),
        'lru_conv_b': nrm((DEPTH, BRANCH_WIDTH), 0.01),
        'lru_w_r': nrm((DEPTH, 2, LRU_BLOCKS, LRU_BLOCK_DIM, LRU_BLOCK_DIM), LRU_BLOCK_DIM ** -0.5),
        'lru_b_r': nrm((DEPTH, 2, BRANCH_WIDTH), 0.01),
        'lru_w_i': nrm((DEPTH, 2, LRU_BLOCKS, LRU_BLOCK_DIM, LRU_BLOCK_DIM), LRU_BLOCK_DIM ** -0.5),
        'lru_b_i': nrm((DEPTH, 2, BRANCH_WIDTH), 0.01),
        'lru_lambda': lru_lambda,
        'ssm_a_re': -0.5 + nrm((DEPTH, 2, SSM_GROUPS, SSM_STATE), 0.01),
        'ssm_a_im': a_im_base + nrm((DEPTH, 2, SSM_GROUPS, SSM_STATE), 0.01),
        'ssm_log_step': unif((DEPTH, 2, SSM_GROUPS), math.log(1e-3), math.log(1e-1)),
        'ssm_b_re': nrm((DEPTH, 2, SSM_GROUPS, SSM_STATE, SSM_GROUP), (2 * SSM_GROUP) ** -0.5),
        'ssm_b_im': nrm((DEPTH, 2, SSM_GROUPS, SSM_STATE, SSM_GROUP), (2 * SSM_GROUP) ** -0.5),
        'ssm_c_re': nrm((DEPTH, SSM_GROUPS, SSM_GROUP, SSM_STATE), (2 * SSM_STATE) ** -0.5),
        'ssm_c_im': nrm((DEPTH, SSM_GROUPS, SSM_GROUP, SSM_STATE), (2 * SSM_STATE) ** -0.5),
        'ssm_d': nrm((DEPTH, BRANCH_WIDTH), 1.0),
        'ssm_w_glu': nrm((DEPTH, BRANCH_WIDTH, 2 * BRANCH_WIDTH), BRANCH_WIDTH ** -0.5),
        'ssm_b_glu': nrm((DEPTH, 2 * BRANCH_WIDTH), 0.01),
        'w_branch': nrm((DEPTH, N_BRANCH, BRANCH_WIDTH, D_MODEL), BRANCH_WIDTH ** -0.5),
        'w_out': nrm((DEPTH, D_MODEL, D_MODEL), D_MODEL ** -0.5),
        'norm2_g': 1.0 + nrm((DEPTH, D_MODEL), 0.01),
        'moe_w_group': nrm((DEPTH, D_MODEL, N_GROUPS), D_MODEL ** -0.5),
        'moe_b_group': nrm((DEPTH, N_GROUPS), 0.01),
        'moe_w_expert': nrm((DEPTH, D_MODEL, N_GROUPS * EXPERTS_PER_GROUP), D_MODEL ** -0.5),
        'moe_b_expert': nrm((DEPTH, N_GROUPS * EXPERTS_PER_GROUP), 0.01),
        'moe_w1': nrm((DEPTH, N_GROUPS, EXPERTS_PER_GROUP, D_MODEL, D_EXPERT), D_MODEL ** -0.5),
        'moe_w3': nrm((DEPTH, N_GROUPS, EXPERTS_PER_GROUP, D_MODEL, D_EXPERT), D_MODEL ** -0.5),
        'moe_w2': nrm((DEPTH, N_GROUPS, EXPERTS_PER_GROUP, D_EXPERT, D_MODEL), D_EXPERT ** -0.5),
        'final_norm_g': 1.0 + nrm((D_MODEL,), 0.01),
    }


def reference(x, norm1_g, w_in, attn_sink, lru_conv_w, lru_conv_b, lru_w_r, lru_b_r,
              lru_w_i, lru_b_i, lru_lambda, ssm_a_re, ssm_a_im, ssm_log_step, ssm_b_re,
              ssm_b_im, ssm_c_re, ssm_c_im, ssm_d, ssm_w_glu, ssm_b_glu, w_branch, w_out,
              norm2_g, moe_w_group, moe_b_group, moe_w_expert, moe_b_expert, moe_w1,
              moe_w3, moe_w2, final_norm_g):
    for i in range(DEPTH):
        hn = rms_norm(x, norm1_g[i])
        x = x + hybrid_mixer(hn, w_in[i], attn_sink[i], lru_conv_w[i], lru_conv_b[i],
                             lru_w_r[i], lru_b_r[i], lru_w_i[i], lru_b_i[i], lru_lambda[i],
                             ssm_a_re[i], ssm_a_im[i], ssm_log_step[i], ssm_b_re[i], ssm_b_im[i],
                             ssm_c_re[i], ssm_c_im[i], ssm_d[i], ssm_w_glu[i], ssm_b_glu[i],
                             w_branch[i], w_out[i]).astype(x.dtype)
        hn = rms_norm(x, norm2_g[i])
        x = x + hier_moe(hn, moe_w_group[i], moe_b_group[i], moe_w_expert[i], moe_b_expert[i],
                         moe_w1[i], moe_w3[i], moe_w2[i])
    return rms_norm(x, final_norm_g)
```

```cpp
#include <hip/hip_runtime.h>
#include <cstdio>
#include <cstdint>

#ifndef MK_PER_PHASE
#define MK_PER_PHASE 0
#endif

constexpr int D = 1024, BATCH = 16, SEQ = 2048, M = BATCH * SEQ, DEPTH = 2;
constexpr int NQ = 8, HD = 64, WIN = 128;
constexpr int BW = 512;
constexpr int ZC = 2304;
constexpr int IN_COLS = 5376;
constexpr int COL_Q = 0, COL_K = 512, COL_V = 640, COL_XR = 768, COL_GR = 1280, COL_U = 1792, COL_GATES = 2304;
constexpr int NBUCKET = 24;
constexpr int MS_MAX = (128 + NBUCKET) * 256;
constexpr float NORM_EPS = 1e-6f;
constexpr int NWAVES = 8, NTHREADS = 512;
constexpr int NPHASE = 21;

constexpr size_t MiB = 1u << 20;
constexpr size_t WS_CTL = 0, CTL_ZERO_BYTES = 1 * MiB;
constexpr size_t WS_RINV1 = 1 * MiB;
constexpr size_t WS_RINV2 = WS_RINV1 + 128 * 1024;
constexpr size_t WS_BUCKET = WS_RINV2 + 128 * 1024;
constexpr size_t WS_RANK = WS_BUCKET + 128 * 1024;
constexpr size_t WS_WTOK = WS_RANK + 128 * 1024;
constexpr size_t WS_HIST = WS_WTOK + 256 * 1024;
constexpr size_t WS_BBASE = WS_HIST + 32 * 1024;
constexpr size_t WS_IDX = WS_BBASE + 1024;
constexpr size_t WS_WSORT = WS_IDX + 160 * 1024;
constexpr size_t WS_RSORT = WS_WSORT + 320 * 1024;
constexpr size_t WS_S5TBL = 3 * MiB;
constexpr size_t WS_WRT = 5 * MiB;
constexpr size_t WS_LRUF = 7 * MiB;
constexpr size_t WS_WINT = 8 * MiB;
constexpr size_t WS_WGLUT = 29 * MiB;
constexpr size_t WS_WBRT = 31 * MiB;
constexpr size_t WS_WOUTT = 37 * MiB;
constexpr size_t WS_W13T = 41 * MiB;
constexpr size_t WS_W2TB = 73 * MiB;
constexpr size_t WS_S5MAT = 121 * MiB;
constexpr size_t WS_S5LAM = 6 * MiB;
constexpr size_t WS_XB = 145 * MiB;
constexpr size_t WS_Z1 = 209 * MiB;
constexpr size_t WS_MIXED = 209 * MiB;
constexpr size_t WS_HS = 273 * MiB;
constexpr size_t WS_OA = 353 * MiB, WS_OL = 385 * MiB, WS_YS = 417 * MiB, WS_OS = 449 * MiB;
constexpr size_t WS_END = 481 * MiB;
static_assert(WS_WSORT + (size_t)MS_MAX * 8 <= WS_RSORT && WS_RSORT + (size_t)MS_MAX * 4 <= WS_S5TBL, "small region");
constexpr size_t WS_P3BSCR = 273 * MiB;
constexpr int TB_OFF = 163840 - 2048;
static_assert(WS_Z1 + (size_t)M * ZC * 2 <= WS_OA, "z1");
static_assert(WS_HS + (size_t)MS_MAX * 512 * 2 <= WS_OA, "hs");

constexpr int CW_BAR = 4096;
constexpr int LDS_BYTES = 163840;
constexpr int MISC_OFF = 163840 - 256;

#define LAS __attribute__((address_space(3)))
typedef unsigned short bf16;
typedef short bf16x8 __attribute__((ext_vector_type(8)));
typedef float f32x4 __attribute__((ext_vector_type(4)));
typedef unsigned u32x4 __attribute__((ext_vector_type(4)));
typedef unsigned u32x2 __attribute__((ext_vector_type(2)));

__device__ __forceinline__ float bf2f(bf16 b) { return __uint_as_float(((unsigned)b) << 16); }
__device__ __forceinline__ unsigned f2bf(float f) { unsigned u = __float_as_uint(f); return (u + 0x7fffu + ((u >> 16) & 1u)) >> 16; }
__device__ __forceinline__ unsigned pk2(float lo, float hi) { return f2bf(lo) | (f2bf(hi) << 16); }
typedef __bf16 hwbf16x2 __attribute__((ext_vector_type(2)));
__device__ __forceinline__ unsigned pk2hw(float lo, float hi) { hwbf16x2 v; v.x = (__bf16)lo; v.y = (__bf16)hi; return __builtin_bit_cast(unsigned, v); }
__device__ __forceinline__ float sigmoidf_(float x) { return __builtin_amdgcn_rcpf(1.0f + __builtin_amdgcn_exp2f(-1.4426950408889634f * x)); }
__device__ __forceinline__ float gelu_tanh(float x) { return x * sigmoidf_(1.5957691216057308f * (x + 0.044715f * x * x * x)); }
template <int N> __device__ __forceinline__ float dpp_ror(float v) { return __int_as_float(__builtin_amdgcn_update_dpp(0, __float_as_int(v), 0x120 + N, 0xf, 0xf, false)); }
__device__ __forceinline__ float rlane(float v, int l) { return __int_as_float(__builtin_amdgcn_readlane(__float_as_int(v), l)); }
__device__ __forceinline__ float wave_sum(float v, int  ) {
    v += dpp_ror<8>(v); v += dpp_ror<4>(v); v += dpp_ror<2>(v); v += dpp_ror<1>(v);
    return (rlane(v, 0) + rlane(v, 16)) + (rlane(v, 32) + rlane(v, 48));
}
__device__ __forceinline__ float lane_xor(float v, int lane, int o) { return __int_as_float(__builtin_amdgcn_ds_bpermute((lane ^ o) << 2, __float_as_int(v))); }
#define LDS_WAIT() asm volatile("s_waitcnt lgkmcnt(0)" ::: "memory")

#define XB_TMO      128
#define XB_XCNT(j)  (256  + 64 * (j))
#define XB_XSUB(j)  (1280 + 64 * (j))
#define XB_XGEN(j)  (2304 + 64 * (j))
#define XB_TOP      3328
#define XB_TOPGEN   3392
#define XCD_BAR_WORDS 3456
#define XB_SPIN_CAP (1u << 20)
__device__ __forceinline__ unsigned xb_ld(unsigned* p)              { return __hip_atomic_load(p, __ATOMIC_RELAXED, __HIP_MEMORY_SCOPE_AGENT); }
__device__ __forceinline__ unsigned xb_add(unsigned* p, unsigned v) { return __hip_atomic_fetch_add(p, v, __ATOMIC_RELAXED, __HIP_MEMORY_SCOPE_AGENT); }
__device__ __forceinline__ unsigned xb_xcc_id() { return (unsigned)__builtin_amdgcn_s_getreg((3 << 11) | 20) & 0xFu; }
#define XB_SPIN(cond, bar) do { unsigned _sp = 0; while (cond) { __builtin_amdgcn_s_sleep(1); \
    if ((++_sp & 255u) == 0u) { if (xb_ld(&(bar)[XB_TMO])) break; if (_sp > XB_SPIN_CAP) { atomicAdd(&(bar)[XB_TMO], 1u); break; } } } } while (0)
struct XcdBarrier { unsigned* bar; unsigned x; volatile LAS unsigned* st; };
__device__ __forceinline__ XcdBarrier xcd_barrier_post(unsigned* bar, volatile LAS unsigned* st, bool leader) {
    XcdBarrier b; b.bar = bar; b.x = xb_xcc_id(); b.st = st;
    if (leader) (void)xb_add(&bar[XB_XCNT(b.x)], 1u);
    return b;
}
__device__ __forceinline__ void xcd_barrier_complete(unsigned* bar, unsigned x, unsigned& nloc, unsigned& nx) {
    const unsigned G = gridDim.x * gridDim.y * gridDim.z;
    unsigned sum, cnt, mine, sp = 0u;
    for (;;) {
        sum = 0u; cnt = 0u; mine = 0u;
#pragma unroll
        for (unsigned j = 0; j < 16; ++j) { const unsigned c = xb_ld(&bar[XB_XCNT(j)]); sum += c; cnt += (c > 0u) ? 1u : 0u; mine = (j == x) ? c : mine; }
        if (sum == G) break;
        __builtin_amdgcn_s_sleep(1);
        if ((++sp & 255u) == 0u) { if (xb_ld(&bar[XB_TMO])) break; if (sp > XB_SPIN_CAP) { atomicAdd(&bar[XB_TMO], 1u); break; } }
    }
    nloc = mine > 0u ? mine : 1u; nx = cnt > 0u ? cnt : 1u;
}
__device__ __forceinline__ void xcd_barrier(const XcdBarrier& b, bool leader) {
    asm volatile("s_waitcnt vmcnt(0)" ::: "memory");
    __syncthreads();
    if (leader) {
        unsigned* bar = b.bar;
        __builtin_amdgcn_s_waitcnt(0);
        unsigned nloc = b.st[0], nx = b.st[1];
        if (nloc == 0u) { xcd_barrier_complete(bar, b.x, nloc, nx); b.st[0] = nloc; b.st[1] = nx; }
        const unsigned old = xb_add(&bar[XB_XSUB(b.x)], 1u);
        const unsigned gen = old / nloc;
        if (old + 1u == (gen + 1u) * nloc) {
            __builtin_amdgcn_fence(__ATOMIC_RELEASE, "agent");
            asm volatile("s_waitcnt vmcnt(0)" ::: "memory");
            const unsigned og = xb_add(&bar[XB_TOP], 1u);
            const unsigned tg = og / nx;
            if (og + 1u == (tg + 1u) * nx) xb_add(&bar[XB_TOPGEN], 1u);
            else XB_SPIN(xb_ld(&bar[XB_TOPGEN]) == tg, bar);
            __builtin_amdgcn_fence(__ATOMIC_ACQUIRE, "agent");
            xb_add(&bar[XB_XGEN(b.x)], 1u);
            asm volatile("s_waitcnt vmcnt(0)" ::: "memory");
        } else {
            XB_SPIN(xb_ld(&bar[XB_XGEN(b.x)]) == gen, bar);
            __builtin_amdgcn_fence(__ATOMIC_ACQUIRE, "agent");
            asm volatile("s_waitcnt vmcnt(0)" ::: "memory");
        }
    }
    __syncthreads();
}

struct Args { const float* in[32]; float* out; unsigned char* ws; int ph_lo, ph_hi, li, pad; };
struct Frame {
    LAS unsigned char* lds;
    int tid, lane, wave, wg, gw;
    static constexpr int G = 256, NGW = 256 * NWAVES;
    const float* const __attribute__((address_space(4)))* in;
    float* out; unsigned char* ws;
};
enum { I_X = 0, I_N1G, I_WIN, I_SINK, I_CONVW, I_CONVB, I_LWR, I_LBR, I_LWI, I_LBI, I_LAM, I_ARE, I_AIM, I_LSTEP, I_BRE, I_BIM, I_CRE, I_CIM, I_SD, I_WGLU, I_BGLU,
       I_WBR, I_WOUT, I_N2G, I_WG, I_BG, I_WE, I_BE, I_W1, I_W3, I_W2, I_FNG };

__device__ __forceinline__ void pair_of(int p, int& a, int& b) {
    a = (p < 3) ? 0 : (p < 5 ? 1 : 2); b = (p < 3) ? p + 1 : (p < 5 ? p - 1 : 3);
}
__device__ __forceinline__ int pair_index(int a, int b) {
    return (a == 0) ? (b - 1) : (a == 1 ? (b + 1) : 5);
}


namespace pg8 {
typedef unsigned short bf16_t;
constexpr int BM = 256, BK = 64, HALF = 128, HTB = HALF * BK * 2, STAGE_BYTES = 8 * HTB, NXCD = 8, WGM = 8;
__host__ __device__ __forceinline__ int lds_byte(int r, int c) { const int st = (r >> 4) * 2 + (c >> 5), rr = r & 15, cc = c & 31, ob = rr * 64 + cc * 2; return st * 1024 + (ob ^ (((ob >> 9) & 1) << 5)); }
__host__ __device__ __forceinline__ void stage_rc(int b, int& R, int& C) { const int st = b / 1024, sb = b % 1024, swz = sb ^ (((sb >> 9) & 1) << 5); R = (st >> 1) * 16 + swz / 64; C = (st & 1) * 32 + (swz % 64) / 2; }
__host__ __device__ __forceinline__ int perm32(int rho) { const int n = rho >> 4, i = rho & 15; return 8 * (i >> 2) + 4 * n + (i & 3); }

struct Unit { int pm, pn, aux; int nt; unsigned lda2, ldb2; const char* A; const char* B; };

__device__ __forceinline__ void static_tile(int L, int nM, int nN, int& pm, int& pn) {
    const int nwg = nM * nN; int wgid = L; { const int q = nwg / NXCD, r = nwg % NXCD, xcd = wgid % NXCD, off = wgid / NXCD; wgid = (xcd < r ? xcd * (q + 1) : r * (q + 1) + (xcd - r) * q) + off; }
    const int nig = WGM * nN, gid = wgid / nig, fm = gid * WGM, gsz = (nM - fm) < WGM ? (nM - fm) : WGM;
    pm = fm + ((wgid % nig) % gsz); pn = (wgid % nig) / gsz;
}

template <class Epi, class Sched, bool ALIGN_EPI, int MODE>
__device__ __forceinline__ void gemm_phase(LAS unsigned char* lds, const Sched& S, const Epi& E, int tid) {
    const int wid = __builtin_amdgcn_readfirstlane(tid >> 6), lane = tid & 63, wr = wid >> 2, wc = wid & 3, fr = lane & 15, fq = lane >> 4;
    unsigned RA[2], C2[2];
#pragma unroll
    for (int i = 0; i < 2; ++i) { int R, C; stage_rc(tid * 16 + i * 8192, R, C); RA[i] = (unsigned)R; C2[i] = (unsigned)C * 2u; }
    const unsigned ldsw = (unsigned)wid * 1024u;
    const int aoff = lds_byte(wr * 64 + fr, fq * 8), boff = lds_byte(wc * 32 + fr, fq * 8);
#define PG8_SA(b, h) (((b) * 2 + (h)) * HTB)
#define PG8_SB(b, h) ((4 + (b) * 2 + (h)) * HTB)
#define PG8_STAGE_A(bufoff, gbase, h, ld2, go) do { _Pragma("unroll") for (int _i = 0; _i < 2; ++_i) { \
        const unsigned _vo = (MODE == 2) ? ((go)[h][_i] + C2[_i]) : ((RA[_i] + 128u * (h)) * (ld2) + C2[_i]); \
        __builtin_amdgcn_global_load_lds((const unsigned*)((gbase) + _vo), (LAS unsigned*)(lds + (bufoff) + ldsw + _i * 8192), 16, 0, 0); } } while (0)
#define PG8_STAGE_B(bufoff, gbase, h, ld2) do { _Pragma("unroll") for (int _i = 0; _i < 2; ++_i) { \
        const unsigned _vo = (((RA[_i] & ~31u) + (unsigned)perm32((int)(RA[_i] & 31u))) + 128u * (h)) * (ld2) + C2[_i]; \
        __builtin_amdgcn_global_load_lds((const unsigned*)((gbase) + _vo), (LAS unsigned*)(lds + (bufoff) + ldsw + _i * 8192), 16, 0, 0); } } while (0)
#define PG8_LDA(dst, b, h) do { _Pragma("unroll") for (int m = 0; m < 4; ++m) _Pragma("unroll") for (int k = 0; k < 2; ++k) dst[m][k] = *(const LAS bf16x8*)(lds + PG8_SA(b, h) + aoff + m * 2048 + k * 1024); } while (0)
#define PG8_LDB(dst, b, h) do { _Pragma("unroll") for (int n = 0; n < 2; ++n) _Pragma("unroll") for (int k = 0; k < 2; ++k) dst[n][k] = *(const LAS bf16x8*)(lds + PG8_SB(b, h) + boff + n * 2048 + k * 1024); } while (0)
#define PG8_MMA(ai, bj, At, Bt) do { __builtin_amdgcn_s_setprio(1); _Pragma("unroll") for (int m = 0; m < 4; ++m) _Pragma("unroll") for (int n = 0; n < 2; ++n) _Pragma("unroll") for (int k = 0; k < 2; ++k) \
        acc[ai][bj][m][n] = __builtin_amdgcn_mfma_f32_16x16x32_bf16(Bt[n][k], At[m][k], acc[ai][bj][m][n], 0, 0, 0); __builtin_amdgcn_s_setprio(0); } while (0)
#define PG8_WAIT_V(n) asm volatile("s_waitcnt vmcnt(" #n ")" ::: "memory")
#define PG8_WAIT_L(n) asm volatile("s_waitcnt lgkmcnt(" #n ")" ::: "memory")
#define PG8_BAR __builtin_amdgcn_s_barrier()
#define PG8_SCHED __builtin_amdgcn_sched_barrier(0)
    Unit cur, nxt; int ui = 0;
    if (!S.next(0, cur)) return;
    f32x4 acc[2][2][4][2];
#pragma unroll
    for (int a = 0; a < 2; ++a)
#pragma unroll
        for (int b = 0; b < 2; ++b)
#pragma unroll
            for (int m = 0; m < 4; ++m)
#pragma unroll
                for (int n = 0; n < 2; ++n) acc[a][b][m][n] = (f32x4){0.f, 0.f, 0.f, 0.f};
    bf16x8 At[4][2], B0[2][2], B1[2][2];
    unsigned cgo[2][2] = {{0u, 0u}, {0u, 0u}}, ngo[2][2] = {{0u, 0u}, {0u, 0u}};
    if (MODE == 2) {
#pragma unroll
        for (int h = 0; h < 2; ++h)
#pragma unroll
            for (int i = 0; i < 2; ++i) cgo[h][i] = S.row_off(cur, h * 128 + (int)RA[i]);
    }
    const size_t kstep = (size_t)(BK * 2);
    const char* cA = cur.A; const char* cB = cur.B;
    PG8_STAGE_B(PG8_SB(0, 0), cB, 0, cur.ldb2); PG8_STAGE_B(PG8_SB(0, 1), cB, 1, cur.ldb2); PG8_STAGE_A(PG8_SA(0, 0), cA, 0, cur.lda2, cgo); PG8_STAGE_A(PG8_SA(0, 1), cA, 1, cur.lda2, cgo);
    if (wr == 1) PG8_BAR;
    PG8_WAIT_V(2); PG8_BAR;
    PG8_STAGE_B(PG8_SB(1, 0), cB + kstep, 0, cur.ldb2); PG8_STAGE_A(PG8_SA(1, 0), cA + kstep, 0, cur.lda2, cgo); PG8_STAGE_B(PG8_SB(1, 1), cB + kstep, 1, cur.ldb2);
    PG8_WAIT_V(6); PG8_BAR;
    for (;;) {
        const bool has_next = S.next(ui + 1, nxt);
        if (!has_next) nxt = cur;
        if (MODE == 2) {
#pragma unroll
            for (int h = 0; h < 2; ++h)
#pragma unroll
                for (int i = 0; i < 2; ++i) ngo[h][i] = has_next ? S.row_off(nxt, h * 128 + (int)RA[i]) : cgo[h][i];
        }
        const char* nA = nxt.A; const char* nB = nxt.B;
        const int nt = cur.nt;
        for (int t = 0; t < nt; t += 2) {
            const bool last = (t == nt - 2);
            const char* a1 = cA + (size_t)(t + 1) * kstep;
            const char* a2 = last ? nA : cA + (size_t)(t + 2) * kstep; const char* b2 = last ? nB : cB + (size_t)(t + 2) * kstep;
            const char* a3 = a2 + kstep; const char* b3 = b2 + kstep;
            const unsigned la2 = last ? nxt.lda2 : cur.lda2, lb2 = last ? nxt.ldb2 : cur.ldb2;
            unsigned go2[2][2];
#pragma unroll
            for (int h = 0; h < 2; ++h)
#pragma unroll
                for (int i = 0; i < 2; ++i) go2[h][i] = last ? ngo[h][i] : cgo[h][i];
            PG8_LDB(B0, 0, 0); PG8_LDB(B1, 0, 1); PG8_SCHED; PG8_LDA(At, 0, 0); PG8_STAGE_A(PG8_SA(1, 1), a1, 1, cur.lda2, cgo);
            PG8_WAIT_V(8); PG8_WAIT_L(0); PG8_BAR; PG8_MMA(0, 0, At, B0); PG8_MMA(0, 1, At, B1); PG8_BAR; PG8_SCHED;
            PG8_LDA(At, 0, 1); PG8_STAGE_B(PG8_SB(0, 0), b2, 0, lb2); PG8_STAGE_B(PG8_SB(0, 1), b2, 1, lb2); PG8_STAGE_A(PG8_SA(0, 0), a2, 0, la2, go2);
            PG8_WAIT_V(8); PG8_WAIT_L(0); PG8_BAR; PG8_MMA(1, 0, At, B0); PG8_MMA(1, 1, At, B1); PG8_BAR; PG8_SCHED;
            PG8_LDB(B0, 1, 0); PG8_LDB(B1, 1, 1); PG8_SCHED; PG8_LDA(At, 1, 0); PG8_STAGE_A(PG8_SA(0, 1), a2, 1, la2, go2);
            PG8_WAIT_V(8); PG8_WAIT_L(0); PG8_BAR; PG8_MMA(0, 0, At, B0); PG8_MMA(0, 1, At, B1); PG8_BAR; PG8_SCHED;
            PG8_LDA(At, 1, 1); PG8_STAGE_B(PG8_SB(1, 0), b3, 0, lb2); PG8_STAGE_B(PG8_SB(1, 1), b3, 1, lb2); PG8_STAGE_A(PG8_SA(1, 0), a3, 0, la2, go2);
            PG8_WAIT_V(8); PG8_WAIT_L(0); PG8_BAR; PG8_MMA(1, 0, At, B0); PG8_MMA(1, 1, At, B1); PG8_BAR; PG8_SCHED;
        }
        if constexpr (ALIGN_EPI) { if (wr == 0) PG8_BAR; }
        const bool keep = E(acc, cur, wr, wc, fr, fq);
        if (!has_next) break;
        if (!keep) {
#pragma unroll
            for (int a = 0; a < 2; ++a)
#pragma unroll
                for (int b = 0; b < 2; ++b)
#pragma unroll
                    for (int m = 0; m < 4; ++m)
#pragma unroll
                        for (int n = 0; n < 2; ++n) acc[a][b][m][n] = (f32x4){0.f, 0.f, 0.f, 0.f};
        }
        cur = nxt; cA = nA; cB = nB; ++ui;
        if (MODE == 2) {
#pragma unroll
            for (int h = 0; h < 2; ++h)
#pragma unroll
                for (int i = 0; i < 2; ++i) cgo[h][i] = ngo[h][i];
        }
        if constexpr (ALIGN_EPI) { if (wr == 1) PG8_BAR; }
    }
    PG8_WAIT_V(0);
    if constexpr (!ALIGN_EPI) { if (wr == 0) PG8_BAR; }
    PG8_BAR;
#undef PG8_SA
#undef PG8_SB
#undef PG8_STAGE_A
#undef PG8_STAGE_B
#undef PG8_LDA
#undef PG8_LDB
#undef PG8_MMA
#undef PG8_WAIT_V
#undef PG8_WAIT_L
#undef PG8_BAR
#undef PG8_SCHED
}
}

__device__ __forceinline__ unsigned cvt_pk_bf16(float lo, float hi) { unsigned r; asm volatile("v_cvt_pk_bf16_f32 %0, %1, %2" : "=v"(r) : "v"(lo), "v"(hi)); return r; }
__device__ __forceinline__ u32x4 pack8(const f32x4& v0, const f32x4& v1) { u32x4 w; w.x = cvt_pk_bf16(v0[0], v0[1]); w.y = cvt_pk_bf16(v0[2], v0[3]); w.z = cvt_pk_bf16(v1[0], v1[1]); w.w = cvt_pk_bf16(v1[2], v1[3]); return w; }
__device__ __forceinline__ void unpack8(const u32x4& w, f32x4& v0, f32x4& v1) {
    v0[0] = __uint_as_float(w.x << 16); v0[1] = __uint_as_float(w.x & 0xffff0000u); v0[2] = __uint_as_float(w.y << 16); v0[3] = __uint_as_float(w.y & 0xffff0000u);
    v1[0] = __uint_as_float(w.z << 16); v1[1] = __uint_as_float(w.z & 0xffff0000u); v1[2] = __uint_as_float(w.w << 16); v1[3] = __uint_as_float(w.w & 0xffff0000u); }

struct DenseSched {
    const char* A; const char* B; int nM, nN, G, c, nt; unsigned lda2, ldb2;
    __device__ __forceinline__ bool next(int i, pg8::Unit& u) const {
        const int L = i * G + c; if (L >= nM * nN) return false;
        pg8::static_tile(L, nM, nN, u.pm, u.pn); u.aux = 0; u.nt = nt; u.lda2 = lda2; u.ldb2 = ldb2;
        u.A = A + (size_t)u.pm * 256 * lda2; u.B = B + (size_t)u.pn * 256 * ldb2; return true;
    }
    __device__ __forceinline__ unsigned row_off(const pg8::Unit&, int) const { return 0u; }
};

template <int MAP>
__device__ __forceinline__ int rowmap(int n) { if (MAP == 0) return n; return (n >> 7) * 256 + (n & 127) + (MAP == 2 ? 128 : 0); }
template <int MAP>
__device__ __forceinline__ void transpose_item(const float* W, int N, int ncol0, const float* gain, bf16* dst, int dld, int dcol0, LAS float* scr, int kb, int nb, int lane) {
    const int k0 = 64 * kb, n0 = 32 * nb;
    float tv_[32];
#pragma unroll
    for (int i = 0; i < 32; ++i) tv_[i] = W[(size_t)(k0 + 2 * i + (lane >> 5)) * N + ncol0 + n0 + (lane & 31)];
    if (gain) {
#pragma unroll
        for (int i = 0; i < 32; ++i) tv_[i] *= gain[k0 + 2 * i + (lane >> 5)];
    }
#pragma unroll
    for (int i = 0; i < 32; ++i) scr[(2 * i + (lane >> 5)) * 33 + (lane & 31)] = tv_[i];
    LDS_WAIT();
    const int c = lane & 7;
#pragma unroll
    for (int j = 0; j < 4; ++j) { const int n = (lane >> 3) + 8 * j; const LAS float* s = scr + (8 * c) * 33 + n;
        u32x4 o; o.x = pk2(s[0 * 33], s[1 * 33]); o.y = pk2(s[2 * 33], s[3 * 33]); o.z = pk2(s[4 * 33], s[5 * 33]); o.w = pk2(s[6 * 33], s[7 * 33]);
        *(u32x4*)(dst + (size_t)rowmap<MAP>(n0 + n) * dld + dcol0 + k0 + 8 * c) = o; }
    LDS_WAIT();
}

__device__ __forceinline__ void s5_setup_item(Frame& F, int l, int g);
#ifndef P0_LAYERS
#define P0_LAYERS 1
#endif
__device__ __forceinline__ void p0_weights(Frame& F, int l0, int l1, int worker, int nworkers) {
    LAS float* scr = (LAS float*)(F.lds + F.wave * 16384);
    unsigned char* ws = F.ws;
    constexpr int IT_WIN = 16 * 168, IT_GLU = 8 * 16 * 2, IT_BR = 3 * 8 * 32, IT_OUT = 16 * 32, IT_W13 = 16 * 2 * 16 * 8, IT_W2 = 48 * 4 * 32;
    constexpr int IT_LAYER = IT_WIN + IT_GLU + IT_BR + IT_OUT + IT_W13 + IT_W2;
    for (int it = l0 * IT_LAYER + worker; it < l1 * IT_LAYER; it += nworkers) {
        const int l = it / IT_LAYER; int r = it % IT_LAYER;
        if (r < IT_WIN) { transpose_item<0>(F.in[I_WIN] + (size_t)l * D * IN_COLS, IN_COLS, 0, F.in[I_N1G] + l * D, (bf16*)(ws + WS_WINT) + (size_t)l * IN_COLS * D, D, 0, scr, r / 168, r % 168, F.lane); continue; }
        r -= IT_WIN;
        if (r < IT_GLU) { const int half = r / (8 * 16); const int q = r % (8 * 16);
            const float* W = F.in[I_WGLU] + (size_t)l * BW * 1024; bf16* dst = (bf16*)(ws + WS_WGLUT) + (size_t)l * 1024 * BW;
            if (half == 0) transpose_item<1>(W, 1024, 0, nullptr, dst, BW, 0, scr, q / 16, q % 16, F.lane);
            else           transpose_item<2>(W, 1024, 512, nullptr, dst, BW, 0, scr, q / 16, q % 16, F.lane);
            continue; }
        r -= IT_GLU;
        if (r < IT_BR) { const int k = r / 256, q = r % 256; transpose_item<0>(F.in[I_WBR] + ((size_t)l * 3 + k) * BW * D, D, 0, nullptr, (bf16*)(ws + WS_WBRT) + ((size_t)l * 3 + k) * D * BW, BW, 0, scr, q / 32, q % 32, F.lane); continue; }
        r -= IT_BR;
        if (r < IT_OUT) { transpose_item<0>(F.in[I_WOUT] + (size_t)l * D * D, D, 0, nullptr, (bf16*)(ws + WS_WOUTT) + (size_t)l * D * D, D, 0, scr, r / 32, r % 32, F.lane); continue; }
        r -= IT_OUT;
        if (r < IT_W13) { const int ge = r / 256, q = r % 256, which = q / 128, qq = q % 128;
            const float* W = F.in[which ? I_W3 : I_W1] + ((size_t)l * 16 + ge) * D * 256; bf16* dst = (bf16*)(ws + WS_W13T) + ((size_t)l * 16 + ge) * 512 * D;
            if (which == 0) transpose_item<1>(W, 256, 0, F.in[I_N2G] + l * D, dst, D, 0, scr, qq / 8, qq % 8, F.lane);
            else            transpose_item<2>(W, 256, 0, F.in[I_N2G] + l * D, dst, D, 0, scr, qq / 8, qq % 8, F.lane);
            continue; }
        r -= IT_W13;
        { const int bs = r / 128, q = r % 128, bucket = bs >> 1, slot = bs & 1, g = bucket / 6; int pa, pb; pair_of(bucket % 6, pa, pb);
          const int e = g * 4 + (slot ? pb : pa);
          transpose_item<0>(F.in[I_W2] + ((size_t)l * 16 + e) * 256 * D, D, 0, nullptr, (bf16*)(ws + WS_W2TB) + ((size_t)l * NBUCKET + bucket) * D * 512, 512, slot * 256, scr, q / 32, q % 32, F.lane); }
    }
}
__device__ __forceinline__ void p0_prologue(Frame& F) {
    LAS float* scr = (LAS float*)(F.lds + F.wave * 16384);
    unsigned char* ws = F.ws;
    constexpr int XB_SPLIT = M / 4;
    const bool s5wg = F.wg < DEPTH * 32;
    if (s5wg) s5_setup_item(F, F.wg >> 5, F.wg & 31);
    const int gwx = s5wg ? F.wg * NWAVES + F.wave : (F.wg - DEPTH * 32) * NWAVES + F.wave; const int NGX = s5wg ? DEPTH * 32 * NWAVES : (256 - DEPTH * 32) * NWAVES;
    if (!s5wg) p0_weights(F, 0, P0_LAYERS, gwx, NGX);
    {
        const float* x = F.in[I_X]; bf16* XB = (bf16*)(ws + WS_XB); float* rinv = (float*)(ws + WS_RINV1);
        for (int m0 = (s5wg ? 0 : XB_SPLIT) + 4 * gwx; m0 < (s5wg ? XB_SPLIT : M); m0 += 4 * NGX) {
            f32x4 v[4][4]; float s4[4];
#pragma unroll
            for (int a = 0; a < 4; ++a) { const f32x4* xr = (const f32x4*)(x + (size_t)(m0 + a) * D) + F.lane;
#pragma unroll
                for (int j = 0; j < 4; ++j) v[a][j] = xr[64 * j]; }
#pragma unroll
            for (int a = 0; a < 4; ++a) { float s = 0.f;
#pragma unroll
                for (int j = 0; j < 4; ++j) s += (v[a][j].x * v[a][j].x + v[a][j].y * v[a][j].y) + (v[a][j].z * v[a][j].z + v[a][j].w * v[a][j].w);
                s4[a] = wave_sum(s, F.lane);
                u32x2* o = (u32x2*)(XB + (size_t)(m0 + a) * D) + F.lane;
#pragma unroll
                for (int j = 0; j < 4; ++j) { u32x2 w; w.x = pk2(v[a][j].x, v[a][j].y); w.y = pk2(v[a][j].z, v[a][j].w); o[64 * j] = w; } }
            if (F.lane < 4) { const float s = F.lane == 0 ? s4[0] : (F.lane == 1 ? s4[1] : (F.lane == 2 ? s4[2] : s4[3])); rinv[m0 + F.lane] = 1.0f / sqrtf(s * (1.0f / D) + NORM_EPS); }
        }
    }
    if (s5wg) return;
    {
        bf16* lf = (bf16*)(ws + WS_LRUF);
        for (int i = gwx * 64 + F.lane; i < DEPTH * 2 * 8 * 2 * 2 * 4 * 64; i += NGX * 64) {
            const int ln = i & 63, ks = (i >> 6) & 3, gate = (i >> 8) & 1, nh = (i >> 9) & 1, hb = (i >> 10) & 7, ld = i >> 13;
            const float* W = F.in[gate ? I_LWI : I_LWR] + ((size_t)ld * 8 + hb) * 4096 + nh * 32 + (ln & 31);
            const int k0 = 16 * ks + 8 * (ln >> 5);
            u32x4 o; o.x = pk2(W[(size_t)(k0 + 0) * 64], W[(size_t)(k0 + 1) * 64]); o.y = pk2(W[(size_t)(k0 + 2) * 64], W[(size_t)(k0 + 3) * 64]);
            o.z = pk2(W[(size_t)(k0 + 4) * 64], W[(size_t)(k0 + 5) * 64]); o.w = pk2(W[(size_t)(k0 + 6) * 64], W[(size_t)(k0 + 7) * 64]);
            *(u32x4*)(lf + (size_t)i * 8) = o;
        }
    }
    {
        float* wrt = (float*)(ws + WS_WRT);
        for (int i = gwx * 64 + F.lane; i < DEPTH * 20 * D; i += NGX * 64) {
            const int k = i % D, j = (i / D) % 20, l = i / (20 * D);
            const float g2 = F.in[I_N2G][l * D + k];
            wrt[i] = g2 * (j < 4 ? F.in[I_WG][((size_t)l * D + k) * 4 + j] : F.in[I_WE][((size_t)l * D + k) * 16 + (j - 4)]);
        }
    }
}

typedef float f32x16 __attribute__((ext_vector_type(16)));
#define MFMA32(a, b, c) __builtin_amdgcn_mfma_f32_32x32x16_bf16((a), (b), (c), 0, 0, 0)
constexpr int S5_ETAB = 0, S5_UIMG = 8192, S5_HIMG = 8192 + 67584, S5_CSTR = 528;

__device__ __forceinline__ void s5_setup_item(Frame& F, int l, int g) {
    LAS float* PW = (LAS float*)F.lds;
    LAS float* BB = PW + 4352;
    LAS float* CC = BB + 4096;
    LAS float* KT = CC + 2048;
    const int tid = F.tid;
    __syncthreads();
    for (int idx = tid; idx < 2 * 64 * 17; idx += NTHREADS) {
        const int d = idx / 1088, rem = idx % 1088, n = rem / 17, j = rem % 17, ld = l * 2 + d;
        const float are = F.in[I_ARE][(size_t)ld * 2048 + g * 64 + n], aim = F.in[I_AIM][(size_t)ld * 2048 + g * 64 + n];
        const float step = expf(F.in[I_LSTEP][ld * 32 + g]);
        const double ang1 = (double)aim * (double)step, lm1 = (double)are * (double)step;
        const double a = fmod(ang1 * j, 6.283185307179586); float sn, cs; sincosf((float)a, &sn, &cs); const float mg = expf((float)(lm1 * j));
        PW[((d * 64 + n) * 17 + j) * 2] = mg * cs; PW[((d * 64 + n) * 17 + j) * 2 + 1] = mg * sn;
    }
    if (tid < 128) {
        const int d = tid >> 6, n = tid & 63, ld = l * 2 + d;
        const float are = F.in[I_ARE][(size_t)ld * 2048 + g * 64 + n], aim = F.in[I_AIM][(size_t)ld * 2048 + g * 64 + n];
        const float step = expf(F.in[I_LSTEP][ld * 32 + g]);
        const double ang1 = (double)aim * (double)step, lm1 = (double)are * (double)step;
        float abr, abi;
        { const double a = fmod(ang1 * 1, 6.283185307179586); float sn, cs; sincosf((float)a, &sn, &cs); const float mg = expf((float)(lm1 * 1)); abr = mg * cs; abi = mg * sn; }
        { float* lam = (float*)(F.ws + WS_S5LAM) + ((((size_t)l * 32 + g) * 2 + d) * 64 + n) * 4;
          const double a16 = fmod(ang1 * 16.0, 6.283185307179586), a256 = fmod(ang1 * 256.0, 6.283185307179586); float sn, cs;
          sincosf((float)a16, &sn, &cs); const float m16 = expf((float)(lm1 * 16.0)); lam[0] = m16 * cs; lam[1] = m16 * sn;
          sincosf((float)a256, &sn, &cs); const float m256 = expf((float)(lm1 * 256.0)); lam[2] = m256 * cs; lam[3] = m256 * sn; }
        const float den = are * are + aim * aim, nr = abr - 1.0f;
        const float sr = (nr * are + abi * aim) / den, si = (abi * are - nr * aim) / den;
        const float* bre = F.in[I_BRE] + ((size_t)ld * 2048 + g * 64 + n) * 16; const float* bim = F.in[I_BIM] + ((size_t)ld * 2048 + g * 64 + n) * 16;
        for (int c = 0; c < 16; ++c) { BB[((d * 64 + n) * 16 + c) * 2] = sr * bre[c] - si * bim[c]; BB[((d * 64 + n) * 16 + c) * 2 + 1] = sr * bim[c] + si * bre[c]; }
    }
    for (int i = tid; i < 1024; i += NTHREADS) { CC[i * 2] = F.in[I_CRE][((size_t)l * 32 + g) * 1024 + i]; CC[i * 2 + 1] = F.in[I_CIM][((size_t)l * 32 + g) * 1024 + i]; }
    __syncthreads();
    {
        const int cp = tid & 15, dl = (tid >> 4) & 15, d = tid >> 8; float acc[16];
#pragma unroll
        for (int c = 0; c < 16; ++c) acc[c] = 0.f;
#pragma unroll 2
        for (int n = 0; n < 64; ++n) { const float cr = CC[(cp * 64 + n) * 2], ci = CC[(cp * 64 + n) * 2 + 1], pr = PW[((d * 64 + n) * 17 + dl) * 2], pi = PW[((d * 64 + n) * 17 + dl) * 2 + 1];
            const float gr = cr * pr - ci * pi, gi = cr * pi + ci * pr;
#pragma unroll
            for (int c = 0; c < 16; ++c) { const float br = BB[((d * 64 + n) * 16 + c) * 2], bi = BB[((d * 64 + n) * 16 + c) * 2 + 1]; acc[c] += gr * br - gi * bi; } }
#pragma unroll
        for (int c = 0; c < 16; ++c) KT[((d * 16 + dl) * 16 + cp) * 16 + c] = acc[c];
    }
    __syncthreads();
    bf16* WsF = (bf16*)(F.ws + WS_S5MAT) + ((size_t)l * 32 + g) * 196608; bf16* W3F = WsF + 65536;
    for (int q = tid; q < 8192; q += NTHREADS) {
        const int row = q >> 5, kc = (q & 31) * 8, s_ = kc >> 4, c0 = kc & 15;
        const int nn = row & 31, ri = (row >> 5) & 1, sh = (row >> 6) & 1, d = row >> 7, n = sh * 32 + nn, e = d ? s_ : 15 - s_;
        const float pr = PW[((d * 64 + n) * 17 + e) * 2], pi = PW[((d * 64 + n) * 17 + e) * 2 + 1]; float v[8];
#pragma unroll
        for (int j = 0; j < 8; ++j) { const float br = BB[((d * 64 + n) * 16 + c0 + j) * 2], bi = BB[((d * 64 + n) * 16 + c0 + j) * 2 + 1]; v[j] = ri ? (pr * bi + pi * br) : (pr * br - pi * bi); }
        u32x4 o; o.x = pk2(v[0], v[1]); o.y = pk2(v[2], v[3]); o.z = pk2(v[4], v[5]); o.w = pk2(v[6], v[7]);
        const int tile = row >> 5, ks = kc >> 4, ln = (row & 31) + 32 * ((kc >> 3) & 1);
        *(u32x4*)(WsF + ((size_t)(tile * 16 + ks) * 64 + ln) * 8) = o;
    }
    const float* dsk = F.in[I_SD] + l * BW + g * 16;
    for (int q = tid; q < 16384; q += NTHREADS) {
        const int row = q >> 6, kc = (q & 63) * 8, tau = row >> 4, cp = row & 15; float v[8];
        if (kc < 256) { const int s_ = kc >> 4, c0 = kc & 15;
#pragma unroll
            for (int j = 0; j < 8; ++j) { float m = 0.f; if (s_ <= tau) m += KT[((0 * 16 + (tau - s_)) * 16 + cp) * 16 + c0 + j]; if (s_ >= tau) m += KT[((1 * 16 + (s_ - tau)) * 16 + cp) * 16 + c0 + j];
                if (s_ == tau && c0 + j == cp) m += dsk[cp]; v[j] = m; }
        } else {
#pragma unroll
            for (int j = 0; j < 8; ++j) { const int kh = kc - 256 + j, d = kh >> 7, n = (kh & 127) >> 1, ri = kh & 1, p = d ? 16 - tau : tau + 1;
                const float cr = CC[(cp * 64 + n) * 2], ci = CC[(cp * 64 + n) * 2 + 1], pr = PW[((d * 64 + n) * 17 + p) * 2], pi = PW[((d * 64 + n) * 17 + p) * 2 + 1];
                v[j] = ri ? -(cr * pi + ci * pr) : (cr * pr - ci * pi); }
        }
        u32x4 o; o.x = pk2(v[0], v[1]); o.y = pk2(v[2], v[3]); o.z = pk2(v[4], v[5]); o.w = pk2(v[6], v[7]);
        const int tile = row >> 5, ks = kc >> 4, ln = (row & 31) + 32 * ((kc >> 3) & 1);
        *(u32x4*)(W3F + ((size_t)(tile * 32 + ks) * 64 + ln) * 8) = o;
    }
}


__device__ __forceinline__ void s5_scan_a(f32x16& re, f32x16& im, float Lr, float Li, LAS float* e) {
#pragma unroll
    for (int i = 1; i < 16; ++i) { const float pr = re[i - 1], pi = im[i - 1]; re[i] += Lr * pr - Li * pi; im[i] += Lr * pi + Li * pr; }
    e[0] = re[15]; e[1] = im[15];
}
__device__ __forceinline__ void s5_scan_b(f32x16& re, f32x16& im, float Lr, float Li, float L16r, float L16i, const LAS float* et, int sg, LAS unsigned char* hp, int hstep) {
    float cr = 0.f, ci = 0.f;
#pragma unroll
    for (int sp = 0; sp < 8; ++sp) { const bool use = sp < sg; const float er = et[sp * 64], ei = et[sp * 64 + 1];
        const float nr_ = L16r * cr - L16i * ci + er, ni_ = L16r * ci + L16i * cr + ei; cr = use ? nr_ : cr; ci = use ? ni_ : ci; }
    float pr = Lr, pi = Li;
#pragma unroll
    for (int i = 0; i < 16; ++i) { re[i] += pr * cr - pi * ci; im[i] += pr * ci + pi * cr; const float t = pr * Lr - pi * Li; pi = pr * Li + pi * Lr; pr = t; }
#pragma unroll
    for (int i = 0; i < 16; ++i) *(LAS unsigned*)(hp + i * hstep) = pk2(re[i], im[i]);
}

__device__ __forceinline__ void s5_mfma(Frame& F, int l) {
    const bf16* Z1 = (const bf16*)(F.ws + WS_Z1); bf16* YS = (bf16*)(F.ws + WS_YS);
    LAS unsigned char* UIMG = F.lds + S5_UIMG; LAS unsigned char* HIMG = F.lds + S5_HIMG; LAS float* ETAB = (LAS float*)(F.lds + S5_ETAB);
    const int tid = F.tid, lane = F.lane, w = F.wave, r = lane & 31, h = lane >> 5;
    for (int item = (F.wg >= 128 ? (F.wg - 128) * 4 : 0); item < (F.wg >= 128 ? (F.wg - 128) * 4 + 4 : 0); ++item) {
        const int b = item >> 5, g = item & 31;
        const bf16* WsF = (const bf16*)(F.ws + WS_S5MAT) + ((size_t)l * 32 + g) * 196608; const bf16* W3F = WsF + 65536;
        __syncthreads();
        { u32x4 uv[8];
#pragma unroll
          for (int q = 0; q < 8; ++q) { const int p = tid + q * NTHREADS, token = p >> 1, half = p & 1; uv[q] = *(const u32x4*)(Z1 + ((size_t)b * SEQ + token) * ZC + COL_U + g * 16 + half * 8); }
#pragma unroll
          for (int q = 0; q < 8; ++q) { const int p = tid + q * NTHREADS, token = p >> 1, half = p & 1; *(LAS u32x4*)(UIMG + (token >> 4) * S5_CSTR + (token & 15) * 32 + half * 16) = uv[q]; } }
        { unsigned z = 0u; asm volatile("" : "+v"(z));
          if (tid < 16) *(LAS u32x4*)(HIMG + 1 * S5_CSTR + tid * 16) = (u32x4){z, z, z, z};
          else if (tid < 32) *(LAS u32x4*)(HIMG + 128 * S5_CSTR + 256 + (tid - 16) * 16) = (u32x4){z, z, z, z}; }
        __syncthreads();
        const int d = w >> 2, sh = (w >> 1) & 1, mh = w & 1;
        f32x16 sre[2], sim[2];
#pragma unroll
        for (int i = 0; i < 16; ++i) { sre[0][i] = 0.f; sre[1][i] = 0.f; sim[0][i] = 0.f; sim[1][i] = 0.f; }
        {
            const int qf = 16 * ((r >> 2) & 1) + 4 * (r >> 3) + (r & 3);
            const int qr = d ? 127 - (64 * mh + qf) : 64 * mh + qf;
            const bf16* bre = WsF + ((size_t)(((d * 2 + sh) * 2 + 0) * 16) * 64 + lane) * 8; const bf16* bim = bre + (size_t)16 * 64 * 8;
            const LAS unsigned char* a0 = UIMG + qr * S5_CSTR + 16 * h; const LAS unsigned char* a1 = UIMG + (d ? qr - 32 : qr + 32) * S5_CSTR + 16 * h;
#pragma unroll 8
            for (int ks = 0; ks < 16; ++ks) {
                const bf16x8 vre = *(const bf16x8*)(bre + ks * 512), vim = *(const bf16x8*)(bim + ks * 512);
                const bf16x8 x0 = *(const LAS bf16x8*)(a0 + ks * 32), x1 = *(const LAS bf16x8*)(a1 + ks * 32);
                sre[0] = MFMA32(x0, vre, sre[0]); sim[0] = MFMA32(x0, vim, sim[0]); sre[1] = MFMA32(x1, vre, sre[1]); sim[1] = MFMA32(x1, vim, sim[1]);
            }
        }
        __builtin_amdgcn_sched_barrier(0);
        asm volatile("s_nop 15\n\ts_nop 15\n\ts_nop 15\n\ts_nop 15\n\ts_nop 15" : "+v"(sre[0]), "+v"(sre[1]), "+v"(sim[0]), "+v"(sim[1]));
        __builtin_amdgcn_sched_barrier(0);

        const int n = sh * 32 + r;
        const f32x4 lam = *(const f32x4*)((const float*)(F.ws + WS_S5LAM) + ((((size_t)l * 32 + g) * 2 + d) * 64 + n) * 4);
        LAS float* et = ETAB + ((d * 2 + sh) * 8) * 64 + r * 2;
        const int sg0 = 4 * mh + h, sg1 = sg0 + 2;
        s5_scan_a(sre[0], sim[0], lam[0], lam[1], et + sg0 * 64); s5_scan_a(sre[1], sim[1], lam[0], lam[1], et + sg1 * 64);
        __syncthreads();
        {
            const int cs0 = 16 * sg0, cs1 = 16 * sg1, hstep = d ? -S5_CSTR : S5_CSTR;
            LAS unsigned char* hcol = HIMG + d * 256 + 4 * n;
            s5_scan_b(sre[0], sim[0], lam[0], lam[1], lam[2], lam[3], et, sg0, hcol + (d ? 127 - cs0 : cs0 + 2) * S5_CSTR, hstep);
            s5_scan_b(sre[1], sim[1], lam[0], lam[1], lam[2], lam[3], et, sg1, hcol + (d ? 127 - cs1 : cs1 + 2) * S5_CSTR, hstep);
        }
        __syncthreads();
        f32x16 acc[4];
#pragma unroll
        for (int nt = 0; nt < 4; ++nt)
#pragma unroll
            for (int i = 0; i < 16; ++i) acc[nt][i] = 0.f;
        {
            const bf16* ap = W3F + ((size_t)(w * 32) * 64 + lane) * 8;
            unsigned bxa[4], bha[4];
#pragma unroll
            for (int nt = 0; nt < 4; ++nt) { bxa[nt] = (unsigned)(S5_UIMG + (nt * 32 + r) * S5_CSTR + 16 * h); bha[nt] = (unsigned)(S5_HIMG + (nt * 32 + r + 1) * S5_CSTR + 16 * h); }
#pragma unroll 8
            for (int ks = 0; ks < 16; ++ks) { const bf16x8 a = *(const bf16x8*)(ap + ks * 512);
#pragma unroll
                for (int nt = 0; nt < 4; ++nt) { const bf16x8 x = *(const LAS bf16x8*)(F.lds + bxa[nt] + ks * 32); acc[nt] = MFMA32(a, x, acc[nt]); } }
#pragma unroll 8
            for (int ks = 0; ks < 16; ++ks) { const bf16x8 a = *(const bf16x8*)(ap + (16 + ks) * 512);
#pragma unroll
                for (int nt = 0; nt < 4; ++nt) { const bf16x8 x = *(const LAS bf16x8*)(F.lds + bha[nt] + ks * 32); acc[nt] = MFMA32(a, x, acc[nt]); } }
            asm volatile("" :: "v"(bxa[0]), "v"(bxa[1]), "v"(bxa[2]), "v"(bxa[3]), "v"(bha[0]), "v"(bha[1]), "v"(bha[2]), "v"(bha[3]));
        }
        __builtin_amdgcn_sched_barrier(0);
        asm volatile("s_nop 15\n\ts_nop 15\n\ts_nop 15\n\ts_nop 15\n\ts_nop 15" : "+v"(acc[0]), "+v"(acc[1]), "+v"(acc[2]), "+v"(acc[3]));
        __builtin_amdgcn_sched_barrier(0);
#pragma unroll
        for (int nt = 0; nt < 4; ++nt)
#pragma unroll
            for (int gq = 0; gq < 4; ++gq) { const int tau = 2 * w + (gq >> 1), cp = 8 * (gq & 1) + 4 * h, token = (32 * nt + r) * 16 + tau;
                u32x2 o; o.x = pk2hw(gelu_tanh(acc[nt][4 * gq]), gelu_tanh(acc[nt][4 * gq + 1])); o.y = pk2hw(gelu_tanh(acc[nt][4 * gq + 2]), gelu_tanh(acc[nt][4 * gq + 3]));
                *(u32x2*)(YS + ((size_t)b * SEQ + token) * BW + g * 16 + cp) = o; }
    }
    __syncthreads();
}


#define MFMA_FENCE3(a, b, c) asm volatile("s_nop 15\n\ts_nop 15\n\ts_nop 15\n\ts_nop 15\n\ts_nop 15" : "+v"(a), "+v"(b), "+v"(c))
__device__ __forceinline__ void lru_half_scan(f32x16& aR, f32x16& aI, const f32x16& aX, float br, float bi, float lamc, LAS float* sgw) {
    float Pp = 1.f, Hh = 0.f;
#pragma unroll
    for (int i = 0; i < 16; ++i) {
        const float rg = sigmoidf_(aR[i] + br), ig = sigmoidf_(aI[i] + bi), x2 = 2.0f * lamc * rg;
        const float a = __builtin_amdgcn_exp2f(0.72134752044f * x2);
        const float om = -x2 * (1.0f + x2 * (0.5f + x2 * (0.16666667f + x2 * (0.041666668f + x2 * (0.008333334f + x2 * 0.0013888889f)))));
        const float u = __builtin_amdgcn_sqrtf(fmaxf(om, 0.f)) * ig * aX[i];
        Hh = a * Hh + u; Pp = a * Pp; aR[i] = Hh; aI[i] = Pp;
        if ((i & 3) == 3) asm volatile("" : "+v"(Hh), "+v"(Pp));
    }
    sgw[0] = Pp; sgw[1] = Hh;
}
constexpr int LRU_TILE = 16384, LRU_TILE_BYTES = 33 * 1024;
__device__ __forceinline__ void lru_mfma(Frame& F, int l) {
    const bf16* Z1 = (const bf16*)(F.ws + WS_Z1); bf16* OL = (bf16*)(F.ws + WS_OL);
    LAS float* CW = (LAS float*)F.lds;
    LAS float* SEG = CW + 320;
    const int tid = F.tid, lane = F.lane, w = F.wave, r = lane & 31, hh = lane >> 5;
    for (int item = F.wg; item < (F.wg < 128 ? BATCH * 8 : 0); item += 128) {
        const int b = item >> 3, hb = item & 7, ch0 = hb * 64 + r;
        __syncthreads();
        if (tid < 256) CW[tid] = F.in[I_CONVW][((size_t)l * 4 + (tid >> 6)) * BW + hb * 64 + (tid & 63)];
        else if (tid < 320) CW[tid] = F.in[I_CONVB][l * BW + hb * 64 + (tid - 256)];
        const int qf = 16 * ((r >> 2) & 1) + 4 * (r >> 3) + (r & 3);
        const bf16* xrb = Z1 + (size_t)b * SEQ * ZC + COL_XR + hb * 64 + (lane & 7) * 8;
#pragma unroll 1
        for (int dir = 0; dir < 2; ++dir) {
            bf16x8 wr[2][4], wi[2][4];
#pragma unroll
            for (int nh = 0; nh < 2; ++nh) { const bf16* lf = (const bf16*)(F.ws + WS_LRUF) + ((((((size_t)l * 2 + dir) * 8 + hb) * 2 + nh) * 2) * 4 * 64 + lane) * 8;
#pragma unroll
              for (int ks = 0; ks < 4; ++ks) { wr[nh][ks] = *(const bf16x8*)(lf + (size_t)ks * 512); wi[nh][ks] = *(const bf16x8*)(lf + (size_t)(4 + ks) * 512); } }
            float br[2], bi[2], lamc[2], carry[2] = {0.f, 0.f};
#pragma unroll
            for (int nh = 0; nh < 2; ++nh) { const int ch = ch0 + 32 * nh; br[nh] = F.in[I_LBR][((size_t)l * 2 + dir) * BW + ch]; bi[nh] = F.in[I_LBI][((size_t)l * 2 + dir) * BW + ch];
                lamc[nh] = -8.0f * log1pf(expf(-F.in[I_LAM][((size_t)l * 2 + dir) * BW + ch])); }
#define LRU_STAGE(SC) do { const int tlo_ = dir ? SEQ - 256 * ((SC) + 1) : 256 * (SC); \
                for (int j_ = w; j_ < 33; j_ += NWAVES) { int t_ = tlo_ - 2 + 8 * j_ + (lane >> 3); t_ = t_ < 0 ? 0 : (t_ >= SEQ ? SEQ - 1 : t_); \
                    __builtin_amdgcn_global_load_lds((const unsigned*)(xrb + (size_t)t_ * ZC), (LAS unsigned*)(F.lds + LRU_TILE + ((SC) & 1) * LRU_TILE_BYTES + j_ * 1024), 16, 0, 0); } } while (0)
            LRU_STAGE(0);
#pragma unroll 1
            for (int sc = 0; sc < 8; ++sc) {
                asm volatile("s_waitcnt vmcnt(0)" ::: "memory"); __syncthreads();
                if (sc + 1 < 8) LRU_STAGE(sc + 1);
                const int srow = sc * 256 + w * 32 + qf, trow = dir ? (SEQ - 1 - srow) : srow, tlo = dir ? SEQ - 256 * (sc + 1) : 256 * sc;
                const LAS unsigned char* tl = F.lds + LRU_TILE + (sc & 1) * LRU_TILE_BYTES + (trow - tlo) * 128 + 16 * hh;
                bf16x8 av[4];
#pragma unroll
                for (int ks = 0; ks < 4; ++ks) {
                    const int c0 = 16 * ks + 8 * hh;
                    float xv[8];
#pragma unroll
                    for (int j = 0; j < 8; ++j) xv[j] = CW[256 + c0 + j];
#pragma unroll
                    for (int tap = 0; tap < 4; ++tap) { const int tt = trow + tap - 2; const float msk = (tt >= 0 && tt < SEQ) ? 1.0f : 0.0f;
                        const bf16x8 v = *(const LAS bf16x8*)(tl + tap * 128 + ks * 32);
#pragma unroll
                        for (int j = 0; j < 8; ++j) xv[j] += (CW[tap * 64 + c0 + j] * msk) * bf2f((bf16)v[j]); }
                    u32x4 pa; pa.x = pk2hw(xv[0], xv[1]); pa.y = pk2hw(xv[2], xv[3]); pa.z = pk2hw(xv[4], xv[5]); pa.w = pk2hw(xv[6], xv[7]);
                    av[ks] = __builtin_bit_cast(bf16x8, pa);
                }
                const int st0 = sc * 256 + w * 32 + 16 * hh; const size_t tok0 = (size_t)b * SEQ + (dir ? (SEQ - 1 - st0) : st0); const long tstep = dir ? -1 : 1;
#pragma unroll
                for (int nh = 0; nh < 2; ++nh) {
                    const int ch = ch0 + 32 * nh;
                    f32x16 aR, aI, aX;
#pragma unroll
                    for (int i = 0; i < 16; ++i) { aR[i] = 0.f; aI[i] = 0.f; aX[i] = 0.f; }
                    bf16x8 idf[4];
#pragma unroll
                    for (int ks = 0; ks < 4; ++ks) { u32x4 pd_;
#pragma unroll
                        for (int jj = 0; jj < 4; ++jj) { const int k0 = 16 * ks + 8 * hh + 2 * jj; pd_[jj] = (k0 == nh * 32 + r ? 0x3f80u : 0u) | (k0 + 1 == nh * 32 + r ? 0x3f800000u : 0u); }
                        idf[ks] = __builtin_bit_cast(bf16x8, pd_); }
                    __builtin_amdgcn_sched_barrier(0);
#pragma unroll
                    for (int ks = 0; ks < 4; ++ks) { aR = MFMA32(av[ks], wr[nh][ks], aR); aI = MFMA32(av[ks], wi[nh][ks], aI); aX = MFMA32(av[ks], idf[ks], aX); }
                    __builtin_amdgcn_sched_barrier(0);
                    MFMA_FENCE3(aR, aI, aX);
                    __builtin_amdgcn_sched_barrier(0);
                    bf16 hfv[16], grv[16];
                    if (dir) {
#pragma unroll
                        for (int i = 0; i < 16; ++i) { const size_t tok = tok0 + tstep * i; hfv[i] = OL[tok * BW + ch]; grv[i] = Z1[tok * ZC + COL_GR + ch]; }
                    }
                    LAS float* sg = SEG + nh * 1024;
                    lru_half_scan(aR, aI, aX, br[nh], bi[nh], lamc[nh], sg + ((2 * w + hh) * 32 + r) * 2);
                    __syncthreads();
                    float cin = 0.f, X = carry[nh];
#pragma unroll
                    for (int sp = 0; sp < 16; ++sp) { cin = (sp == 2 * w + hh) ? X : cin; X = sg[(sp * 32 + r) * 2] * X + sg[(sp * 32 + r) * 2 + 1]; }
                    carry[nh] = X;
                    if (dir == 0) {
#pragma unroll
                        for (int i = 0; i < 16; i += 2) { const unsigned p = pk2hw(aR[i] + aI[i] * cin, aR[i + 1] + aI[i + 1] * cin);
                            OL[(tok0 + tstep * i) * BW + ch] = (bf16)(p & 0xffffu); OL[(tok0 + tstep * (i + 1)) * BW + ch] = (bf16)(p >> 16); }
                    } else {
#pragma unroll
                        for (int i = 0; i < 16; i += 2) { const unsigned p = pk2hw(gelu_tanh(bf2f(grv[i])) * (bf2f(hfv[i]) + aR[i] + aI[i] * cin), gelu_tanh(bf2f(grv[i + 1])) * (bf2f(hfv[i + 1]) + aR[i + 1] + aI[i + 1] * cin));
                            OL[(tok0 + tstep * i) * BW + ch] = (bf16)(p & 0xffffu); OL[(tok0 + tstep * (i + 1)) * BW + ch] = (bf16)(p >> 16); }
                    }
                }
            }
            asm volatile("s_waitcnt vmcnt(0)" ::: "memory"); __syncthreads();
        }
    }
    __syncthreads();
}

#ifndef ATT_LO
#define ATT_LO 2
#endif
constexpr int AT_KSTR = 144, AT_VSTR = 776, AT_K = 0, AT_V = 384 * AT_KSTR;
__device__ __forceinline__ void attn_mfma(Frame& F, int l) {
    const bf16* Z1 = (const bf16*)(F.ws + WS_Z1); bf16* OA = (bf16*)(F.ws + WS_OA);
    LAS unsigned char* KL = F.lds + AT_K; LAS unsigned char* VT = F.lds + AT_V;
    const int tid = F.tid, lane = F.lane, w = F.wave, r = lane & 31, hh = lane >> 5;
    const float LOG2E = 1.4426950408889634f;
    for (int k = 0; k < (F.wg < 128 ? ATT_LO : 4 - ATT_LO); ++k) {
        const int item = F.wg < 128 ? F.wg * ATT_LO + k : 128 * ATT_LO + (F.wg - 128) * (4 - ATT_LO) + k;
        const int b = item >> 5, nb = (item >> 1) & 15, kvh = item & 1;
        __syncthreads();
        { u32x4 kq[6], vq[6];
#pragma unroll
          for (int q = 0; q < 6; ++q) { const int p = tid + q * NTHREADS, kj = p >> 3, dc = p & 7, sp = nb * 128 - 128 + kj; const bool ok = (sp >= 0 && sp < SEQ);
              const bf16* base = Z1 + ((size_t)b * SEQ + (ok ? sp : 0)) * ZC + kvh * 64 + dc * 8; kq[q] = *(const u32x4*)(base + COL_K); vq[q] = *(const u32x4*)(base + COL_V);
              if (!ok) { kq[q] = (u32x4){0u, 0u, 0u, 0u}; vq[q] = (u32x4){0u, 0u, 0u, 0u}; } }
#pragma unroll
          for (int q = 0; q < 6; ++q) { const int p = tid + q * NTHREADS, kj = p >> 3, dc = p & 7; const u32x4 vv = vq[q];
              *(LAS u32x4*)(KL + kj * AT_KSTR + dc * 16) = kq[q];
              LAS bf16* vt = (LAS bf16*)(VT + (dc * 8) * AT_VSTR + kj * 2);
              vt[0 * (AT_VSTR / 2)] = (bf16)(vv.x & 0xffffu); vt[1 * (AT_VSTR / 2)] = (bf16)(vv.x >> 16); vt[2 * (AT_VSTR / 2)] = (bf16)(vv.y & 0xffffu); vt[3 * (AT_VSTR / 2)] = (bf16)(vv.y >> 16);
              vt[4 * (AT_VSTR / 2)] = (bf16)(vv.z & 0xffffu); vt[5 * (AT_VSTR / 2)] = (bf16)(vv.z >> 16); vt[6 * (AT_VSTR / 2)] = (bf16)(vv.w & 0xffffu); vt[7 * (AT_VSTR / 2)] = (bf16)(vv.w >> 16); } }
        __syncthreads();
#pragma unroll 1
        for (int task = w; task < 16; task += NWAVES) {
            const int g = task >> 2, qt = task & 3, hq = kvh * 4 + g;
            const size_t tokq = (size_t)b * SEQ + nb * 128 + 32 * qt + r;
            bf16x8 qf[4];
#pragma unroll
            for (int ks = 0; ks < 4; ++ks) qf[ks] = *(const bf16x8*)(Z1 + tokq * ZC + COL_Q + hq * 64 + 16 * ks + 8 * hh);
            const float slope2 = exp2f(-(float)(hq + 1)) * LOG2E, sink2 = F.in[I_SINK][l * NQ + hq] * LOG2E;
            float m = sink2, lsum = 1.0f;
            f32x16 o0, o1;
#pragma unroll
            for (int i = 0; i < 16; ++i) { o0[i] = 0.f; o1[i] = 0.f; }
            u32x4 pp0 = (u32x4){0u, 0u, 0u, 0u}, pp1 = pp0, va0 = pp0, va1 = pp0, va2 = pp0, va3 = pp0;
#pragma unroll 1
            for (int kt = qt; kt < qt + 9; ++kt) {
                f32x16 sc;
#pragma unroll
                for (int i = 0; i < 16; ++i) sc[i] = 0.f;
                { const LAS unsigned char* kp = KL + (32 * kt + r) * AT_KSTR + 16 * hh;
#pragma unroll
                  for (int ks = 0; ks < 4; ++ks) { const bf16x8 a = *(const LAS bf16x8*)(kp + ks * 32); sc = MFMA32(a, qf[ks], sc); } }
                __builtin_amdgcn_sched_barrier(0);
                asm volatile("s_nop 15\n\ts_nop 15\n\ts_nop 15\n\ts_nop 15\n\ts_nop 15" : "+v"(sc), "+v"(o0), "+v"(o1), "+v"(pp0), "+v"(pp1), "+v"(va0), "+v"(va1), "+v"(va2), "+v"(va3));
                __builtin_amdgcn_sched_barrier(0);
                const float fd0 = (float)(128 + 32 * qt + r - 32 * kt - 4 * hh);
                const bool inwin = (kt > qt) && (kt < qt + 8), inseq = (nb * 128 - 128 + 32 * kt >= 0) && (nb * 128 - 128 + 32 * kt + 31 < SEQ);
                float tmax = -1e30f;
                if (inwin && inseq) {
#pragma unroll
                    for (int i = 0; i < 16; ++i) { const float dd = fd0 - (float)((i & 3) + 8 * (i >> 2)); const float v = sc[i] * (0.125f * LOG2E) - slope2 * __builtin_fabsf(dd); sc[i] = v; tmax = fmaxf(tmax, v); }
                } else {
#pragma unroll
                    for (int i = 0; i < 16; ++i) { const int kj = 32 * kt + (i & 3) + 8 * (i >> 2) + 4 * hh, sp = nb * 128 - 128 + kj; const float dd = fd0 - (float)((i & 3) + 8 * (i >> 2)), ad = __builtin_fabsf(dd);
                        const bool valid = (ad <= (float)WIN) && (sp >= 0) && (sp < SEQ);
                        const float v = valid ? (sc[i] * (0.125f * LOG2E) - slope2 * ad) : -1e30f; sc[i] = v; tmax = fmaxf(tmax, v); }
                }
                { const auto sw = __builtin_amdgcn_permlane32_swap(__float_as_uint(tmax), __float_as_uint(tmax), false, false); tmax = fmaxf(__uint_as_float(sw[0]), __uint_as_float(sw[1])); }
                const float mnew = fmaxf(m, tmax), alpha = __builtin_amdgcn_exp2f(m - mnew); m = mnew;
                float psum = 0.f;
#pragma unroll
                for (int i = 0; i < 16; ++i) { const float p = __builtin_amdgcn_exp2f(sc[i] - mnew); sc[i] = p; psum += p; }
                { const auto sw = __builtin_amdgcn_permlane32_swap(__float_as_uint(psum), __float_as_uint(psum), false, false); psum = __uint_as_float(sw[0]) + __uint_as_float(sw[1]); }
                lsum = lsum * alpha + psum;
#pragma unroll
                for (int i = 0; i < 16; ++i) { o0[i] *= alpha; o1[i] *= alpha; }
                pp0.x = pk2hw(sc[0], sc[1]); pp0.y = pk2hw(sc[2], sc[3]); pp0.z = pk2hw(sc[4], sc[5]); pp0.w = pk2hw(sc[6], sc[7]);
                pp1.x = pk2hw(sc[8], sc[9]); pp1.y = pk2hw(sc[10], sc[11]); pp1.z = pk2hw(sc[12], sc[13]); pp1.w = pk2hw(sc[14], sc[15]);
                {   const LAS unsigned char* vp = VT + r * AT_VSTR + (32 * kt + 4 * hh) * 2;
#define AT_LDV(dst, off) do { const u32x2 lo_ = *(const LAS u32x2*)(vp + (off)), hi_ = *(const LAS u32x2*)(vp + (off) + 16); dst.x = lo_.x; dst.y = lo_.y; dst.z = hi_.x; dst.w = hi_.y; } while (0)
                    AT_LDV(va0, 0); AT_LDV(va1, 32 * AT_VSTR); AT_LDV(va2, 32); AT_LDV(va3, 32 * AT_VSTR + 32);
#undef AT_LDV
                    o0 = MFMA32(__builtin_bit_cast(bf16x8, va0), __builtin_bit_cast(bf16x8, pp0), o0); o1 = MFMA32(__builtin_bit_cast(bf16x8, va1), __builtin_bit_cast(bf16x8, pp0), o1);
                    o0 = MFMA32(__builtin_bit_cast(bf16x8, va2), __builtin_bit_cast(bf16x8, pp1), o0); o1 = MFMA32(__builtin_bit_cast(bf16x8, va3), __builtin_bit_cast(bf16x8, pp1), o1); }
            }
            __builtin_amdgcn_sched_barrier(0);
            asm volatile("s_nop 15\n\ts_nop 15\n\ts_nop 15\n\ts_nop 15\n\ts_nop 15" : "+v"(o0), "+v"(o1), "+v"(pp0), "+v"(pp1), "+v"(va0), "+v"(va1), "+v"(va2), "+v"(va3));
            __builtin_amdgcn_sched_barrier(0);
            const float inv = 1.0f / lsum;
            bf16* op = OA + tokq * BW + hq * 64 + 4 * hh;
#pragma unroll
            for (int gq = 0; gq < 4; ++gq) {
                u32x2 w0, w1; w0.x = pk2hw(o0[4 * gq] * inv, o0[4 * gq + 1] * inv); w0.y = pk2hw(o0[4 * gq + 2] * inv, o0[4 * gq + 3] * inv);
                w1.x = pk2hw(o1[4 * gq] * inv, o1[4 * gq + 1] * inv); w1.y = pk2hw(o1[4 * gq + 2] * inv, o1[4 * gq + 3] * inv);
                *(u32x2*)(op + 8 * gq) = w0; *(u32x2*)(op + 32 + 8 * gq) = w1; }
        }
    }
    __syncthreads();
}

__device__ __forceinline__ void p4a_router(Frame& F, int l) {
    LAS float* wl = (LAS float*)F.lds;
    LAS int* bk = (LAS int*)(F.lds + 81920);
    const float* wrt = (const float*)(F.ws + WS_WRT) + (size_t)l * 20 * D;
    for (int i = F.tid; i < 20 * D / 4; i += NTHREADS) ((LAS f32x4*)wl)[i] = ((const f32x4*)wrt)[i];
    __syncthreads();
    const float* X = F.out; float* rinv2 = (float*)(F.ws + WS_RINV2); int* BUCKET = (int*)(F.ws + WS_BUCKET); float* WTOK = (float*)(F.ws + WS_WTOK);
    const int lane = F.lane, tok0 = F.wg * 128 + F.wave * 16;
    float lgv[20], ssv = 0.f;
#pragma unroll
    for (int o = 0; o < 20; ++o) lgv[o] = 0.f;
#pragma unroll 1
    for (int q = 0; q < 8; ++q) {
        f32x4 xv[2][4];
#pragma unroll
        for (int a = 0; a < 2; ++a) { const f32x4* xr = (const f32x4*)(X + (size_t)(tok0 + q * 2 + a) * D) + lane;
#pragma unroll
            for (int j = 0; j < 4; ++j) xv[a][j] = xr[64 * j]; }
#pragma unroll
        for (int a = 0; a < 2; ++a) { float s = 0.f;
#pragma unroll
            for (int j = 0; j < 4; ++j) s += (xv[a][j].x * xv[a][j].x + xv[a][j].y * xv[a][j].y) + (xv[a][j].z * xv[a][j].z + xv[a][j].w * xv[a][j].w);
            const float t = wave_sum(s, lane); ssv = (lane == q * 2 + a) ? t : ssv; }
#pragma unroll
        for (int o = 0; o < 20; ++o) {
            f32x4 w[4];
#pragma unroll
            for (int j = 0; j < 4; ++j) w[j] = ((const LAS f32x4*)(wl + o * D))[lane + 64 * j];
#pragma unroll
            for (int a = 0; a < 2; ++a) { float s = 0.f;
#pragma unroll
                for (int j = 0; j < 4; ++j) s += (xv[a][j].x * w[j].x + xv[a][j].y * w[j].y) + (xv[a][j].z * w[j].z + xv[a][j].w * w[j].w);
                const float t = wave_sum(s, lane); lgv[o] = (lane == q * 2 + a) ? t : lgv[o]; }
            if (o & 1) asm volatile("" ::: "memory");
        }
    }
    {
        const int tok = tok0 + (lane & 15); const float ri = 1.0f / sqrtf(ssv * (1.0f / D) + NORM_EPS);
        float gl[4]; int gi = 0; float gm;
#pragma unroll
        for (int j = 0; j < 4; ++j) gl[j] = lgv[j] * ri + F.in[I_BG][l * 4 + j];
        gm = gl[0];
#pragma unroll
        for (int j = 1; j < 4; ++j) if (gl[j] > gm) { gm = gl[j]; gi = j; }
        float gs = 0.f;
#pragma unroll
        for (int j = 0; j < 4; ++j) gs += expf(gl[j] - gm);
        const float gw = 1.0f / gs;
        float el[4];
#pragma unroll
        for (int e = 0; e < 4; ++e) { float v = 0.f;
#pragma unroll
            for (int g = 0; g < 4; ++g) v = (gi == g) ? (lgv[4 + g * 4 + e] * ri + F.in[I_BE][l * 16 + g * 4 + e]) : v;
            el[e] = v; }
        int i1 = 0; float v1 = el[0];
#pragma unroll
        for (int e = 1; e < 4; ++e) if (el[e] > v1) { v1 = el[e]; i1 = e; }
        int i2 = -1; float v2 = -3.4e38f;
#pragma unroll
        for (int e = 0; e < 4; ++e) if (e != i1 && el[e] > v2) { v2 = el[e]; i2 = e; }
        const float e2 = expf(v2 - v1), w1 = gw / (1.0f + e2), w2 = gw * e2 / (1.0f + e2);
        const int ea = i1 < i2 ? i1 : i2, eb = i1 < i2 ? i2 : i1; const float wa = i1 < i2 ? w1 : w2, wb = i1 < i2 ? w2 : w1;
        const int bucket = gi * 6 + pair_index(ea, eb);
        if (lane < 16) { rinv2[tok] = ri; BUCKET[tok] = bucket; WTOK[2 * tok] = wa; WTOK[2 * tok + 1] = wb; bk[F.wave * 16 + lane] = bucket; }
    }
    __syncthreads();
    if (F.tid < 128) { const int b = bk[F.tid]; int r = 0; for (int i = 0; i < F.tid; ++i) r += (bk[i] == b) ? 1 : 0; ((int*)(F.ws + WS_RANK))[F.wg * 128 + F.tid] = r; }
    if (F.tid >= 128 && F.tid < 128 + 32) { const int b = F.tid - 128; int c = 0; if (b < NBUCKET) for (int i = 0; i < 128; ++i) c += (bk[i] == b) ? 1 : 0; ((int*)(F.ws + WS_HIST))[F.wg * 32 + b] = c; }
    __syncthreads();
}

__device__ __forceinline__ void p4b_positions(Frame& F) {
    LAS int* tot = (LAS int*)F.lds; LAS int* pre = tot + 32; LAS int* base = tot + 64;
    const int* HIST = (const int*)(F.ws + WS_HIST);
    if (F.tid < NBUCKET) { int t = 0, p = 0; for (int w = 0; w < 256; ++w) { const int h = HIST[w * 32 + F.tid]; if (w < F.wg) p += h; t += h; } tot[F.tid] = t; pre[F.tid] = p; }
    __syncthreads();
    if (F.tid == 0) { int a = 0; for (int b = 0; b < NBUCKET; ++b) { base[b] = a; a += (tot[b] + 255) & ~255; } base[NBUCKET] = a; }
    __syncthreads();
    int* IDX = (int*)(F.ws + WS_IDX); float* WSORT = (float*)(F.ws + WS_WSORT); float* RSORT = (float*)(F.ws + WS_RSORT); const float* WTOK = (const float*)(F.ws + WS_WTOK);
    if (F.tid < 128) { const int tok = F.wg * 128 + F.tid; const int b = ((const int*)(F.ws + WS_BUCKET))[tok]; const int pos = base[b] + pre[b] + ((const int*)(F.ws + WS_RANK))[tok];
        IDX[pos] = tok; *(u32x2*)(WSORT + 2 * pos) = (u32x2){__float_as_uint(WTOK[2 * tok]), __float_as_uint(WTOK[2 * tok + 1])}; RSORT[pos] = ((const float*)(F.ws + WS_RINV2))[tok]; }
    if (F.wg == 0) {
        float z = 0.f; asm volatile("" : "+v"(z));
        for (int b = 0; b < NBUCKET; ++b) for (int p = base[b] + tot[b] + F.tid; p < base[b + 1]; p += NTHREADS) { IDX[p] = -1; WSORT[2 * p] = z; WSORT[2 * p + 1] = z; RSORT[p] = z; }
        if (F.tid <= NBUCKET) ((int*)(F.ws + WS_BBASE))[F.tid] = base[F.tid];
    }
    __syncthreads();
}

__device__ __forceinline__ int build_tile_table(Frame& F, LAS int* tb) {
    const int* BB = (const int*)(F.ws + WS_BBASE);
    if (F.tid < 160) { const int r0 = F.tid * 256; int bkt = -1; for (int b = 0; b < NBUCKET; ++b) if (r0 >= BB[b] && r0 < BB[b + 1]) bkt = b; tb[1 + F.tid] = bkt; }
    if (F.tid == 0) tb[0] = BB[NBUCKET] / 256;
    __syncthreads();
    return tb[0];
}

typedef f32x4 AccT[2][2][4][2];
struct EpiZ1 { bf16* Z1; const float* rinv;
    __device__ __forceinline__ bool operator()(const AccT& acc, const pg8::Unit& u, int wr, int wc, int fr, int fq) const {
        asm volatile("" : "+v"(fr), "+v"(fq));
#pragma unroll
        for (int ai = 0; ai < 2; ++ai)
#pragma unroll
            for (int m = 0; m < 4; ++m) { const int row = u.pm * 256 + ai * 128 + wr * 64 + m * 16 + fr; const float ri = rinv[row]; bf16* rowp = Z1 + (size_t)row * ZC + u.pn * 256 + wc * 32 + 8 * fq;
#pragma unroll
                for (int bj = 0; bj < 2; ++bj) *(u32x4*)(rowp + bj * 128) = pack8(acc[ai][bj][m][0] * ri, acc[ai][bj][m][1] * ri); }
        return false; } };
__device__ __forceinline__ void p1_inproj_pg8(Frame& F, int l) {
    DenseSched S{(const char*)(F.ws + WS_XB), (const char*)(F.ws + WS_WINT) + (size_t)l * IN_COLS * D * 2, M / 256, ZC / 256, F.G, F.wg, D / 64, D * 2, D * 2};
    EpiZ1 E{(bf16*)(F.ws + WS_Z1), (const float*)(F.ws + WS_RINV1)};
    pg8::gemm_phase<EpiZ1, DenseSched, true, 0>(F.lds, S, E, F.tid);
    if (P0_LAYERS < DEPTH && l == 0 && F.wg >= 128) p0_weights(F, P0_LAYERS, DEPTH, (F.wg - 128) * NWAVES + F.wave, 128 * NWAVES);
}
struct EpiGlu { bf16* OS; const float* bg;
    __device__ __forceinline__ bool operator()(const AccT& acc, const pg8::Unit& u, int wr, int wc, int fr, int fq) const {
        asm volatile("" : "+v"(fr), "+v"(fq));
        const int col = u.pn * 128 + wc * 32 + 8 * fq;
        f32x4 bv[2], bgt[2];
#pragma unroll
        for (int n = 0; n < 2; ++n) { bv[n] = *(const f32x4*)(bg + col + 4 * n); bgt[n] = *(const f32x4*)(bg + 512 + col + 4 * n); }
#pragma unroll
        for (int ai = 0; ai < 2; ++ai)
#pragma unroll
            for (int m = 0; m < 4; ++m) { const int row = u.pm * 256 + ai * 128 + wr * 64 + m * 16 + fr; f32x4 o[2];
#pragma unroll
                for (int n = 0; n < 2; ++n) { const f32x4 v = acc[ai][0][m][n] + bv[n], g = acc[ai][1][m][n] + bgt[n];
#pragma unroll
                    for (int j = 0; j < 4; ++j) o[n][j] = v[j] * sigmoidf_(g[j]); }
                *(u32x4*)(OS + (size_t)row * BW + col) = pack8(o[0], o[1]); }
        return false; } };
__device__ __forceinline__ void p3a_glu_pg8(Frame& F, int l) {
    DenseSched S{(const char*)(F.ws + WS_YS), (const char*)(F.ws + WS_WGLUT) + (size_t)l * 1024 * BW * 2, M / 256, 4, F.G, F.wg, BW / 64, BW * 2, BW * 2};
    EpiGlu E{(bf16*)(F.ws + WS_OS), F.in[I_BGLU] + l * 1024};
    pg8::gemm_phase<EpiGlu, DenseSched, true, 0>(F.lds, S, E, F.tid);
}
struct EpiOut { const float* xin; float* X; bf16* XB;
    __device__ __forceinline__ bool operator()(const AccT& acc, const pg8::Unit& u, int wr, int wc, int fr, int fq) const {
        asm volatile("" : "+v"(fr), "+v"(fq));
#pragma unroll
        for (int ai = 0; ai < 2; ++ai) {
#pragma unroll
            for (int mp = 0; mp < 2; ++mp) {
                f32x4 xv[2][2][2];
#pragma unroll
                for (int mm = 0; mm < 2; ++mm) { const size_t row = u.pm * 256 + ai * 128 + wr * 64 + (2 * mp + mm) * 16 + fr;
#pragma unroll
                    for (int bj = 0; bj < 2; ++bj) { const size_t o = row * D + u.pn * 256 + bj * 128 + wc * 32 + 8 * fq; xv[mm][bj][0] = *(const f32x4*)(xin + o); xv[mm][bj][1] = *(const f32x4*)(xin + o + 4); } }
#pragma unroll
                for (int mm = 0; mm < 2; ++mm) { const int m = 2 * mp + mm; const size_t row = u.pm * 256 + ai * 128 + wr * 64 + m * 16 + fr;
#pragma unroll
                    for (int bj = 0; bj < 2; ++bj) { const size_t o = row * D + u.pn * 256 + bj * 128 + wc * 32 + 8 * fq;
                        const f32x4 v0 = xv[mm][bj][0] + acc[ai][bj][m][0], v1 = xv[mm][bj][1] + acc[ai][bj][m][1];
                        *(f32x4*)(X + o) = v0; *(f32x4*)(X + o + 4) = v1; *(u32x4*)(XB + o) = pack8(v0, v1); } }
                asm volatile("" ::: "memory"); } }
        return false; } };
__device__ __forceinline__ void p3c_outproj_pg8(Frame& F, int l) {
    DenseSched S{(const char*)(F.ws + WS_MIXED), (const char*)(F.ws + WS_WOUTT) + (size_t)l * D * D * 2, M / 256, 4, F.G, F.wg, D / 64, D * 2, D * 2};
    EpiOut E{(l == 0) ? F.in[I_X] : F.out, F.out, (bf16*)(F.ws + WS_XB)};
    pg8::gemm_phase<EpiOut, DenseSched, true, 0>(F.lds, S, E, F.tid);
}
struct MixSched { const char* XB; const char* WG; const char* WB; const char* ws; int G, c;
    __device__ __forceinline__ bool next(int i, pg8::Unit& u) const {
        const int sub = i % 6, L = (i / 6) * G + c; if (L >= 512) return false;
        pg8::static_tile(L, M / 256, 4, u.pm, u.pn); u.aux = sub; const int k = sub >> 1;
        if (!(sub & 1)) { u.A = XB + (size_t)u.pm * 256 * 2048; u.lda2 = 2048; u.nt = 16; u.B = WG + ((size_t)k * D + u.pn * 256) * 2048; u.ldb2 = 2048; }
        else { const char* br = ws + (k == 0 ? WS_OA : (k == 1 ? WS_OL : WS_OS)); u.A = br + (size_t)u.pm * 256 * 1024; u.lda2 = 1024; u.nt = 8; u.B = WB + ((size_t)k * D + u.pn * 256) * 1024; u.ldb2 = 1024; }
        return true; }
    __device__ __forceinline__ unsigned row_off(const pg8::Unit&, int) const { return 0u; }
};
struct EpiMix { u32x2* SIG; u32x4* MIXS; bf16* MX; const float* rinv;
    __device__ __forceinline__ bool operator()(const AccT& acc, const pg8::Unit& u, int wr, int wc, int fr, int fq) const {
        asm volatile("" : "+v"(fr), "+v"(fq));
        const int tid = (wr * 4 + wc) * 64 + fq * 16 + fr, sub = u.aux, k = sub >> 1;
        if (!(sub & 1)) {
            float ri[2][4];
#pragma unroll
            for (int ai = 0; ai < 2; ++ai)
#pragma unroll
                for (int m = 0; m < 4; ++m) ri[ai][m] = rinv[u.pm * 256 + ai * 128 + wr * 64 + m * 16 + fr];
#pragma unroll
            for (int ai = 0; ai < 2; ++ai)
#pragma unroll
                for (int m = 0; m < 4; ++m)
#pragma unroll
                    for (int bj = 0; bj < 2; ++bj) { unsigned q0 = 0u, q1 = 0u;
#pragma unroll
                        for (int j = 0; j < 4; ++j) { q0 |= (unsigned)__builtin_rintf(255.0f * sigmoidf_(acc[ai][bj][m][0][j] * ri[ai][m])) << (8 * j); q1 |= (unsigned)__builtin_rintf(255.0f * sigmoidf_(acc[ai][bj][m][1][j] * ri[ai][m])) << (8 * j); }
                        SIG[((ai * 4 + m) * 2 + bj) * 512 + tid] = (u32x2){q0, q1}; }
        } else {
#pragma unroll
            for (int ai = 0; ai < 2; ++ai)
#pragma unroll
            for (int mp = 0; mp < 2; ++mp) {
                u32x2 sv[2][2]; u32x4 mv[2][2];
#pragma unroll
                for (int mm = 0; mm < 2; ++mm)
#pragma unroll
                    for (int bj = 0; bj < 2; ++bj) { const int slot = ((ai * 4 + 2 * mp + mm) * 2 + bj) * 512 + tid; sv[mm][bj] = SIG[slot]; if (k > 0) mv[mm][bj] = MIXS[slot]; }
#pragma unroll
                for (int mm = 0; mm < 2; ++mm) { const int m = 2 * mp + mm; const size_t row = u.pm * 256 + ai * 128 + wr * 64 + m * 16 + fr;
#pragma unroll
                    for (int bj = 0; bj < 2; ++bj) { const int slot = ((ai * 4 + m) * 2 + bj) * 512 + tid; f32x4 s0, s1;
#pragma unroll
                        for (int j = 0; j < 4; ++j) { s0[j] = (float)((sv[mm][bj].x >> (8 * j)) & 255u) * (1.0f / 255.0f); s1[j] = (float)((sv[mm][bj].y >> (8 * j)) & 255u) * (1.0f / 255.0f); }
                        f32x4 v0 = acc[ai][bj][m][0] * s0, v1 = acc[ai][bj][m][1] * s1;
                        if (k > 0) { f32x4 p0, p1; unpack8(mv[mm][bj], p0, p1); v0 += p0; v1 += p1; }
                        if (k < 2) MIXS[slot] = pack8(v0, v1);
                        else *(u32x4*)(MX + row * D + u.pn * 256 + bj * 128 + wc * 32 + 8 * fq) = pack8(v0, v1); } }
                asm volatile("" ::: "memory"); }
        }
        return false; } };
__device__ __forceinline__ void p3b_mix_pg8(Frame& F, int l) {
    MixSched S{(const char*)(F.ws + WS_XB), (const char*)(F.ws + WS_WINT) + ((size_t)l * IN_COLS + COL_GATES) * D * 2, (const char*)(F.ws + WS_WBRT) + (size_t)l * 3 * D * BW * 2, (const char*)F.ws, F.G, F.wg};
    EpiMix E{(u32x2*)(F.ws + WS_P3BSCR + (size_t)F.wg * 262144), (u32x4*)(F.ws + WS_P3BSCR + (size_t)F.wg * 262144 + 131072), (bf16*)(F.ws + WS_MIXED), (const float*)(F.ws + WS_RINV1)};
    pg8::gemm_phase<EpiMix, MixSched, true, 0>(F.lds, S, E, F.tid);
}
struct Moe1Sched { const char* XB; const char* W13; const int* IDX; const LAS int* tb; int ntile, G, c;
    __device__ __forceinline__ bool next(int i, pg8::Unit& u) const {
        const int L = i * G + c; if (L >= ntile * 4) return false;
        u.pm = L >> 2; u.pn = L & 3; const int bucket = tb[1 + u.pm], g = bucket / 6; int pa, pb; pair_of(bucket % 6, pa, pb);
        u.aux = u.pn >> 1; const int e = g * 4 + (u.aux ? pb : pa);
        u.A = XB; u.lda2 = 2048; u.nt = 16; u.B = W13 + ((size_t)e * 512 + (u.pn & 1) * 256) * 2048; u.ldb2 = 2048; return true; }
    __device__ __forceinline__ unsigned row_off(const pg8::Unit& u, int r) const { int tok = IDX[u.pm * 256 + r]; tok = tok < 0 ? 0 : tok; return (unsigned)tok * 2048u; }
};
struct EpiMoe1 { bf16* HS; const float* WSORT; const float* RSORT;
    __device__ __forceinline__ bool operator()(const AccT& acc, const pg8::Unit& u, int wr, int wc, int fr, int fq) const {
        asm volatile("" : "+v"(fr), "+v"(fq));
        const int slot = u.aux, hcol = slot * 256 + (u.pn & 1) * 128 + wc * 32 + 8 * fq;
#pragma unroll
        for (int ai = 0; ai < 2; ++ai)
#pragma unroll
            for (int m = 0; m < 4; ++m) { const int row = u.pm * 256 + ai * 128 + wr * 64 + m * 16 + fr; const float wsel = WSORT[2 * row + slot], ri = RSORT[row]; f32x4 o[2];
#pragma unroll
                for (int n = 0; n < 2; ++n)
#pragma unroll
                    for (int j = 0; j < 4; ++j) { const float v1 = acc[ai][0][m][n][j] * ri, v3 = acc[ai][1][m][n][j] * ri; o[n][j] = v1 * sigmoidf_(v1) * v3 * wsel; }
                *(u32x4*)(HS + (size_t)row * 512 + hcol) = pack8(o[0], o[1]); }
        return false; } };
__device__ __forceinline__ void p4c_moe1_pg8(Frame& F, int l) {
    LAS int* tb = (LAS int*)(F.lds + TB_OFF);
    const int ntile = build_tile_table(F, tb);
    Moe1Sched S{(const char*)(F.ws + WS_XB), (const char*)(F.ws + WS_W13T) + (size_t)l * 16 * 512 * D * 2, (const int*)(F.ws + WS_IDX), tb, ntile, F.G, F.wg};
    EpiMoe1 E{(bf16*)(F.ws + WS_HS), (const float*)(F.ws + WS_WSORT), (const float*)(F.ws + WS_RSORT)};
    pg8::gemm_phase<EpiMoe1, Moe1Sched, true, 2>(F.lds, S, E, F.tid);
}
struct Moe2Sched { const char* HS; const char* W2; const LAS int* tb; int ntile, G, c;
    __device__ __forceinline__ bool next(int i, pg8::Unit& u) const {
        const int L = i * G + c; if (L >= ntile * 4) return false;
        u.pm = L >> 2; u.pn = L & 3; u.aux = 0; const int bucket = tb[1 + u.pm];
        u.A = HS + (size_t)u.pm * 256 * 1024; u.lda2 = 1024; u.nt = 8; u.B = W2 + ((size_t)bucket * D + u.pn * 256) * 1024; u.ldb2 = 1024; return true; }
    __device__ __forceinline__ unsigned row_off(const pg8::Unit&, int) const { return 0u; }
};
struct EpiMoe2 { float* X; bf16* XB; const int* IDX;
    __device__ __forceinline__ bool operator()(const AccT& acc, const pg8::Unit& u, int wr, int wc, int fr, int fq) const {
        asm volatile("" : "+v"(fr), "+v"(fq));
        int tk[2][4];
#pragma unroll
        for (int ai = 0; ai < 2; ++ai)
#pragma unroll
            for (int m = 0; m < 4; ++m) tk[ai][m] = IDX[u.pm * 256 + ai * 128 + wr * 64 + m * 16 + fr];
#pragma unroll
        for (int ai = 0; ai < 2; ++ai) {
#pragma unroll
            for (int mp = 0; mp < 2; ++mp) {
                f32x4 xv[2][2][2];
#pragma unroll
                for (int mm = 0; mm < 2; ++mm) { const int tok = tk[ai][2 * mp + mm]; const size_t rb = (size_t)(tok < 0 ? 0 : tok) * D + u.pn * 256 + wc * 32 + 8 * fq;
#pragma unroll
                    for (int bj = 0; bj < 2; ++bj) { xv[mm][bj][0] = *(const f32x4*)(X + rb + bj * 128); xv[mm][bj][1] = *(const f32x4*)(X + rb + bj * 128 + 4); } }
#pragma unroll
                for (int mm = 0; mm < 2; ++mm) { const int m = 2 * mp + mm, tok = tk[ai][m];
                    if (tok >= 0) { const size_t rb = (size_t)tok * D + u.pn * 256 + wc * 32 + 8 * fq;
#pragma unroll
                        for (int bj = 0; bj < 2; ++bj) { const f32x4 v0 = xv[mm][bj][0] + acc[ai][bj][m][0], v1 = xv[mm][bj][1] + acc[ai][bj][m][1];
                            *(f32x4*)(X + rb + bj * 128) = v0; *(f32x4*)(X + rb + bj * 128 + 4) = v1; *(u32x4*)(XB + rb + bj * 128) = pack8(v0, v1); } } }
                asm volatile("" ::: "memory"); } }
        return false; } };
__device__ __forceinline__ void p4d_moe2_pg8(Frame& F, int l) {
    LAS int* tb = (LAS int*)(F.lds + TB_OFF);
    const int ntile = build_tile_table(F, tb);
    Moe2Sched S{(const char*)(F.ws + WS_HS), (const char*)(F.ws + WS_W2TB) + (size_t)l * NBUCKET * D * 512 * 2, tb, ntile, F.G, F.wg};
    EpiMoe2 E{F.out, (bf16*)(F.ws + WS_XB), (const int*)(F.ws + WS_IDX)};
    pg8::gemm_phase<EpiMoe2, Moe2Sched, true, 0>(F.lds, S, E, F.tid);
}

__device__ __forceinline__ void p_rowstats(Frame& F) {
    const float* X = F.out; float* rinv = (float*)(F.ws + WS_RINV1);
    for (int m0 = 4 * F.gw; m0 < M; m0 += 4 * F.NGW) {
        f32x4 v[4][4];
#pragma unroll
        for (int a = 0; a < 4; ++a) { const f32x4* xr = (const f32x4*)(X + (size_t)(m0 + a) * D) + F.lane;
#pragma unroll
            for (int j = 0; j < 4; ++j) v[a][j] = xr[64 * j]; }
        float t[4];
#pragma unroll
        for (int a = 0; a < 4; ++a) { float s = 0.f;
#pragma unroll
            for (int j = 0; j < 4; ++j) s += (v[a][j].x * v[a][j].x + v[a][j].y * v[a][j].y) + (v[a][j].z * v[a][j].z + v[a][j].w * v[a][j].w);
            t[a] = wave_sum(s, F.lane); }
        if (F.lane < 4) { const float s = F.lane == 0 ? t[0] : (F.lane == 1 ? t[1] : (F.lane == 2 ? t[2] : t[3])); rinv[m0 + F.lane] = 1.0f / sqrtf(s * (1.0f / D) + NORM_EPS); }
    }
}
__device__ __forceinline__ void p_final_norm(Frame& F) {
    float* X = F.out;
    const f32x4* gp = (const f32x4*)F.in[I_FNG] + F.lane; f32x4 gv[4];
#pragma unroll
    for (int j = 0; j < 4; ++j) gv[j] = gp[64 * j];
    for (int m0 = 4 * F.gw; m0 < M; m0 += 4 * F.NGW) {
        f32x4 v[4][4];
#pragma unroll
        for (int a = 0; a < 4; ++a) { const f32x4* xr = (const f32x4*)(X + (size_t)(m0 + a) * D) + F.lane;
#pragma unroll
            for (int j = 0; j < 4; ++j) v[a][j] = xr[64 * j]; }
#pragma unroll
        for (int a = 0; a < 4; ++a) { float s = 0.f;
#pragma unroll
            for (int j = 0; j < 4; ++j) s += (v[a][j].x * v[a][j].x + v[a][j].y * v[a][j].y) + (v[a][j].z * v[a][j].z + v[a][j].w * v[a][j].w);
            s = wave_sum(s, F.lane); const float ri = 1.0f / sqrtf(s * (1.0f / D) + NORM_EPS);
            f32x4* xw = (f32x4*)(X + (size_t)(m0 + a) * D) + F.lane;
#pragma unroll
            for (int j = 0; j < 4; ++j) xw[64 * j] = v[a][j] * ri * gv[j]; }
    }
}

__device__ __forceinline__ bool fresh(Frame& F) {
    int t = threadIdx.x; asm volatile("" : "+v"(t));
    F.tid = t; F.lane = t & 63; F.wave = __builtin_amdgcn_readfirstlane(t >> 6); F.gw = F.wg * NWAVES + F.wave;
    const __attribute__((address_space(4))) Args* ap = (const __attribute__((address_space(4))) Args*)__builtin_amdgcn_kernarg_segment_ptr();
    asm volatile("" : "+s"(ap));
    F.in = ap->in; F.out = ap->out; F.ws = ap->ws;
    return true;
}
__global__ void __launch_bounds__(NTHREADS, 2) fwd(Args args) {
    extern __shared__ __attribute__((aligned(16))) unsigned char lds[];
    Frame F;
    F.lds = (LAS unsigned char*)lds;
    volatile LAS unsigned* MISC = (volatile LAS unsigned*)(F.lds + MISC_OFF);
    if (threadIdx.x < 32) MISC[threadIdx.x] = 0u;
    __syncthreads();
    F.tid = threadIdx.x; F.lane = F.tid & 63; F.wave = __builtin_amdgcn_readfirstlane(F.tid >> 6);
    F.wg = blockIdx.x; F.gw = F.wg * NWAVES + F.wave;
    F.in = nullptr; F.out = args.out; F.ws = args.ws;
    unsigned* ctl = (unsigned*)(F.ws + WS_CTL);
    XcdBarrier bar; bar.bar = ctl + CW_BAR; bar.x = 0; bar.st = nullptr;
    if (!MK_PER_PHASE) bar = xcd_barrier_post(ctl + CW_BAR, MISC + 8, F.tid == 0);
    const int lo = args.ph_lo, hi = args.ph_hi;
#define IN(k) (lo <= (k) && (k) < hi && fresh(F))
#define SEAM(k) do { if (IN(k) && IN((k) + 1)) xcd_barrier(bar, F.tid == 0); } while (0)

#ifndef DUP_MASK
#define DUP_MASK 0
#endif
#define RUN(k, body) do { int reps_ = 1 + ((DUP_MASK >> (k)) & 1); if (DUP_MASK) asm volatile("" : "+s"(reps_)); for (int rep_ = 0; rep_ < reps_; ++rep_) { body; if (DUP_MASK) __syncthreads(); } } while (0)
    if (IN(0)) { RUN(0, p0_prologue(F)); } SEAM(0);
    for (int l = 0; l < DEPTH; ++l) {
        const int pb = 1 + 10 * l;
        if (IN(pb + 0)) { RUN(1, p1_inproj_pg8(F, l)); } SEAM(pb + 0);
        if (IN(pb + 1)) { RUN(2, lru_mfma(F, l)); RUN(3, s5_mfma(F, l)); RUN(4, attn_mfma(F, l)); } SEAM(pb + 1);
        if (IN(pb + 2)) { RUN(5, p3a_glu_pg8(F, l)); } SEAM(pb + 2);
        if (IN(pb + 3)) { RUN(6, p3b_mix_pg8(F, l)); } SEAM(pb + 3);
        if (IN(pb + 4)) { p3c_outproj_pg8(F, l); } SEAM(pb + 4);
        if (IN(pb + 5)) { RUN(8, p4a_router(F, l)); } SEAM(pb + 5);
        if (IN(pb + 6)) { RUN(9, p4b_positions(F)); } SEAM(pb + 6);
        if (IN(pb + 7)) { RUN(10, p4c_moe1_pg8(F, l)); } SEAM(pb + 7);
        if (IN(pb + 8)) { p4d_moe2_pg8(F, l); } SEAM(pb + 8);
        if (IN(pb + 9)) { if (l == DEPTH - 1) p_final_norm(F); else { RUN(12, p_rowstats(F)); } }
        if (l < DEPTH - 1) SEAM(pb + 9);
    }
#undef IN
#undef SEAM
}

extern "C" void kernel_launch(void* const* d_in, const int* in_sizes, int n_in, void* d_out, int out_size, void* d_ws, size_t ws_size, hipStream_t stream) {
    static int grid = 0;
    if (grid == 0) {
        if (n_in != 32 || out_size != M * D || ws_size < WS_END) { fprintf(stderr, "kernel_launch: unexpected shapes (n_in %d, out %d, ws %zu)\n", n_in, out_size, ws_size); grid = -1; return; }
        if (hipFuncSetAttribute((const void*)fwd, hipFuncAttributeMaxDynamicSharedMemorySize, LDS_BYTES) != hipSuccess) { fprintf(stderr, "kernel_launch: hipFuncSetAttribute failed\n"); grid = -1; return; }
        int per_cu = 0;
        if (hipOccupancyMaxActiveBlocksPerMultiprocessor(&per_cu, (const void*)fwd, NTHREADS, LDS_BYTES) != hipSuccess || per_cu < 1) fprintf(stderr, "kernel_launch: occupancy query reports %d\n", per_cu);
        (void)hipGetLastError();
        grid = 256;
    }
    if (grid < 0) return;
    (void)hipMemsetAsync((char*)d_ws + WS_CTL, 0, CTL_ZERO_BYTES, stream);
    Args a{};
    for (int i = 0; i < 32; ++i) a.in[i] = (const float*)d_in[i];
    a.out = (float*)d_out; a.ws = (unsigned char*)d_ws; a.pad = 0;
#if MK_PER_PHASE
    for (int p = 0; p < NPHASE; ++p) { a.ph_lo = p; a.ph_hi = p + 1; a.li = p; hipLaunchKernelGGL(fwd, dim3(grid), dim3(NTHREADS), LDS_BYTES, stream, a); }
#else
    a.ph_lo = 0; a.ph_hi = NPHASE; a.li = 0;
    hipLaunchKernelGGL(fwd, dim3(grid), dim3(NTHREADS), LDS_BYTES, stream, a);
#endif
}
```

```cpp
#include <hip/hip_runtime.h>
#include <cstdio>
#include <cstdint>

#ifndef MK_PER_PHASE
#define MK_PER_PHASE 0
#endif

constexpr int D = 1024, BATCH = 16, SEQ = 2048, M = BATCH * SEQ, DEPTH = 2;
constexpr int NQ = 8, HD = 64, WIN = 128;
constexpr int BW = 512;
constexpr int ZC = 2304;
constexpr int IN_COLS = 5376;
constexpr int COL_Q = 0, COL_K = 512, COL_V = 640, COL_XR = 768, COL_GR = 1280, COL_U = 1792, COL_GATES = 2304;
constexpr int NBUCKET = 24;
constexpr int MS_MAX = (128 + NBUCKET) * 256;
constexpr float NORM_EPS = 1e-6f;
constexpr int NWAVES = 8, NTHREADS = 512;
constexpr int NPHASE = 21;

constexpr size_t MiB = 1u << 20;
constexpr size_t WS_CTL = 0, CTL_ZERO_BYTES = 1 * MiB;
constexpr size_t WS_RINV1 = 1 * MiB;
constexpr size_t WS_RINV2 = WS_RINV1 + 128 * 1024;
constexpr size_t WS_BUCKET = WS_RINV2 + 128 * 1024;
constexpr size_t WS_RANK = WS_BUCKET + 128 * 1024;
constexpr size_t WS_WTOK = WS_RANK + 128 * 1024;
constexpr size_t WS_HIST = WS_WTOK + 256 * 1024;
constexpr size_t WS_BBASE = WS_HIST + 32 * 1024;
constexpr size_t WS_IDX = WS_BBASE + 1024;
constexpr size_t WS_WSORT = WS_IDX + 160 * 1024;
constexpr size_t WS_RSORT = WS_WSORT + 320 * 1024;
constexpr size_t WS_S5TBL = 3 * MiB;
constexpr size_t WS_WRT = 5 * MiB;
constexpr size_t WS_LRUF = 7 * MiB;
constexpr size_t WS_WINT = 8 * MiB;
constexpr size_t WS_WGLUT = 29 * MiB;
constexpr size_t WS_WBRT = 31 * MiB;
constexpr size_t WS_WOUTT = 37 * MiB;
constexpr size_t WS_W13T = 41 * MiB;
constexpr size_t WS_W2TB = 73 * MiB;
constexpr size_t WS_S5MAT = 121 * MiB;
constexpr size_t WS_S5LAM = 6 * MiB;
constexpr size_t WS_XB = 145 * MiB;
constexpr size_t WS_Z1 = 209 * MiB;
constexpr size_t WS_MIXED = 209 * MiB;
constexpr size_t WS_HS = 273 * MiB;
constexpr size_t WS_OA = 353 * MiB, WS_OL = 385 * MiB, WS_YS = 417 * MiB, WS_OS = 449 * MiB;
constexpr size_t WS_END = 481 * MiB;
static_assert(WS_WSORT + (size_t)MS_MAX * 8 <= WS_RSORT && WS_RSORT + (size_t)MS_MAX * 4 <= WS_S5TBL, "small region");
constexpr size_t WS_P3BSCR = 273 * MiB;
constexpr int TB_OFF = 163840 - 2048;
static_assert(WS_Z1 + (size_t)M * ZC * 2 <= WS_OA, "z1");
static_assert(WS_HS + (size_t)MS_MAX * 512 * 2 <= WS_OA, "hs");

constexpr int CW_BAR = 4096;
constexpr int LDS_BYTES = 163840;
constexpr int MISC_OFF = 163840 - 256;

#define LAS __attribute__((address_space(3)))
typedef unsigned short bf16;
typedef short bf16x8 __attribute__((ext_vector_type(8)));
typedef float f32x4 __attribute__((ext_vector_type(4)));
typedef unsigned u32x4 __attribute__((ext_vector_type(4)));
typedef unsigned u32x2 __attribute__((ext_vector_type(2)));

__device__ __forceinline__ float bf2f(bf16 b) { return __uint_as_float(((unsigned)b) << 16); }
__device__ __forceinline__ unsigned f2bf(float f) { unsigned u = __float_as_uint(f); return (u + 0x7fffu + ((u >> 16) & 1u)) >> 16; }
__device__ __forceinline__ unsigned pk2(float lo, float hi) { return f2bf(lo) | (f2bf(hi) << 16); }
typedef __bf16 hwbf16x2 __attribute__((ext_vector_type(2)));
__device__ __forceinline__ unsigned pk2hw(float lo, float hi) { hwbf16x2 v; v.x = (__bf16)lo; v.y = (__bf16)hi; return __builtin_bit_cast(unsigned, v); }
__device__ __forceinline__ float sigmoidf_(float x) { return __builtin_amdgcn_rcpf(1.0f + __builtin_amdgcn_exp2f(-1.4426950408889634f * x)); }
__device__ __forceinline__ float gelu_tanh(float x) { return x * sigmoidf_(1.5957691216057308f * (x + 0.044715f * x * x * x)); }
template <int N> __device__ __forceinline__ float dpp_ror(float v) { return __int_as_float(__builtin_amdgcn_update_dpp(0, __float_as_int(v), 0x120 + N, 0xf, 0xf, false)); }
__device__ __forceinline__ float rlane(float v, int l) { return __int_as_float(__builtin_amdgcn_readlane(__float_as_int(v), l)); }
__device__ __forceinline__ float wave_sum(float v, int  ) {
    v += dpp_ror<8>(v); v += dpp_ror<4>(v); v += dpp_ror<2>(v); v += dpp_ror<1>(v);
    return (rlane(v, 0) + rlane(v, 16)) + (rlane(v, 32) + rlane(v, 48));
}
__device__ __forceinline__ float lane_xor(float v, int lane, int o) { return __int_as_float(__builtin_amdgcn_ds_bpermute((lane ^ o) << 2, __float_as_int(v))); }
#define LDS_WAIT() asm volatile("s_waitcnt lgkmcnt(0)" ::: "memory")

#define XB_TMO      128
#define XB_XCNT(j)  (256  + 64 * (j))
#define XB_XSUB(j)  (1280 + 64 * (j))
#define XB_XGEN(j)  (2304 + 64 * (j))
#define XB_TOP      3328
#define XB_TOPGEN   3392
#define XCD_BAR_WORDS 3456
#define XB_SPIN_CAP (1u << 20)
__device__ __forceinline__ unsigned xb_ld(unsigned* p)              { return __hip_atomic_load(p, __ATOMIC_RELAXED, __HIP_MEMORY_SCOPE_AGENT); }
__device__ __forceinline__ unsigned xb_add(unsigned* p, unsigned v) { return __hip_atomic_fetch_add(p, v, __ATOMIC_RELAXED, __HIP_MEMORY_SCOPE_AGENT); }
__device__ __forceinline__ unsigned xb_xcc_id() { return (unsigned)__builtin_amdgcn_s_getreg((3 << 11) | 20) & 0xFu; }
#define XB_SPIN(cond, bar) do { unsigned _sp = 0; while (cond) { __builtin_amdgcn_s_sleep(1); \
    if ((++_sp & 255u) == 0u) { if (xb_ld(&(bar)[XB_TMO])) break; if (_sp > XB_SPIN_CAP) { atomicAdd(&(bar)[XB_TMO], 1u); break; } } } } while (0)
struct XcdBarrier { unsigned* bar; unsigned x; volatile LAS unsigned* st; };
__device__ __forceinline__ XcdBarrier xcd_barrier_post(unsigned* bar, volatile LAS unsigned* st, bool leader) {
    XcdBarrier b; b.bar = bar; b.x = xb_xcc_id(); b.st = st;
    if (leader) (void)xb_add(&bar[XB_XCNT(b.x)], 1u);
    return b;
}
__device__ __forceinline__ void xcd_barrier_complete(unsigned* bar, unsigned x, unsigned& nloc, unsigned& nx) {
    const unsigned G = gridDim.x * gridDim.y * gridDim.z;
    unsigned sum, cnt, mine, sp = 0u;
    for (;;) {
        sum = 0u; cnt = 0u; mine = 0u;
#pragma unroll
        for (unsigned j = 0; j < 16; ++j) { const unsigned c = xb_ld(&bar[XB_XCNT(j)]); sum += c; cnt += (c > 0u) ? 1u : 0u; mine = (j == x) ? c : mine; }
        if (sum == G) break;
        __builtin_amdgcn_s_sleep(1);
        if ((++sp & 255u) == 0u) { if (xb_ld(&bar[XB_TMO])) break; if (sp > XB_SPIN_CAP) { atomicAdd(&bar[XB_TMO], 1u); break; } }
    }
    nloc = mine > 0u ? mine : 1u; nx = cnt > 0u ? cnt : 1u;
}
__device__ __forceinline__ void xcd_barrier(const XcdBarrier& b, bool leader) {
    asm volatile("s_waitcnt vmcnt(0)" ::: "memory");
    __syncthreads();
    if (leader) {
        unsigned* bar = b.bar;
        __builtin_amdgcn_s_waitcnt(0);
        unsigned nloc = b.st[0], nx = b.st[1];
        if (nloc == 0u) { xcd_barrier_complete(bar, b.x, nloc, nx); b.st[0] = nloc; b.st[1] = nx; }
        const unsigned old = xb_add(&bar[XB_XSUB(b.x)], 1u);
        const unsigned gen = old / nloc;
        if (old + 1u == (gen + 1u) * nloc) {
            __builtin_amdgcn_fence(__ATOMIC_RELEASE, "agent");
            asm volatile("s_waitcnt vmcnt(0)" ::: "memory");
            const unsigned og = xb_add(&bar[XB_TOP], 1u);
            const unsigned tg = og / nx;
            if (og + 1u == (tg + 1u) * nx) xb_add(&bar[XB_TOPGEN], 1u);
            else XB_SPIN(xb_ld(&bar[XB_TOPGEN]) == tg, bar);
            __builtin_amdgcn_fence(__ATOMIC_ACQUIRE, "agent");
            xb_add(&bar[XB_XGEN(b.x)], 1u);
            asm volatile("s_waitcnt vmcnt(0)" ::: "memory");
        } else {
            XB_SPIN(xb_ld(&bar[XB_XGEN(b.x)]) == gen, bar);
            __builtin_amdgcn_fence(__ATOMIC_ACQUIRE, "agent");
            asm volatile("s_waitcnt vmcnt(0)" ::: "memory");
        }
    }
    __syncthreads();
}

struct Args { const float* in[32]; float* out; unsigned char* ws; int ph_lo, ph_hi, li, pad; };
struct Frame {
    LAS unsigned char* lds;
    int tid, lane, wave, wg, gw;
    static constexpr int G = 256, NGW = 256 * NWAVES;
    const float* const __attribute__((address_space(4)))* in;
    float* out; unsigned char* ws;
};
enum { I_X = 0, I_N1G, I_WIN, I_SINK, I_CONVW, I_CONVB, I_LWR, I_LBR, I_LWI, I_LBI, I_LAM, I_ARE, I_AIM, I_LSTEP, I_BRE, I_BIM, I_CRE, I_CIM, I_SD, I_WGLU, I_BGLU,
       I_WBR, I_WOUT, I_N2G, I_WG, I_BG, I_WE, I_BE, I_W1, I_W3, I_W2, I_FNG };

__device__ __forceinline__ void pair_of(int p, int& a, int& b) {
    a = (p < 3) ? 0 : (p < 5 ? 1 : 2); b = (p < 3) ? p + 1 : (p < 5 ? p - 1 : 3);
}
__device__ __forceinline__ int pair_index(int a, int b) {
    return (a == 0) ? (b - 1) : (a == 1 ? (b + 1) : 5);
}


namespace pg8 {
typedef unsigned short bf16_t;
constexpr int BM = 256, BK = 64, HALF = 128, HTB = HALF * BK * 2, STAGE_BYTES = 8 * HTB, NXCD = 8, WGM = 8;
__host__ __device__ __forceinline__ int lds_byte(int r, int c) { const int st = (r >> 4) * 2 + (c >> 5), rr = r & 15, cc = c & 31, ob = rr * 64 + cc * 2; return st * 1024 + (ob ^ (((ob >> 9) & 1) << 5)); }
__host__ __device__ __forceinline__ void stage_rc(int b, int& R, int& C) { const int st = b / 1024, sb = b % 1024, swz = sb ^ (((sb >> 9) & 1) << 5); R = (st >> 1) * 16 + swz / 64; C = (st & 1) * 32 + (swz % 64) / 2; }
__host__ __device__ __forceinline__ int perm32(int rho) { const int n = rho >> 4, i = rho & 15; return 8 * (i >> 2) + 4 * n + (i & 3); }

struct Unit { int pm, pn, aux; int nt; unsigned lda2, ldb2; const char* A; const char* B; };

__device__ __forceinline__ void static_tile(int L, int nM, int nN, int& pm, int& pn) {
    const int nwg = nM * nN; int wgid = L; { const int q = nwg / NXCD, r = nwg % NXCD, xcd = wgid % NXCD, off = wgid / NXCD; wgid = (xcd < r ? xcd * (q + 1) : r * (q + 1) + (xcd - r) * q) + off; }
    const int nig = WGM * nN, gid = wgid / nig, fm = gid * WGM, gsz = (nM - fm) < WGM ? (nM - fm) : WGM;
    pm = fm + ((wgid % nig) % gsz); pn = (wgid % nig) / gsz;
}

template <class Epi, class Sched, bool ALIGN_EPI, int MODE>
__device__ __forceinline__ void gemm_phase(LAS unsigned char* lds, const Sched& S, const Epi& E, int tid) {
    const int wid = __builtin_amdgcn_readfirstlane(tid >> 6), lane = tid & 63, wr = wid >> 2, wc = wid & 3, fr = lane & 15, fq = lane >> 4;
    unsigned RA[2], C2[2];
#pragma unroll
    for (int i = 0; i < 2; ++i) { int R, C; stage_rc(tid * 16 + i * 8192, R, C); RA[i] = (unsigned)R; C2[i] = (unsigned)C * 2u; }
    const unsigned ldsw = (unsigned)wid * 1024u;
    const int aoff = lds_byte(wr * 64 + fr, fq * 8), boff = lds_byte(wc * 32 + fr, fq * 8);
#define PG8_SA(b, h) (((b) * 2 + (h)) * HTB)
#define PG8_SB(b, h) ((4 + (b) * 2 + (h)) * HTB)
#define PG8_STAGE_A(bufoff, gbase, h, ld2, go) do { _Pragma("unroll") for (int _i = 0; _i < 2; ++_i) { \
        const unsigned _vo = (MODE == 2) ? ((go)[h][_i] + C2[_i]) : ((RA[_i] + 128u * (h)) * (ld2) + C2[_i]); \
        __builtin_amdgcn_global_load_lds((const unsigned*)((gbase) + _vo), (LAS unsigned*)(lds + (bufoff) + ldsw + _i * 8192), 16, 0, 0); } } while (0)
#define PG8_STAGE_B(bufoff, gbase, h, ld2) do { _Pragma("unroll") for (int _i = 0; _i < 2; ++_i) { \
        const unsigned _vo = (((RA[_i] & ~31u) + (unsigned)perm32((int)(RA[_i] & 31u))) + 128u * (h)) * (ld2) + C2[_i]; \
        __builtin_amdgcn_global_load_lds((const unsigned*)((gbase) + _vo), (LAS unsigned*)(lds + (bufoff) + ldsw + _i * 8192), 16, 0, 0); } } while (0)
#define PG8_LDA(dst, b, h) do { _Pragma("unroll") for (int m = 0; m < 4; ++m) _Pragma("unroll") for (int k = 0; k < 2; ++k) dst[m][k] = *(const LAS bf16x8*)(lds + PG8_SA(b, h) + aoff + m * 2048 + k * 1024); } while (0)
#define PG8_LDB(dst, b, h) do { _Pragma("unroll") for (int n = 0; n < 2; ++n) _Pragma("unroll") for (int k = 0; k < 2; ++k) dst[n][k] = *(const LAS bf16x8*)(lds + PG8_SB(b, h) + boff + n * 2048 + k * 1024); } while (0)
#define PG8_MMA(ai, bj, At, Bt) do { __builtin_amdgcn_s_setprio(1); _Pragma("unroll") for (int m = 0; m < 4; ++m) _Pragma("unroll") for (int n = 0; n < 2; ++n) _Pragma("unroll") for (int k = 0; k < 2; ++k) \
        acc[ai][bj][m][n] = __builtin_amdgcn_mfma_f32_16x16x32_bf16(Bt[n][k], At[m][k], acc[ai][bj][m][n], 0, 0, 0); __builtin_amdgcn_s_setprio(0); } while (0)
#define PG8_WAIT_V(n) asm volatile("s_waitcnt vmcnt(" #n ")" ::: "memory")
#define PG8_WAIT_L(n) asm volatile("s_waitcnt lgkmcnt(" #n ")" ::: "memory")
#define PG8_BAR __builtin_amdgcn_s_barrier()
#define PG8_SCHED __builtin_amdgcn_sched_barrier(0)
    Unit cur, nxt; int ui = 0;
    if (!S.next(0, cur)) return;
    f32x4 acc[2][2][4][2];
#pragma unroll
    for (int a = 0; a < 2; ++a)
#pragma unroll
        for (int b = 0; b < 2; ++b)
#pragma unroll
            for (int m = 0; m < 4; ++m)
#pragma unroll
                for (int n = 0; n < 2; ++n) acc[a][b][m][n] = (f32x4){0.f, 0.f, 0.f, 0.f};
    bf16x8 At[4][2], B0[2][2], B1[2][2];
    unsigned cgo[2][2] = {{0u, 0u}, {0u, 0u}}, ngo[2][2] = {{0u, 0u}, {0u, 0u}};
    if (MODE == 2) {
#pragma unroll
        for (int h = 0; h < 2; ++h)
#pragma unroll
            for (int i = 0; i < 2; ++i) cgo[h][i] = S.row_off(cur, h * 128 + (int)RA[i]);
    }
    const size_t kstep = (size_t)(BK * 2);
    const char* cA = cur.A; const char* cB = cur.B;
    PG8_STAGE_B(PG8_SB(0, 0), cB, 0, cur.ldb2); PG8_STAGE_B(PG8_SB(0, 1), cB, 1, cur.ldb2); PG8_STAGE_A(PG8_SA(0, 0), cA, 0, cur.lda2, cgo); PG8_STAGE_A(PG8_SA(0, 1), cA, 1, cur.lda2, cgo);
    if (wr == 1) PG8_BAR;
    PG8_WAIT_V(2); PG8_BAR;
    PG8_STAGE_B(PG8_SB(1, 0), cB + kstep, 0, cur.ldb2); PG8_STAGE_A(PG8_SA(1, 0), cA + kstep, 0, cur.lda2, cgo); PG8_STAGE_B(PG8_SB(1, 1), cB + kstep, 1, cur.ldb2);
    PG8_WAIT_V(6); PG8_BAR;
    for (;;) {
        const bool has_next = S.next(ui + 1, nxt);
        if (!has_next) nxt = cur;
        if (MODE == 2) {
#pragma unroll
            for (int h = 0; h < 2; ++h)
#pragma unroll
                for (int i = 0; i < 2; ++i) ngo[h][i] = has_next ? S.row_off(nxt, h * 128 + (int)RA[i]) : cgo[h][i];
        }
        const char* nA = nxt.A; const char* nB = nxt.B;
        const int nt = cur.nt;
        for (int t = 0; t < nt; t += 2) {
            const bool last = (t == nt - 2);
            const char* a1 = cA + (size_t)(t + 1) * kstep;
            const char* a2 = last ? nA : cA + (size_t)(t + 2) * kstep; const char* b2 = last ? nB : cB + (size_t)(t + 2) * kstep;
            const char* a3 = a2 + kstep; const char* b3 = b2 + kstep;
            const unsigned la2 = last ? nxt.lda2 : cur.lda2, lb2 = last ? nxt.ldb2 : cur.ldb2;
            unsigned go2[2][2];
#pragma unroll
            for (int h = 0; h < 2; ++h)
#pragma unroll
                for (int i = 0; i < 2; ++i) go2[h][i] = last ? ngo[h][i] : cgo[h][i];
            PG8_LDB(B0, 0, 0); PG8_LDB(B1, 0, 1); PG8_SCHED; PG8_LDA(At, 0, 0); PG8_STAGE_A(PG8_SA(1, 1), a1, 1, cur.lda2, cgo);
            PG8_WAIT_V(8); PG8_WAIT_L(0); PG8_BAR; PG8_MMA(0, 0, At, B0); PG8_MMA(0, 1, At, B1); PG8_BAR; PG8_SCHED;
            PG8_LDA(At, 0, 1); PG8_STAGE_B(PG8_SB(0, 0), b2, 0, lb2); PG8_STAGE_B(PG8_SB(0, 1), b2, 1, lb2); PG8_STAGE_A(PG8_SA(0, 0), a2, 0, la2, go2);
            PG8_WAIT_V(8); PG8_WAIT_L(0); PG8_BAR; PG8_MMA(1, 0, At, B0); PG8_MMA(1, 1, At, B1); PG8_BAR; PG8_SCHED;
            PG8_LDB(B0, 1, 0); PG8_LDB(B1, 1, 1); PG8_SCHED; PG8_LDA(At, 1, 0); PG8_STAGE_A(PG8_SA(0, 1), a2, 1, la2, go2);
            PG8_WAIT_V(8); PG8_WAIT_L(0); PG8_BAR; PG8_MMA(0, 0, At, B0); PG8_MMA(0, 1, At, B1); PG8_BAR; PG8_SCHED;
            PG8_LDA(At, 1, 1); PG8_STAGE_B(PG8_SB(1, 0), b3, 0, lb2); PG8_STAGE_B(PG8_SB(1, 1), b3, 1, lb2); PG8_STAGE_A(PG8_SA(1, 0), a3, 0, la2, go2);
            PG8_WAIT_V(8); PG8_WAIT_L(0); PG8_BAR; PG8_MMA(1, 0, At, B0); PG8_MMA(1, 1, At, B1); PG8_BAR; PG8_SCHED;
        }
        if constexpr (ALIGN_EPI) { if (wr == 0) PG8_BAR; }
        const bool keep = E(acc, cur, wr, wc, fr, fq);
        if (!has_next) break;
        if (!keep) {
#pragma unroll
            for (int a = 0; a < 2; ++a)
#pragma unroll
                for (int b = 0; b < 2; ++b)
#pragma unroll
                    for (int m = 0; m < 4; ++m)
#pragma unroll
                        for (int n = 0; n < 2; ++n) acc[a][b][m][n] = (f32x4){0.f, 0.f, 0.f, 0.f};
        }
        cur = nxt; cA = nA; cB = nB; ++ui;
        if (MODE == 2) {
#pragma unroll
            for (int h = 0; h < 2; ++h)
#pragma unroll
                for (int i = 0; i < 2; ++i) cgo[h][i] = ngo[h][i];
        }
        if constexpr (ALIGN_EPI) { if (wr == 1) PG8_BAR; }
    }
    PG8_WAIT_V(0);
    if constexpr (!ALIGN_EPI) { if (wr == 0) PG8_BAR; }
    PG8_BAR;
#undef PG8_SA
#undef PG8_SB
#undef PG8_STAGE_A
#undef PG8_STAGE_B
#undef PG8_LDA
#undef PG8_LDB
#undef PG8_MMA
#undef PG8_WAIT_V
#undef PG8_WAIT_L
#undef PG8_BAR
#undef PG8_SCHED
}
}

__device__ __forceinline__ unsigned cvt_pk_bf16(float lo, float hi) { unsigned r; asm volatile("v_cvt_pk_bf16_f32 %0, %1, %2" : "=v"(r) : "v"(lo), "v"(hi)); return r; }
__device__ __forceinline__ u32x4 pack8(const f32x4& v0, const f32x4& v1) { u32x4 w; w.x = cvt_pk_bf16(v0[0], v0[1]); w.y = cvt_pk_bf16(v0[2], v0[3]); w.z = cvt_pk_bf16(v1[0], v1[1]); w.w = cvt_pk_bf16(v1[2], v1[3]); return w; }
__device__ __forceinline__ void unpack8(const u32x4& w, f32x4& v0, f32x4& v1) {
    v0[0] = __uint_as_float(w.x << 16); v0[1] = __uint_as_float(w.x & 0xffff0000u); v0[2] = __uint_as_float(w.y << 16); v0[3] = __uint_as_float(w.y & 0xffff0000u);
    v1[0] = __uint_as_float(w.z << 16); v1[1] = __uint_as_float(w.z & 0xffff0000u); v1[2] = __uint_as_float(w.w << 16); v1[3] = __uint_as_float(w.w & 0xffff0000u); }

struct DenseSched {
    const char* A; const char* B; int nM, nN, G, c, nt; unsigned lda2, ldb2;
    __device__ __forceinline__ bool next(int i, pg8::Unit& u) const {
        const int L = i * G + c; if (L >= nM * nN) return false;
        pg8::static_tile(L, nM, nN, u.pm, u.pn); u.aux = 0; u.nt = nt; u.lda2 = lda2; u.ldb2 = ldb2;
        u.A = A + (size_t)u.pm * 256 * lda2; u.B = B + (size_t)u.pn * 256 * ldb2; return true;
    }
    __device__ __forceinline__ unsigned row_off(const pg8::Unit&, int) const { return 0u; }
};

template <int MAP>
__device__ __forceinline__ int rowmap(int n) { if (MAP == 0) return n; return (n >> 7) * 256 + (n & 127) + (MAP == 2 ? 128 : 0); }
template <int MAP>
__device__ __forceinline__ void transpose_item(const float* W, int N, int ncol0, const float* gain, bf16* dst, int dld, int dcol0, LAS float* scr, int kb, int nb, int lane) {
    const int k0 = 64 * kb, n0 = 32 * nb;
    float tv_[32];
#pragma unroll
    for (int i = 0; i < 32; ++i) tv_[i] = W[(size_t)(k0 + 2 * i + (lane >> 5)) * N + ncol0 + n0 + (lane & 31)];
    if (gain) {
#pragma unroll
        for (int i = 0; i < 32; ++i) tv_[i] *= gain[k0 + 2 * i + (lane >> 5)];
    }
#pragma unroll
    for (int i = 0; i < 32; ++i) scr[(2 * i + (lane >> 5)) * 33 + (lane & 31)] = tv_[i];
    LDS_WAIT();
    const int c = lane & 7;
#pragma unroll
    for (int j = 0; j < 4; ++j) { const int n = (lane >> 3) + 8 * j; const LAS float* s = scr + (8 * c) * 33 + n;
        u32x4 o; o.x = pk2(s[0 * 33], s[1 * 33]); o.y = pk2(s[2 * 33], s[3 * 33]); o.z = pk2(s[4 * 33], s[5 * 33]); o.w = pk2(s[6 * 33], s[7 * 33]);
        *(u32x4*)(dst + (size_t)rowmap<MAP>(n0 + n) * dld + dcol0 + k0 + 8 * c) = o; }
    LDS_WAIT();
}

__device__ __forceinline__ void s5_setup_item(Frame& F, int l, int g);
#ifndef P0_LAYERS
#define P0_LAYERS 1
#endif
__device__ __forceinline__ void p0_weights(Frame& F, int l0, int l1, int worker, int nworkers) {
    LAS float* scr = (LAS float*)(F.lds + F.wave * 16384);
    unsigned char* ws = F.ws;
    constexpr int IT_WIN = 16 * 168, IT_GLU = 8 * 16 * 2, IT_BR = 3 * 8 * 32, IT_OUT = 16 * 32, IT_W13 = 16 * 2 * 16 * 8, IT_W2 = 48 * 4 * 32;
    constexpr int IT_LAYER = IT_WIN + IT_GLU + IT_BR + IT_OUT + IT_W13 + IT_W2;
    for (int it = l0 * IT_LAYER + worker; it < l1 * IT_LAYER; it += nworkers) {
        const int l = it / IT_LAYER; int r = it % IT_LAYER;
        if (r < IT_WIN) { transpose_item<0>(F.in[I_WIN] + (size_t)l * D * IN_COLS, IN_COLS, 0, F.in[I_N1G] + l * D, (bf16*)(ws + WS_WINT) + (size_t)l * IN_COLS * D, D, 0, scr, r / 168, r % 168, F.lane); continue; }
        r -= IT_WIN;
        if (r < IT_GLU) { const int half = r / (8 * 16); const int q = r % (8 * 16);
            const float* W = F.in[I_WGLU] + (size_t)l * BW * 1024; bf16* dst = (bf16*)(ws + WS_WGLUT) + (size_t)l * 1024 * BW;
            if (half == 0) transpose_item<1>(W, 1024, 0, nullptr, dst, BW, 0, scr, q / 16, q % 16, F.lane);
            else           transpose_item<2>(W, 1024, 512, nullptr, dst, BW, 0, scr, q / 16, q % 16, F.lane);
            continue; }
        r -= IT_GLU;
        if (r < IT_BR) { const int k = r / 256, q = r % 256; transpose_item<0>(F.in[I_WBR] + ((size_t)l * 3 + k) * BW * D, D, 0, nullptr, (bf16*)(ws + WS_WBRT) + ((size_t)l * 3 + k) * D * BW, BW, 0, scr, q / 32, q % 32, F.lane); continue; }
        r -= IT_BR;
        if (r < IT_OUT) { transpose_item<0>(F.in[I_WOUT] + (size_t)l * D * D, D, 0, nullptr, (bf16*)(ws + WS_WOUTT) + (size_t)l * D * D, D, 0, scr, r / 32, r % 32, F.lane); continue; }
        r -= IT_OUT;
        if (r < IT_W13) { const int ge = r / 256, q = r % 256, which = q / 128, qq = q % 128;
            const float* W = F.in[which ? I_W3 : I_W1] + ((size_t)l * 16 + ge) * D * 256; bf16* dst = (bf16*)(ws + WS_W13T) + ((size_t)l * 16 + ge) * 512 * D;
            if (which == 0) transpose_item<1>(W, 256, 0, F.in[I_N2G] + l * D, dst, D, 0, scr, qq / 8, qq % 8, F.lane);
            else            transpose_item<2>(W, 256, 0, F.in[I_N2G] + l * D, dst, D, 0, scr, qq / 8, qq % 8, F.lane);
            continue; }
        r -= IT_W13;
        { const int bs = r / 128, q = r % 128, bucket = bs >> 1, slot = bs & 1, g = bucket / 6; int pa, pb; pair_of(bucket % 6, pa, pb);
          const int e = g * 4 + (slot ? pb : pa);
          transpose_item<0>(F.in[I_W2] + ((size_t)l * 16 + e) * 256 * D, D, 0, nullptr, (bf16*)(ws + WS_W2TB) + ((size_t)l * NBUCKET + bucket) * D * 512, 512, slot * 256, scr, q / 32, q % 32, F.lane); }
    }
}
__device__ __forceinline__ void p0_prologue(Frame& F) {
    LAS float* scr = (LAS float*)(F.lds + F.wave * 16384);
    unsigned char* ws = F.ws;
    if (F.wg < DEPTH * 32) { s5_setup_item(F, F.wg >> 5, F.wg & 31); return; }
    const int gwx = (F.wg - DEPTH * 32) * NWAVES + F.wave; constexpr int NGX = (256 - DEPTH * 32) * NWAVES;
    p0_weights(F, 0, P0_LAYERS, gwx, NGX);
    {
        const float* x = F.in[I_X]; bf16* XB = (bf16*)(ws + WS_XB); float* rinv = (float*)(ws + WS_RINV1);
        for (int m0 = 4 * gwx; m0 < M; m0 += 4 * NGX) {
            f32x4 v[4][4]; float s4[4];
#pragma unroll
            for (int a = 0; a < 4; ++a) { const f32x4* xr = (const f32x4*)(x + (size_t)(m0 + a) * D) + F.lane;
#pragma unroll
                for (int j = 0; j < 4; ++j) v[a][j] = xr[64 * j]; }
#pragma unroll
            for (int a = 0; a < 4; ++a) { float s = 0.f;
#pragma unroll
                for (int j = 0; j < 4; ++j) s += (v[a][j].x * v[a][j].x + v[a][j].y * v[a][j].y) + (v[a][j].z * v[a][j].z + v[a][j].w * v[a][j].w);
                s4[a] = wave_sum(s, F.lane);
                u32x2* o = (u32x2*)(XB + (size_t)(m0 + a) * D) + F.lane;
#pragma unroll
                for (int j = 0; j < 4; ++j) { u32x2 w; w.x = pk2(v[a][j].x, v[a][j].y); w.y = pk2(v[a][j].z, v[a][j].w); o[64 * j] = w; } }
            if (F.lane < 4) { const float s = F.lane == 0 ? s4[0] : (F.lane == 1 ? s4[1] : (F.lane == 2 ? s4[2] : s4[3])); rinv[m0 + F.lane] = 1.0f / sqrtf(s * (1.0f / D) + NORM_EPS); }
        }
    }
    {
        bf16* lf = (bf16*)(ws + WS_LRUF);
        for (int i = gwx * 64 + F.lane; i < DEPTH * 2 * 8 * 2 * 2 * 4 * 64; i += NGX * 64) {
            const int ln = i & 63, ks = (i >> 6) & 3, gate = (i >> 8) & 1, nh = (i >> 9) & 1, hb = (i >> 10) & 7, ld = i >> 13;
            const float* W = F.in[gate ? I_LWI : I_LWR] + ((size_t)ld * 8 + hb) * 4096 + nh * 32 + (ln & 31);
            const int k0 = 16 * ks + 8 * (ln >> 5);
            u32x4 o; o.x = pk2(W[(size_t)(k0 + 0) * 64], W[(size_t)(k0 + 1) * 64]); o.y = pk2(W[(size_t)(k0 + 2) * 64], W[(size_t)(k0 + 3) * 64]);
            o.z = pk2(W[(size_t)(k0 + 4) * 64], W[(size_t)(k0 + 5) * 64]); o.w = pk2(W[(size_t)(k0 + 6) * 64], W[(size_t)(k0 + 7) * 64]);
            *(u32x4*)(lf + (size_t)i * 8) = o;
        }
    }
    {
        float* wrt = (float*)(ws + WS_WRT);
        for (int i = gwx * 64 + F.lane; i < DEPTH * 20 * D; i += NGX * 64) {
            const int k = i % D, j = (i / D) % 20, l = i / (20 * D);
            const float g2 = F.in[I_N2G][l * D + k];
            wrt[i] = g2 * (j < 4 ? F.in[I_WG][((size_t)l * D + k) * 4 + j] : F.in[I_WE][((size_t)l * D + k) * 16 + (j - 4)]);
        }
    }
}

typedef float f32x16 __attribute__((ext_vector_type(16)));
#define MFMA32(a, b, c) __builtin_amdgcn_mfma_f32_32x32x16_bf16((a), (b), (c), 0, 0, 0)
constexpr int S5_ETAB = 0, S5_UIMG = 8192, S5_HIMG = 8192 + 67584, S5_CSTR = 528;

__device__ __forceinline__ void s5_setup_item(Frame& F, int l, int g) {
    LAS float* PW = (LAS float*)F.lds;
    LAS float* BB = PW + 4352;
    LAS float* CC = BB + 4096;
    LAS float* KT = CC + 2048;
    const int tid = F.tid;
    __syncthreads();
    if (tid < 128) {
        const int d = tid >> 6, n = tid & 63, ld = l * 2 + d;
        const float are = F.in[I_ARE][(size_t)ld * 2048 + g * 64 + n], aim = F.in[I_AIM][(size_t)ld * 2048 + g * 64 + n];
        const float step = expf(F.in[I_LSTEP][ld * 32 + g]);
        const double ang1 = (double)aim * (double)step, lm1 = (double)are * (double)step;
        float abr = 0.f, abi = 0.f;
        for (int j = 0; j <= 16; ++j) { const double a = fmod(ang1 * j, 6.283185307179586); float sn, cs; sincosf((float)a, &sn, &cs); const float mg = expf((float)(lm1 * j));
            PW[((d * 64 + n) * 17 + j) * 2] = mg * cs; PW[((d * 64 + n) * 17 + j) * 2 + 1] = mg * sn; if (j == 1) { abr = mg * cs; abi = mg * sn; } }
        { float* lam = (float*)(F.ws + WS_S5LAM) + ((((size_t)l * 32 + g) * 2 + d) * 64 + n) * 4;
          const double a16 = fmod(ang1 * 16.0, 6.283185307179586), a256 = fmod(ang1 * 256.0, 6.283185307179586); float sn, cs;
          sincosf((float)a16, &sn, &cs); const float m16 = expf((float)(lm1 * 16.0)); lam[0] = m16 * cs; lam[1] = m16 * sn;
          sincosf((float)a256, &sn, &cs); const float m256 = expf((float)(lm1 * 256.0)); lam[2] = m256 * cs; lam[3] = m256 * sn; }
        const float den = are * are + aim * aim, nr = abr - 1.0f;
        const float sr = (nr * are + abi * aim) / den, si = (abi * are - nr * aim) / den;
        const float* bre = F.in[I_BRE] + ((size_t)ld * 2048 + g * 64 + n) * 16; const float* bim = F.in[I_BIM] + ((size_t)ld * 2048 + g * 64 + n) * 16;
        for (int c = 0; c < 16; ++c) { BB[((d * 64 + n) * 16 + c) * 2] = sr * bre[c] - si * bim[c]; BB[((d * 64 + n) * 16 + c) * 2 + 1] = sr * bim[c] + si * bre[c]; }
    }
    for (int i = tid; i < 1024; i += NTHREADS) { CC[i * 2] = F.in[I_CRE][((size_t)l * 32 + g) * 1024 + i]; CC[i * 2 + 1] = F.in[I_CIM][((size_t)l * 32 + g) * 1024 + i]; }
    __syncthreads();
    for (int q = tid; q < 8192; q += NTHREADS) {
        const int c = q & 15, cp = (q >> 4) & 15, dl = (q >> 8) & 15, d = q >> 12; float acc = 0.f;
        for (int n = 0; n < 64; ++n) { const float cr = CC[(cp * 64 + n) * 2], ci = CC[(cp * 64 + n) * 2 + 1], pr = PW[((d * 64 + n) * 17 + dl) * 2], pi = PW[((d * 64 + n) * 17 + dl) * 2 + 1];
            const float br = BB[((d * 64 + n) * 16 + c) * 2], bi = BB[((d * 64 + n) * 16 + c) * 2 + 1]; acc += (cr * pr - ci * pi) * br - (cr * pi + ci * pr) * bi; }
        KT[q] = acc;
    }
    __syncthreads();
    bf16* WsF = (bf16*)(F.ws + WS_S5MAT) + ((size_t)l * 32 + g) * 196608; bf16* W3F = WsF + 65536;
    for (int q = tid; q < 8192; q += NTHREADS) {
        const int row = q >> 5, kc = (q & 31) * 8, s_ = kc >> 4, c0 = kc & 15;
        const int nn = row & 31, ri = (row >> 5) & 1, sh = (row >> 6) & 1, d = row >> 7, n = sh * 32 + nn, e = d ? s_ : 15 - s_;
        const float pr = PW[((d * 64 + n) * 17 + e) * 2], pi = PW[((d * 64 + n) * 17 + e) * 2 + 1]; float v[8];
#pragma unroll
        for (int j = 0; j < 8; ++j) { const float br = BB[((d * 64 + n) * 16 + c0 + j) * 2], bi = BB[((d * 64 + n) * 16 + c0 + j) * 2 + 1]; v[j] = ri ? (pr * bi + pi * br) : (pr * br - pi * bi); }
        u32x4 o; o.x = pk2(v[0], v[1]); o.y = pk2(v[2], v[3]); o.z = pk2(v[4], v[5]); o.w = pk2(v[6], v[7]);
        const int tile = row >> 5, ks = kc >> 4, ln = (row & 31) + 32 * ((kc >> 3) & 1);
        *(u32x4*)(WsF + ((size_t)(tile * 16 + ks) * 64 + ln) * 8) = o;
    }
    const float* dsk = F.in[I_SD] + l * BW + g * 16;
    for (int q = tid; q < 16384; q += NTHREADS) {
        const int row = q >> 6, kc = (q & 63) * 8, tau = row >> 4, cp = row & 15; float v[8];
        if (kc < 256) { const int s_ = kc >> 4, c0 = kc & 15;
#pragma unroll
            for (int j = 0; j < 8; ++j) { float m = 0.f; if (s_ <= tau) m += KT[((0 * 16 + (tau - s_)) * 16 + cp) * 16 + c0 + j]; if (s_ >= tau) m += KT[((1 * 16 + (s_ - tau)) * 16 + cp) * 16 + c0 + j];
                if (s_ == tau && c0 + j == cp) m += dsk[cp]; v[j] = m; }
        } else {
#pragma unroll
            for (int j = 0; j < 8; ++j) { const int kh = kc - 256 + j, d = kh >> 7, n = (kh & 127) >> 1, ri = kh & 1, p = d ? 16 - tau : tau + 1;
                const float cr = CC[(cp * 64 + n) * 2], ci = CC[(cp * 64 + n) * 2 + 1], pr = PW[((d * 64 + n) * 17 + p) * 2], pi = PW[((d * 64 + n) * 17 + p) * 2 + 1];
                v[j] = ri ? -(cr * pi + ci * pr) : (cr * pr - ci * pi); }
        }
        u32x4 o; o.x = pk2(v[0], v[1]); o.y = pk2(v[2], v[3]); o.z = pk2(v[4], v[5]); o.w = pk2(v[6], v[7]);
        const int tile = row >> 5, ks = kc >> 4, ln = (row & 31) + 32 * ((kc >> 3) & 1);
        *(u32x4*)(W3F + ((size_t)(tile * 32 + ks) * 64 + ln) * 8) = o;
    }
}


__device__ __forceinline__ void s5_scan_a(f32x16& re, f32x16& im, float Lr, float Li, LAS float* e) {
#pragma unroll
    for (int i = 1; i < 16; ++i) { const float pr = re[i - 1], pi = im[i - 1]; re[i] += Lr * pr - Li * pi; im[i] += Lr * pi + Li * pr; }
    e[0] = re[15]; e[1] = im[15];
}
__device__ __forceinline__ void s5_scan_b(f32x16& re, f32x16& im, float Lr, float Li, float L16r, float L16i, const LAS float* et, int sg, LAS unsigned char* hp, int hstep) {
    float cr = 0.f, ci = 0.f;
#pragma unroll
    for (int sp = 0; sp < 8; ++sp) { const bool use = sp < sg; const float er = et[sp * 64], ei = et[sp * 64 + 1];
        const float nr_ = L16r * cr - L16i * ci + er, ni_ = L16r * ci + L16i * cr + ei; cr = use ? nr_ : cr; ci = use ? ni_ : ci; }
    float pr = Lr, pi = Li;
#pragma unroll
    for (int i = 0; i < 16; ++i) { re[i] += pr * cr - pi * ci; im[i] += pr * ci + pi * cr; const float t = pr * Lr - pi * Li; pi = pr * Li + pi * Lr; pr = t; }
#pragma unroll
    for (int i = 0; i < 16; ++i) *(LAS unsigned*)(hp + i * hstep) = pk2(re[i], im[i]);
}

__device__ __forceinline__ void s5_mfma(Frame& F, int l) {
    const bf16* Z1 = (const bf16*)(F.ws + WS_Z1); bf16* YS = (bf16*)(F.ws + WS_YS);
    LAS unsigned char* UIMG = F.lds + S5_UIMG; LAS unsigned char* HIMG = F.lds + S5_HIMG; LAS float* ETAB = (LAS float*)(F.lds + S5_ETAB);
    const int tid = F.tid, lane = F.lane, w = F.wave, r = lane & 31, h = lane >> 5;
    for (int item = (F.wg >= 128 ? (F.wg - 128) * 4 : 0); item < (F.wg >= 128 ? (F.wg - 128) * 4 + 4 : 0); ++item) {
        const int b = item >> 5, g = item & 31;
        const bf16* WsF = (const bf16*)(F.ws + WS_S5MAT) + ((size_t)l * 32 + g) * 196608; const bf16* W3F = WsF + 65536;
        __syncthreads();
        { u32x4 uv[8];
#pragma unroll
          for (int q = 0; q < 8; ++q) { const int p = tid + q * NTHREADS, token = p >> 1, half = p & 1; uv[q] = *(const u32x4*)(Z1 + ((size_t)b * SEQ + token) * ZC + COL_U + g * 16 + half * 8); }
#pragma unroll
          for (int q = 0; q < 8; ++q) { const int p = tid + q * NTHREADS, token = p >> 1, half = p & 1; *(LAS u32x4*)(UIMG + (token >> 4) * S5_CSTR + (token & 15) * 32 + half * 16) = uv[q]; } }
        { unsigned z = 0u; asm volatile("" : "+v"(z));
          if (tid < 16) *(LAS u32x4*)(HIMG + 1 * S5_CSTR + tid * 16) = (u32x4){z, z, z, z};
          else if (tid < 32) *(LAS u32x4*)(HIMG + 128 * S5_CSTR + 256 + (tid - 16) * 16) = (u32x4){z, z, z, z}; }
        __syncthreads();
        const int d = w >> 2, sh = (w >> 1) & 1, mh = w & 1;
        f32x16 sre[2], sim[2];
#pragma unroll
        for (int i = 0; i < 16; ++i) { sre[0][i] = 0.f; sre[1][i] = 0.f; sim[0][i] = 0.f; sim[1][i] = 0.f; }
        {
            const int qf = 16 * ((r >> 2) & 1) + 4 * (r >> 3) + (r & 3);
            const int qr = d ? 127 - (64 * mh + qf) : 64 * mh + qf;
            const bf16* bre = WsF + ((size_t)(((d * 2 + sh) * 2 + 0) * 16) * 64 + lane) * 8; const bf16* bim = bre + (size_t)16 * 64 * 8;
            const LAS unsigned char* a0 = UIMG + qr * S5_CSTR + 16 * h; const LAS unsigned char* a1 = UIMG + (d ? qr - 32 : qr + 32) * S5_CSTR + 16 * h;
            unsigned zq = 0u; asm volatile("" : "+v"(zq));
            u32x4 gre[4], gim[4], l0, l1, ore, oim, ox0, ox1;
#pragma unroll
            for (int q = 0; q < 4; ++q) { gre[q] = *(const u32x4*)(bre + q * 512); gim[q] = *(const u32x4*)(bim + q * 512); }
            l0 = *(const LAS u32x4*)(a0); l1 = *(const LAS u32x4*)(a1);
            ore = oim = ox0 = ox1 = (u32x4){0u, 0u, 0u, 0u};
#pragma unroll
            for (int ks = 0; ks < 16; ++ks) {
                asm volatile("s_nop 15\n\ts_nop 15" : "+v"(zq), "+v"(ore), "+v"(oim), "+v"(ox0), "+v"(ox1));
                ore = gre[ks & 3] ^ zq; oim = gim[ks & 3] ^ zq; ox0 = l0 ^ zq; ox1 = l1 ^ zq;
                asm volatile("" : "+v"(ore), "+v"(oim), "+v"(ox0), "+v"(ox1));
                if (ks + 4 < 16) { gre[ks & 3] = *(const u32x4*)(bre + (ks + 4) * 512); gim[ks & 3] = *(const u32x4*)(bim + (ks + 4) * 512); }
                if (ks + 1 < 16) { l0 = *(const LAS u32x4*)(a0 + (ks + 1) * 32); l1 = *(const LAS u32x4*)(a1 + (ks + 1) * 32); }
                sre[0] = MFMA32(__builtin_bit_cast(bf16x8, ox0), __builtin_bit_cast(bf16x8, ore), sre[0]); sim[0] = MFMA32(__builtin_bit_cast(bf16x8, ox0), __builtin_bit_cast(bf16x8, oim), sim[0]);
                sre[1] = MFMA32(__builtin_bit_cast(bf16x8, ox1), __builtin_bit_cast(bf16x8, ore), sre[1]); sim[1] = MFMA32(__builtin_bit_cast(bf16x8, ox1), __builtin_bit_cast(bf16x8, oim), sim[1]);
            }
            asm volatile("" : "+v"(ore), "+v"(oim), "+v"(ox0), "+v"(ox1));
        }
        __builtin_amdgcn_sched_barrier(0);
        asm volatile("s_nop 15\n\ts_nop 15\n\ts_nop 15\n\ts_nop 15\n\ts_nop 15" : "+v"(sre[0]), "+v"(sre[1]), "+v"(sim[0]), "+v"(sim[1]));
        __builtin_amdgcn_sched_barrier(0);

        const int n = sh * 32 + r;
        const f32x4 lam = *(const f32x4*)((const float*)(F.ws + WS_S5LAM) + ((((size_t)l * 32 + g) * 2 + d) * 64 + n) * 4);
        LAS float* et = ETAB + ((d * 2 + sh) * 8) * 64 + r * 2;
        const int sg0 = 4 * mh + h, sg1 = sg0 + 2;
        s5_scan_a(sre[0], sim[0], lam[0], lam[1], et + sg0 * 64); s5_scan_a(sre[1], sim[1], lam[0], lam[1], et + sg1 * 64);
        __syncthreads();
        {
            const int cs0 = 16 * sg0, cs1 = 16 * sg1, hstep = d ? -S5_CSTR : S5_CSTR;
            LAS unsigned char* hcol = HIMG + d * 256 + 4 * n;
            s5_scan_b(sre[0], sim[0], lam[0], lam[1], lam[2], lam[3], et, sg0, hcol + (d ? 127 - cs0 : cs0 + 2) * S5_CSTR, hstep);
            s5_scan_b(sre[1], sim[1], lam[0], lam[1], lam[2], lam[3], et, sg1, hcol + (d ? 127 - cs1 : cs1 + 2) * S5_CSTR, hstep);
        }
        __syncthreads();
        f32x16 acc[4];
#pragma unroll
        for (int nt = 0; nt < 4; ++nt)
#pragma unroll
            for (int i = 0; i < 16; ++i) acc[nt][i] = 0.f;
        {
            const bf16* ap = W3F + ((size_t)(w * 32) * 64 + lane) * 8;
            unsigned bxa[4], bha[4];
#pragma unroll
            for (int nt = 0; nt < 4; ++nt) { bxa[nt] = (unsigned)(S5_UIMG + (nt * 32 + r) * S5_CSTR + 16 * h); bha[nt] = (unsigned)(S5_HIMG + (nt * 32 + r + 1) * S5_CSTR + 16 * h); }
            unsigned zq = 0u; asm volatile("" : "+v"(zq));
            u32x4 ga[4], lx[4], oa, ox[4];
#pragma unroll
            for (int q = 0; q < 4; ++q) ga[q] = *(const u32x4*)(ap + q * 512);
#pragma unroll
            for (int nt = 0; nt < 4; ++nt) { lx[nt] = *(const LAS u32x4*)(F.lds + bxa[nt]); ox[nt] = (u32x4){0u, 0u, 0u, 0u}; }
            oa = (u32x4){0u, 0u, 0u, 0u};
#pragma unroll
            for (int ks = 0; ks < 32; ++ks) {
                asm volatile("s_nop 15\n\ts_nop 15" : "+v"(zq), "+v"(oa), "+v"(ox[0]), "+v"(ox[1]), "+v"(ox[2]), "+v"(ox[3]));
                oa = ga[ks & 3] ^ zq;
#pragma unroll
                for (int nt = 0; nt < 4; ++nt) ox[nt] = lx[nt] ^ zq;
                asm volatile("" : "+v"(oa), "+v"(ox[0]), "+v"(ox[1]), "+v"(ox[2]), "+v"(ox[3]));
                if (ks + 4 < 32) ga[ks & 3] = *(const u32x4*)(ap + (ks + 4) * 512);
                if (ks + 1 < 32) {
#pragma unroll
                    for (int nt = 0; nt < 4; ++nt) lx[nt] = *(const LAS u32x4*)(F.lds + ((ks + 1) < 16 ? bxa[nt] + (ks + 1) * 32 : bha[nt] + (ks + 1 - 16) * 32));
                }
#pragma unroll
                for (int nt = 0; nt < 4; ++nt) acc[nt] = MFMA32(__builtin_bit_cast(bf16x8, oa), __builtin_bit_cast(bf16x8, ox[nt]), acc[nt]);
            }
            asm volatile("" : "+v"(oa), "+v"(ox[0]), "+v"(ox[1]), "+v"(ox[2]), "+v"(ox[3]));
            asm volatile("" :: "v"(bxa[0]), "v"(bxa[1]), "v"(bxa[2]), "v"(bxa[3]), "v"(bha[0]), "v"(bha[1]), "v"(bha[2]), "v"(bha[3]));
        }
        __builtin_amdgcn_sched_barrier(0);
        asm volatile("s_nop 15\n\ts_nop 15\n\ts_nop 15\n\ts_nop 15\n\ts_nop 15" : "+v"(acc[0]), "+v"(acc[1]), "+v"(acc[2]), "+v"(acc[3]));
        __builtin_amdgcn_sched_barrier(0);
#pragma unroll
        for (int nt = 0; nt < 4; ++nt)
#pragma unroll
            for (int gq = 0; gq < 4; ++gq) { const int tau = 2 * w + (gq >> 1), cp = 8 * (gq & 1) + 4 * h, token = (32 * nt + r) * 16 + tau;
                u32x2 o; o.x = pk2hw(gelu_tanh(acc[nt][4 * gq]), gelu_tanh(acc[nt][4 * gq + 1])); o.y = pk2hw(gelu_tanh(acc[nt][4 * gq + 2]), gelu_tanh(acc[nt][4 * gq + 3]));
                *(u32x2*)(YS + ((size_t)b * SEQ + token) * BW + g * 16 + cp) = o; }
    }
    __syncthreads();
}


#define MFMA_FENCE3(a, b, c) asm volatile("s_nop 15\n\ts_nop 15\n\ts_nop 15\n\ts_nop 15\n\ts_nop 15" : "+v"(a), "+v"(b), "+v"(c))
__device__ __forceinline__ void lru_half_scan(f32x16& aR, f32x16& aI, const f32x16& aX, float br, float bi, float lamc, LAS float* sgw) {
    float Pp = 1.f, Hh = 0.f;
#pragma unroll
    for (int i = 0; i < 16; ++i) {
        const float rg = sigmoidf_(aR[i] + br), ig = sigmoidf_(aI[i] + bi), x2 = 2.0f * lamc * rg;
        const float a = __builtin_amdgcn_exp2f(0.72134752044f * x2);
        const float om = -x2 * (1.0f + x2 * (0.5f + x2 * (0.16666667f + x2 * (0.041666668f + x2 * (0.008333334f + x2 * 0.0013888889f)))));
        const float u = __builtin_amdgcn_sqrtf(fmaxf(om, 0.f)) * ig * aX[i];
        Hh = a * Hh + u; Pp = a * Pp; aR[i] = Hh; aI[i] = Pp;
        if ((i & 3) == 3) asm volatile("" : "+v"(Hh), "+v"(Pp));
    }
    sgw[0] = Pp; sgw[1] = Hh;
}
constexpr int LRU_TILE = 16384, LRU_TILE_BYTES = 33 * 1024;
__device__ __forceinline__ void lru_mfma(Frame& F, int l) {
    const bf16* Z1 = (const bf16*)(F.ws + WS_Z1); bf16* OL = (bf16*)(F.ws + WS_OL);
    LAS float* CW = (LAS float*)F.lds;
    LAS float* SEG = CW + 320;
    const int tid = F.tid, lane = F.lane, w = F.wave, r = lane & 31, hh = lane >> 5;
    for (int item = F.wg; item < (F.wg < 128 ? BATCH * 8 : 0); item += 128) {
        const int b = item >> 3, hb = item & 7, ch0 = hb * 64 + r;
        __syncthreads();
        if (tid < 256) CW[tid] = F.in[I_CONVW][((size_t)l * 4 + (tid >> 6)) * BW + hb * 64 + (tid & 63)];
        else if (tid < 320) CW[tid] = F.in[I_CONVB][l * BW + hb * 64 + (tid - 256)];
        const int qf = 16 * ((r >> 2) & 1) + 4 * (r >> 3) + (r & 3);
        const bf16* xrb = Z1 + (size_t)b * SEQ * ZC + COL_XR + hb * 64 + (lane & 7) * 8;
#pragma unroll 1
        for (int dir = 0; dir < 2; ++dir) {
            bf16x8 wr[2][4], wi[2][4];
#pragma unroll
            for (int nh = 0; nh < 2; ++nh) { const bf16* lf = (const bf16*)(F.ws + WS_LRUF) + ((((((size_t)l * 2 + dir) * 8 + hb) * 2 + nh) * 2) * 4 * 64 + lane) * 8;
#pragma unroll
              for (int ks = 0; ks < 4; ++ks) { wr[nh][ks] = *(const bf16x8*)(lf + (size_t)ks * 512); wi[nh][ks] = *(const bf16x8*)(lf + (size_t)(4 + ks) * 512); } }
            float br[2], bi[2], lamc[2], carry[2] = {0.f, 0.f};
#pragma unroll
            for (int nh = 0; nh < 2; ++nh) { const int ch = ch0 + 32 * nh; br[nh] = F.in[I_LBR][((size_t)l * 2 + dir) * BW + ch]; bi[nh] = F.in[I_LBI][((size_t)l * 2 + dir) * BW + ch];
                lamc[nh] = -8.0f * log1pf(expf(-F.in[I_LAM][((size_t)l * 2 + dir) * BW + ch])); }
#define LRU_STAGE(SC) do { const int tlo_ = dir ? SEQ - 256 * ((SC) + 1) : 256 * (SC); \
                for (int j_ = w; j_ < 33; j_ += NWAVES) { int t_ = tlo_ - 2 + 8 * j_ + (lane >> 3); t_ = t_ < 0 ? 0 : (t_ >= SEQ ? SEQ - 1 : t_); \
                    __builtin_amdgcn_global_load_lds((const unsigned*)(xrb + (size_t)t_ * ZC), (LAS unsigned*)(F.lds + LRU_TILE + ((SC) & 1) * LRU_TILE_BYTES + j_ * 1024), 16, 0, 0); } } while (0)
            LRU_STAGE(0);
#pragma unroll 1
            for (int sc = 0; sc < 8; ++sc) {
                asm volatile("s_waitcnt vmcnt(0)" ::: "memory"); __syncthreads();
                if (sc + 1 < 8) LRU_STAGE(sc + 1);
                const int srow = sc * 256 + w * 32 + qf, trow = dir ? (SEQ - 1 - srow) : srow, tlo = dir ? SEQ - 256 * (sc + 1) : 256 * sc;
                const LAS unsigned char* tl = F.lds + LRU_TILE + (sc & 1) * LRU_TILE_BYTES + (trow - tlo) * 128 + 16 * hh;
                bf16x8 av[4];
#pragma unroll
                for (int ks = 0; ks < 4; ++ks) {
                    const int c0 = 16 * ks + 8 * hh;
                    float xv[8];
#pragma unroll
                    for (int j = 0; j < 8; ++j) xv[j] = CW[256 + c0 + j];
#pragma unroll
                    for (int tap = 0; tap < 4; ++tap) { const int tt = trow + tap - 2; const float msk = (tt >= 0 && tt < SEQ) ? 1.0f : 0.0f;
                        const bf16x8 v = *(const LAS bf16x8*)(tl + tap * 128 + ks * 32);
#pragma unroll
                        for (int j = 0; j < 8; ++j) xv[j] += (CW[tap * 64 + c0 + j] * msk) * bf2f((bf16)v[j]); }
                    u32x4 pa; pa.x = pk2hw(xv[0], xv[1]); pa.y = pk2hw(xv[2], xv[3]); pa.z = pk2hw(xv[4], xv[5]); pa.w = pk2hw(xv[6], xv[7]);
                    av[ks] = __builtin_bit_cast(bf16x8, pa);
                }
                const int st0 = sc * 256 + w * 32 + 16 * hh; const size_t tok0 = (size_t)b * SEQ + (dir ? (SEQ - 1 - st0) : st0); const long tstep = dir ? -1 : 1;
#pragma unroll
                for (int nh = 0; nh < 2; ++nh) {
                    const int ch = ch0 + 32 * nh;
                    f32x16 aR, aI, aX;
#pragma unroll
                    for (int i = 0; i < 16; ++i) { aR[i] = 0.f; aI[i] = 0.f; aX[i] = 0.f; }
                    bf16x8 idf[4];
#pragma unroll
                    for (int ks = 0; ks < 4; ++ks) { u32x4 pd_;
#pragma unroll
                        for (int jj = 0; jj < 4; ++jj) { const int k0 = 16 * ks + 8 * hh + 2 * jj; pd_[jj] = (k0 == nh * 32 + r ? 0x3f80u : 0u) | (k0 + 1 == nh * 32 + r ? 0x3f800000u : 0u); }
                        idf[ks] = __builtin_bit_cast(bf16x8, pd_); }
                    __builtin_amdgcn_sched_barrier(0);
#pragma unroll
                    for (int ks = 0; ks < 4; ++ks) { aR = MFMA32(av[ks], wr[nh][ks], aR); aI = MFMA32(av[ks], wi[nh][ks], aI); aX = MFMA32(av[ks], idf[ks], aX); }
                    __builtin_amdgcn_sched_barrier(0);
                    MFMA_FENCE3(aR, aI, aX);
                    __builtin_amdgcn_sched_barrier(0);
                    bf16 hfv[16], grv[16];
                    if (dir) {
#pragma unroll
                        for (int i = 0; i < 16; ++i) { const size_t tok = tok0 + tstep * i; hfv[i] = OL[tok * BW + ch]; grv[i] = Z1[tok * ZC + COL_GR + ch]; }
                    }
                    LAS float* sg = SEG + nh * 1024;
                    lru_half_scan(aR, aI, aX, br[nh], bi[nh], lamc[nh], sg + ((2 * w + hh) * 32 + r) * 2);
                    __syncthreads();
                    float cin = 0.f, X = carry[nh];
#pragma unroll
                    for (int sp = 0; sp < 16; ++sp) { cin = (sp == 2 * w + hh) ? X : cin; X = sg[(sp * 32 + r) * 2] * X + sg[(sp * 32 + r) * 2 + 1]; }
                    carry[nh] = X;
                    if (dir == 0) {
#pragma unroll
                        for (int i = 0; i < 16; i += 2) { const unsigned p = pk2hw(aR[i] + aI[i] * cin, aR[i + 1] + aI[i + 1] * cin);
                            OL[(tok0 + tstep * i) * BW + ch] = (bf16)(p & 0xffffu); OL[(tok0 + tstep * (i + 1)) * BW + ch] = (bf16)(p >> 16); }
                    } else {
#pragma unroll
                        for (int i = 0; i < 16; i += 2) { const unsigned p = pk2hw(gelu_tanh(bf2f(grv[i])) * (bf2f(hfv[i]) + aR[i] + aI[i] * cin), gelu_tanh(bf2f(grv[i + 1])) * (bf2f(hfv[i + 1]) + aR[i + 1] + aI[i + 1] * cin));
                            OL[(tok0 + tstep * i) * BW + ch] = (bf16)(p & 0xffffu); OL[(tok0 + tstep * (i + 1)) * BW + ch] = (bf16)(p >> 16); }
                    }
                }
            }
            asm volatile("s_waitcnt vmcnt(0)" ::: "memory"); __syncthreads();
        }
    }
    __syncthreads();
}

#ifndef ATT_LO
#define ATT_LO 1
#endif
constexpr int AT_KSTR = 144, AT_VSTR = 776, AT_K = 0, AT_V = 384 * AT_KSTR;
__device__ __forceinline__ void attn_mfma(Frame& F, int l) {
    const bf16* Z1 = (const bf16*)(F.ws + WS_Z1); bf16* OA = (bf16*)(F.ws + WS_OA);
    LAS unsigned char* KL = F.lds + AT_K; LAS unsigned char* VT = F.lds + AT_V;
    const int tid = F.tid, lane = F.lane, w = F.wave, r = lane & 31, hh = lane >> 5;
    const float LOG2E = 1.4426950408889634f;
    for (int k = 0; k < (F.wg < 128 ? ATT_LO : 4 - ATT_LO); ++k) {
        const int item = F.wg < 128 ? F.wg * ATT_LO + k : 128 * ATT_LO + (F.wg - 128) * (4 - ATT_LO) + k;
        const int b = item >> 5, nb = (item >> 1) & 15, kvh = item & 1;
        __syncthreads();
        { u32x4 kq[6], vq[6];
#pragma unroll
          for (int q = 0; q < 6; ++q) { const int p = tid + q * NTHREADS, kj = p >> 3, dc = p & 7, sp = nb * 128 - 128 + kj; const bool ok = (sp >= 0 && sp < SEQ);
              const bf16* base = Z1 + ((size_t)b * SEQ + (ok ? sp : 0)) * ZC + kvh * 64 + dc * 8; kq[q] = *(const u32x4*)(base + COL_K); vq[q] = *(const u32x4*)(base + COL_V);
              if (!ok) { kq[q] = (u32x4){0u, 0u, 0u, 0u}; vq[q] = (u32x4){0u, 0u, 0u, 0u}; } }
#pragma unroll
          for (int q = 0; q < 6; ++q) { const int p = tid + q * NTHREADS, kj = p >> 3, dc = p & 7; const u32x4 vv = vq[q];
              *(LAS u32x4*)(KL + kj * AT_KSTR + dc * 16) = kq[q];
              LAS bf16* vt = (LAS bf16*)(VT + (dc * 8) * AT_VSTR + kj * 2);
              vt[0 * (AT_VSTR / 2)] = (bf16)(vv.x & 0xffffu); vt[1 * (AT_VSTR / 2)] = (bf16)(vv.x >> 16); vt[2 * (AT_VSTR / 2)] = (bf16)(vv.y & 0xffffu); vt[3 * (AT_VSTR / 2)] = (bf16)(vv.y >> 16);
              vt[4 * (AT_VSTR / 2)] = (bf16)(vv.z & 0xffffu); vt[5 * (AT_VSTR / 2)] = (bf16)(vv.z >> 16); vt[6 * (AT_VSTR / 2)] = (bf16)(vv.w & 0xffffu); vt[7 * (AT_VSTR / 2)] = (bf16)(vv.w >> 16); } }
        __syncthreads();
#pragma unroll 1
        for (int task = w; task < 16; task += NWAVES) {
            const int g = task >> 2, qt = task & 3, hq = kvh * 4 + g;
            const size_t tokq = (size_t)b * SEQ + nb * 128 + 32 * qt + r;
            bf16x8 qf[4];
#pragma unroll
            for (int ks = 0; ks < 4; ++ks) qf[ks] = *(const bf16x8*)(Z1 + tokq * ZC + COL_Q + hq * 64 + 16 * ks + 8 * hh);
            const float slope2 = exp2f(-(float)(hq + 1)) * LOG2E, sink2 = F.in[I_SINK][l * NQ + hq] * LOG2E;
            float m = sink2, lsum = 1.0f;
            f32x16 o0, o1;
#pragma unroll
            for (int i = 0; i < 16; ++i) { o0[i] = 0.f; o1[i] = 0.f; }
            u32x4 pp0 = (u32x4){0u, 0u, 0u, 0u}, pp1 = pp0, va0 = pp0, va1 = pp0, va2 = pp0, va3 = pp0;
#pragma unroll 1
            for (int kt = qt; kt < qt + 9; ++kt) {
                f32x16 sc;
#pragma unroll
                for (int i = 0; i < 16; ++i) sc[i] = 0.f;
                { const LAS unsigned char* kp = KL + (32 * kt + r) * AT_KSTR + 16 * hh;
#pragma unroll
                  for (int ks = 0; ks < 4; ++ks) { const bf16x8 a = *(const LAS bf16x8*)(kp + ks * 32); sc = MFMA32(a, qf[ks], sc); } }
                __builtin_amdgcn_sched_barrier(0);
                asm volatile("s_nop 15\n\ts_nop 15\n\ts_nop 15\n\ts_nop 15\n\ts_nop 15" : "+v"(sc), "+v"(o0), "+v"(o1), "+v"(pp0), "+v"(pp1), "+v"(va0), "+v"(va1), "+v"(va2), "+v"(va3));
                __builtin_amdgcn_sched_barrier(0);
                const float fd0 = (float)(128 + 32 * qt + r - 32 * kt - 4 * hh);
                const bool inwin = (kt > qt) && (kt < qt + 8), inseq = (nb * 128 - 128 + 32 * kt >= 0) && (nb * 128 - 128 + 32 * kt + 31 < SEQ);
                float tmax = -1e30f;
                if (inwin && inseq) {
#pragma unroll
                    for (int i = 0; i < 16; ++i) { const float dd = fd0 - (float)((i & 3) + 8 * (i >> 2)); const float v = sc[i] * (0.125f * LOG2E) - slope2 * __builtin_fabsf(dd); sc[i] = v; tmax = fmaxf(tmax, v); }
                } else {
#pragma unroll
                    for (int i = 0; i < 16; ++i) { const int kj = 32 * kt + (i & 3) + 8 * (i >> 2) + 4 * hh, sp = nb * 128 - 128 + kj; const float dd = fd0 - (float)((i & 3) + 8 * (i >> 2)), ad = __builtin_fabsf(dd);
                        const bool valid = (ad <= (float)WIN) && (sp >= 0) && (sp < SEQ);
                        const float v = valid ? (sc[i] * (0.125f * LOG2E) - slope2 * ad) : -1e30f; sc[i] = v; tmax = fmaxf(tmax, v); }
                }
                { const auto sw = __builtin_amdgcn_permlane32_swap(__float_as_uint(tmax), __float_as_uint(tmax), false, false); tmax = fmaxf(__uint_as_float(sw[0]), __uint_as_float(sw[1])); }
                const float mnew = fmaxf(m, tmax), alpha = __builtin_amdgcn_exp2f(m - mnew); m = mnew;
                float psum = 0.f;
#pragma unroll
                for (int i = 0; i < 16; ++i) { const float p = __builtin_amdgcn_exp2f(sc[i] - mnew); sc[i] = p; psum += p; }
                { const auto sw = __builtin_amdgcn_permlane32_swap(__float_as_uint(psum), __float_as_uint(psum), false, false); psum = __uint_as_float(sw[0]) + __uint_as_float(sw[1]); }
                lsum = lsum * alpha + psum;
#pragma unroll
                for (int i = 0; i < 16; ++i) { o0[i] *= alpha; o1[i] *= alpha; }
                pp0.x = pk2hw(sc[0], sc[1]); pp0.y = pk2hw(sc[2], sc[3]); pp0.z = pk2hw(sc[4], sc[5]); pp0.w = pk2hw(sc[6], sc[7]);
                pp1.x = pk2hw(sc[8], sc[9]); pp1.y = pk2hw(sc[10], sc[11]); pp1.z = pk2hw(sc[12], sc[13]); pp1.w = pk2hw(sc[14], sc[15]);
                {   const LAS unsigned char* vp = VT + r * AT_VSTR + (32 * kt + 4 * hh) * 2;
#define AT_LDV(dst, off) do { const u32x2 lo_ = *(const LAS u32x2*)(vp + (off)), hi_ = *(const LAS u32x2*)(vp + (off) + 16); dst.x = lo_.x; dst.y = lo_.y; dst.z = hi_.x; dst.w = hi_.y; } while (0)
                    AT_LDV(va0, 0); AT_LDV(va1, 32 * AT_VSTR); AT_LDV(va2, 32); AT_LDV(va3, 32 * AT_VSTR + 32);
#undef AT_LDV
                    o0 = MFMA32(__builtin_bit_cast(bf16x8, va0), __builtin_bit_cast(bf16x8, pp0), o0); o1 = MFMA32(__builtin_bit_cast(bf16x8, va1), __builtin_bit_cast(bf16x8, pp0), o1);
                    o0 = MFMA32(__builtin_bit_cast(bf16x8, va2), __builtin_bit_cast(bf16x8, pp1), o0); o1 = MFMA32(__builtin_bit_cast(bf16x8, va3), __builtin_bit_cast(bf16x8, pp1), o1); }
            }
            __builtin_amdgcn_sched_barrier(0);
            asm volatile("s_nop 15\n\ts_nop 15\n\ts_nop 15\n\ts_nop 15\n\ts_nop 15" : "+v"(o0), "+v"(o1), "+v"(pp0), "+v"(pp1), "+v"(va0), "+v"(va1), "+v"(va2), "+v"(va3));
            __builtin_amdgcn_sched_barrier(0);
            const float inv = 1.0f / lsum;
            bf16* op = OA + tokq * BW + hq * 64 + 4 * hh;
#pragma unroll
            for (int gq = 0; gq < 4; ++gq) {
                u32x2 w0, w1; w0.x = pk2hw(o0[4 * gq] * inv, o0[4 * gq + 1] * inv); w0.y = pk2hw(o0[4 * gq + 2] * inv, o0[4 * gq + 3] * inv);
                w1.x = pk2hw(o1[4 * gq] * inv, o1[4 * gq + 1] * inv); w1.y = pk2hw(o1[4 * gq + 2] * inv, o1[4 * gq + 3] * inv);
                *(u32x2*)(op + 8 * gq) = w0; *(u32x2*)(op + 32 + 8 * gq) = w1; }
        }
    }
    __syncthreads();
}

__device__ __forceinline__ void p4a_router(Frame& F, int l) {
    LAS float* wl = (LAS float*)F.lds;
    LAS int* bk = (LAS int*)(F.lds + 81920);
    const float* wrt = (const float*)(F.ws + WS_WRT) + (size_t)l * 20 * D;
    for (int i = F.tid; i < 20 * D / 4; i += NTHREADS) ((LAS f32x4*)wl)[i] = ((const f32x4*)wrt)[i];
    __syncthreads();
    const float* X = F.out; float* rinv2 = (float*)(F.ws + WS_RINV2); int* BUCKET = (int*)(F.ws + WS_BUCKET); float* WTOK = (float*)(F.ws + WS_WTOK);
    const int lane = F.lane, tok0 = F.wg * 128 + F.wave * 16;
    float lgv[20], ssv = 0.f;
#pragma unroll
    for (int o = 0; o < 20; ++o) lgv[o] = 0.f;
#pragma unroll 1
    for (int q = 0; q < 8; ++q) {
        f32x4 xv[2][4];
#pragma unroll
        for (int a = 0; a < 2; ++a) { const f32x4* xr = (const f32x4*)(X + (size_t)(tok0 + q * 2 + a) * D) + lane;
#pragma unroll
            for (int j = 0; j < 4; ++j) xv[a][j] = xr[64 * j]; }
#pragma unroll
        for (int a = 0; a < 2; ++a) { float s = 0.f;
#pragma unroll
            for (int j = 0; j < 4; ++j) s += (xv[a][j].x * xv[a][j].x + xv[a][j].y * xv[a][j].y) + (xv[a][j].z * xv[a][j].z + xv[a][j].w * xv[a][j].w);
            const float t = wave_sum(s, lane); ssv = (lane == q * 2 + a) ? t : ssv; }
#pragma unroll
        for (int o = 0; o < 20; ++o) {
            f32x4 w[4];
#pragma unroll
            for (int j = 0; j < 4; ++j) w[j] = ((const LAS f32x4*)(wl + o * D))[lane + 64 * j];
#pragma unroll
            for (int a = 0; a < 2; ++a) { float s = 0.f;
#pragma unroll
                for (int j = 0; j < 4; ++j) s += (xv[a][j].x * w[j].x + xv[a][j].y * w[j].y) + (xv[a][j].z * w[j].z + xv[a][j].w * w[j].w);
                const float t = wave_sum(s, lane); lgv[o] = (lane == q * 2 + a) ? t : lgv[o]; }
            if (o & 1) asm volatile("" ::: "memory");
        }
    }
    {
        const int tok = tok0 + (lane & 15); const float ri = 1.0f / sqrtf(ssv * (1.0f / D) + NORM_EPS);
        float gl[4]; int gi = 0; float gm;
#pragma unroll
        for (int j = 0; j < 4; ++j) gl[j] = lgv[j] * ri + F.in[I_BG][l * 4 + j];
        gm = gl[0];
#pragma unroll
        for (int j = 1; j < 4; ++j) if (gl[j] > gm) { gm = gl[j]; gi = j; }
        float gs = 0.f;
#pragma unroll
        for (int j = 0; j < 4; ++j) gs += expf(gl[j] - gm);
        const float gw = 1.0f / gs;
        float el[4];
#pragma unroll
        for (int e = 0; e < 4; ++e) { float v = 0.f;
#pragma unroll
            for (int g = 0; g < 4; ++g) v = (gi == g) ? (lgv[4 + g * 4 + e] * ri + F.in[I_BE][l * 16 + g * 4 + e]) : v;
            el[e] = v; }
        int i1 = 0; float v1 = el[0];
#pragma unroll
        for (int e = 1; e < 4; ++e) if (el[e] > v1) { v1 = el[e]; i1 = e; }
        int i2 = -1; float v2 = -3.4e38f;
#pragma unroll
        for (int e = 0; e < 4; ++e) if (e != i1 && el[e] > v2) { v2 = el[e]; i2 = e; }
        const float e2 = expf(v2 - v1), w1 = gw / (1.0f + e2), w2 = gw * e2 / (1.0f + e2);
        const int ea = i1 < i2 ? i1 : i2, eb = i1 < i2 ? i2 : i1; const float wa = i1 < i2 ? w1 : w2, wb = i1 < i2 ? w2 : w1;
        const int bucket = gi * 6 + pair_index(ea, eb);
        if (lane < 16) { rinv2[tok] = ri; BUCKET[tok] = bucket; WTOK[2 * tok] = wa; WTOK[2 * tok + 1] = wb; bk[F.wave * 16 + lane] = bucket; }
    }
    __syncthreads();
    if (F.tid < 128) { const int b = bk[F.tid]; int r = 0; for (int i = 0; i < F.tid; ++i) r += (bk[i] == b) ? 1 : 0; ((int*)(F.ws + WS_RANK))[F.wg * 128 + F.tid] = r; }
    if (F.tid >= 128 && F.tid < 128 + 32) { const int b = F.tid - 128; int c = 0; if (b < NBUCKET) for (int i = 0; i < 128; ++i) c += (bk[i] == b) ? 1 : 0; ((int*)(F.ws + WS_HIST))[F.wg * 32 + b] = c; }
    __syncthreads();
}

__device__ __forceinline__ void p4b_positions(Frame& F) {
    LAS int* tot = (LAS int*)F.lds; LAS int* pre = tot + 32; LAS int* base = tot + 64;
    const int* HIST = (const int*)(F.ws + WS_HIST);
    if (F.tid < NBUCKET) { int t = 0, p = 0; for (int w = 0; w < 256; ++w) { const int h = HIST[w * 32 + F.tid]; if (w < F.wg) p += h; t += h; } tot[F.tid] = t; pre[F.tid] = p; }
    __syncthreads();
    if (F.tid == 0) { int a = 0; for (int b = 0; b < NBUCKET; ++b) { base[b] = a; a += (tot[b] + 255) & ~255; } base[NBUCKET] = a; }
    __syncthreads();
    int* IDX = (int*)(F.ws + WS_IDX); float* WSORT = (float*)(F.ws + WS_WSORT); float* RSORT = (float*)(F.ws + WS_RSORT); const float* WTOK = (const float*)(F.ws + WS_WTOK);
    if (F.tid < 128) { const int tok = F.wg * 128 + F.tid; const int b = ((const int*)(F.ws + WS_BUCKET))[tok]; const int pos = base[b] + pre[b] + ((const int*)(F.ws + WS_RANK))[tok];
        IDX[pos] = tok; *(u32x2*)(WSORT + 2 * pos) = (u32x2){__float_as_uint(WTOK[2 * tok]), __float_as_uint(WTOK[2 * tok + 1])}; RSORT[pos] = ((const float*)(F.ws + WS_RINV2))[tok]; }
    if (F.wg == 0) {
        float z = 0.f; asm volatile("" : "+v"(z));
        for (int b = 0; b < NBUCKET; ++b) for (int p = base[b] + tot[b] + F.tid; p < base[b + 1]; p += NTHREADS) { IDX[p] = -1; WSORT[2 * p] = z; WSORT[2 * p + 1] = z; RSORT[p] = z; }
        if (F.tid <= NBUCKET) ((int*)(F.ws + WS_BBASE))[F.tid] = base[F.tid];
    }
    __syncthreads();
}

__device__ __forceinline__ int build_tile_table(Frame& F, LAS int* tb) {
    const int* BB = (const int*)(F.ws + WS_BBASE);
    if (F.tid < 160) { const int r0 = F.tid * 256; int bkt = -1; for (int b = 0; b < NBUCKET; ++b) if (r0 >= BB[b] && r0 < BB[b + 1]) bkt = b; tb[1 + F.tid] = bkt; }
    if (F.tid == 0) tb[0] = BB[NBUCKET] / 256;
    __syncthreads();
    return tb[0];
}

typedef f32x4 AccT[2][2][4][2];
struct EpiZ1 { bf16* Z1; const float* rinv;
    __device__ __forceinline__ bool operator()(const AccT& acc, const pg8::Unit& u, int wr, int wc, int fr, int fq) const {
        asm volatile("" : "+v"(fr), "+v"(fq));
#pragma unroll
        for (int ai = 0; ai < 2; ++ai)
#pragma unroll
            for (int m = 0; m < 4; ++m) { const int row = u.pm * 256 + ai * 128 + wr * 64 + m * 16 + fr; const float ri = rinv[row]; bf16* rowp = Z1 + (size_t)row * ZC + u.pn * 256 + wc * 32 + 8 * fq;
#pragma unroll
                for (int bj = 0; bj < 2; ++bj) *(u32x4*)(rowp + bj * 128) = pack8(acc[ai][bj][m][0] * ri, acc[ai][bj][m][1] * ri); }
        return false; } };
__device__ __forceinline__ void p1_inproj_pg8(Frame& F, int l) {
    DenseSched S{(const char*)(F.ws + WS_XB), (const char*)(F.ws + WS_WINT) + (size_t)l * IN_COLS * D * 2, M / 256, ZC / 256, F.G, F.wg, D / 64, D * 2, D * 2};
    EpiZ1 E{(bf16*)(F.ws + WS_Z1), (const float*)(F.ws + WS_RINV1)};
    pg8::gemm_phase<EpiZ1, DenseSched, true, 0>(F.lds, S, E, F.tid);
    if (P0_LAYERS < DEPTH && l == 0 && F.wg >= 128) p0_weights(F, P0_LAYERS, DEPTH, (F.wg - 128) * NWAVES + F.wave, 128 * NWAVES);
}
struct EpiGlu { bf16* OS; const float* bg;
    __device__ __forceinline__ bool operator()(const AccT& acc, const pg8::Unit& u, int wr, int wc, int fr, int fq) const {
        asm volatile("" : "+v"(fr), "+v"(fq));
        const int col = u.pn * 128 + wc * 32 + 8 * fq;
        f32x4 bv[2], bgt[2];
#pragma unroll
        for (int n = 0; n < 2; ++n) { bv[n] = *(const f32x4*)(bg + col + 4 * n); bgt[n] = *(const f32x4*)(bg + 512 + col + 4 * n); }
#pragma unroll
        for (int ai = 0; ai < 2; ++ai)
#pragma unroll
            for (int m = 0; m < 4; ++m) { const int row = u.pm * 256 + ai * 128 + wr * 64 + m * 16 + fr; f32x4 o[2];
#pragma unroll
                for (int n = 0; n < 2; ++n) { const f32x4 v = acc[ai][0][m][n] + bv[n], g = acc[ai][1][m][n] + bgt[n];
#pragma unroll
                    for (int j = 0; j < 4; ++j) o[n][j] = v[j] * sigmoidf_(g[j]); }
                *(u32x4*)(OS + (size_t)row * BW + col) = pack8(o[0], o[1]); }
        return false; } };
__device__ __forceinline__ void p3a_glu_pg8(Frame& F, int l) {
    DenseSched S{(const char*)(F.ws + WS_YS), (const char*)(F.ws + WS_WGLUT) + (size_t)l * 1024 * BW * 2, M / 256, 4, F.G, F.wg, BW / 64, BW * 2, BW * 2};
    EpiGlu E{(bf16*)(F.ws + WS_OS), F.in[I_BGLU] + l * 1024};
    pg8::gemm_phase<EpiGlu, DenseSched, true, 0>(F.lds, S, E, F.tid);
}
struct EpiOut { const float* xin; float* X; bf16* XB;
    __device__ __forceinline__ bool operator()(const AccT& acc, const pg8::Unit& u, int wr, int wc, int fr, int fq) const {
        asm volatile("" : "+v"(fr), "+v"(fq));
#pragma unroll
        for (int ai = 0; ai < 2; ++ai) {
#pragma unroll
            for (int mp = 0; mp < 2; ++mp) {
                f32x4 xv[2][2][2];
#pragma unroll
                for (int mm = 0; mm < 2; ++mm) { const size_t row = u.pm * 256 + ai * 128 + wr * 64 + (2 * mp + mm) * 16 + fr;
#pragma unroll
                    for (int bj = 0; bj < 2; ++bj) { const size_t o = row * D + u.pn * 256 + bj * 128 + wc * 32 + 8 * fq; xv[mm][bj][0] = *(const f32x4*)(xin + o); xv[mm][bj][1] = *(const f32x4*)(xin + o + 4); } }
#pragma unroll
                for (int mm = 0; mm < 2; ++mm) { const int m = 2 * mp + mm; const size_t row = u.pm * 256 + ai * 128 + wr * 64 + m * 16 + fr;
#pragma unroll
                    for (int bj = 0; bj < 2; ++bj) { const size_t o = row * D + u.pn * 256 + bj * 128 + wc * 32 + 8 * fq;
                        const f32x4 v0 = xv[mm][bj][0] + acc[ai][bj][m][0], v1 = xv[mm][bj][1] + acc[ai][bj][m][1];
                        *(f32x4*)(X + o) = v0; *(f32x4*)(X + o + 4) = v1; *(u32x4*)(XB + o) = pack8(v0, v1); } }
                asm volatile("" ::: "memory"); } }
        return false; } };
__device__ __forceinline__ void p3c_outproj_pg8(Frame& F, int l) {
    DenseSched S{(const char*)(F.ws + WS_MIXED), (const char*)(F.ws + WS_WOUTT) + (size_t)l * D * D * 2, M / 256, 4, F.G, F.wg, D / 64, D * 2, D * 2};
    EpiOut E{(l == 0) ? F.in[I_X] : F.out, F.out, (bf16*)(F.ws + WS_XB)};
    pg8::gemm_phase<EpiOut, DenseSched, true, 0>(F.lds, S, E, F.tid);
}
struct MixSched { const char* XB; const char* WG; const char* WB; const char* ws; int G, c;
    __device__ __forceinline__ bool next(int i, pg8::Unit& u) const {
        const int sub = i % 6, L = (i / 6) * G + c; if (L >= 512) return false;
        pg8::static_tile(L, M / 256, 4, u.pm, u.pn); u.aux = sub; const int k = sub >> 1;
        if (!(sub & 1)) { u.A = XB + (size_t)u.pm * 256 * 2048; u.lda2 = 2048; u.nt = 16; u.B = WG + ((size_t)k * D + u.pn * 256) * 2048; u.ldb2 = 2048; }
        else { const char* br = ws + (k == 0 ? WS_OA : (k == 1 ? WS_OL : WS_OS)); u.A = br + (size_t)u.pm * 256 * 1024; u.lda2 = 1024; u.nt = 8; u.B = WB + ((size_t)k * D + u.pn * 256) * 1024; u.ldb2 = 1024; }
        return true; }
    __device__ __forceinline__ unsigned row_off(const pg8::Unit&, int) const { return 0u; }
};
struct EpiMix { u32x2* SIG; u32x4* MIXS; bf16* MX; const float* rinv;
    __device__ __forceinline__ bool operator()(const AccT& acc, const pg8::Unit& u, int wr, int wc, int fr, int fq) const {
        asm volatile("" : "+v"(fr), "+v"(fq));
        const int tid = (wr * 4 + wc) * 64 + fq * 16 + fr, sub = u.aux, k = sub >> 1;
        if (!(sub & 1)) {
            float ri[2][4];
#pragma unroll
            for (int ai = 0; ai < 2; ++ai)
#pragma unroll
                for (int m = 0; m < 4; ++m) ri[ai][m] = rinv[u.pm * 256 + ai * 128 + wr * 64 + m * 16 + fr];
#pragma unroll
            for (int ai = 0; ai < 2; ++ai)
#pragma unroll
                for (int m = 0; m < 4; ++m)
#pragma unroll
                    for (int bj = 0; bj < 2; ++bj) { unsigned q0 = 0u, q1 = 0u;
#pragma unroll
                        for (int j = 0; j < 4; ++j) { q0 |= (unsigned)__builtin_rintf(255.0f * sigmoidf_(acc[ai][bj][m][0][j] * ri[ai][m])) << (8 * j); q1 |= (unsigned)__builtin_rintf(255.0f * sigmoidf_(acc[ai][bj][m][1][j] * ri[ai][m])) << (8 * j); }
                        SIG[((ai * 4 + m) * 2 + bj) * 512 + tid] = (u32x2){q0, q1}; }
        } else {
#pragma unroll
            for (int ai = 0; ai < 2; ++ai)
#pragma unroll
            for (int mp = 0; mp < 2; ++mp) {
                u32x2 sv[2][2]; u32x4 mv[2][2];
#pragma unroll
                for (int mm = 0; mm < 2; ++mm)
#pragma unroll
                    for (int bj = 0; bj < 2; ++bj) { const int slot = ((ai * 4 + 2 * mp + mm) * 2 + bj) * 512 + tid; sv[mm][bj] = SIG[slot]; if (k > 0) mv[mm][bj] = MIXS[slot]; }
#pragma unroll
                for (int mm = 0; mm < 2; ++mm) { const int m = 2 * mp + mm; const size_t row = u.pm * 256 + ai * 128 + wr * 64 + m * 16 + fr;
#pragma unroll
                    for (int bj = 0; bj < 2; ++bj) { const int slot = ((ai * 4 + m) * 2 + bj) * 512 + tid; f32x4 s0, s1;
#pragma unroll
                        for (int j = 0; j < 4; ++j) { s0[j] = (float)((sv[mm][bj].x >> (8 * j)) & 255u) * (1.0f / 255.0f); s1[j] = (float)((sv[mm][bj].y >> (8 * j)) & 255u) * (1.0f / 255.0f); }
                        f32x4 v0 = acc[ai][bj][m][0] * s0, v1 = acc[ai][bj][m][1] * s1;
                        if (k > 0) { f32x4 p0, p1; unpack8(mv[mm][bj], p0, p1); v0 += p0; v1 += p1; }
                        if (k < 2) MIXS[slot] = pack8(v0, v1);
                        else *(u32x4*)(MX + row * D + u.pn * 256 + bj * 128 + wc * 32 + 8 * fq) = pack8(v0, v1); } }
                asm volatile("" ::: "memory"); }
        }
        return false; } };
__device__ __forceinline__ void p3b_mix_pg8(Frame& F, int l) {
    MixSched S{(const char*)(F.ws + WS_XB), (const char*)(F.ws + WS_WINT) + ((size_t)l * IN_COLS + COL_GATES) * D * 2, (const char*)(F.ws + WS_WBRT) + (size_t)l * 3 * D * BW * 2, (const char*)F.ws, F.G, F.wg};
    EpiMix E{(u32x2*)(F.ws + WS_P3BSCR + (size_t)F.wg * 262144), (u32x4*)(F.ws + WS_P3BSCR + (size_t)F.wg * 262144 + 131072), (bf16*)(F.ws + WS_MIXED), (const float*)(F.ws + WS_RINV1)};
    pg8::gemm_phase<EpiMix, MixSched, true, 0>(F.lds, S, E, F.tid);
}
struct Moe1Sched { const char* XB; const char* W13; const int* IDX; const LAS int* tb; int ntile, G, c;
    __device__ __forceinline__ bool next(int i, pg8::Unit& u) const {
        const int L = i * G + c; if (L >= ntile * 4) return false;
        u.pm = L >> 2; u.pn = L & 3; const int bucket = tb[1 + u.pm], g = bucket / 6; int pa, pb; pair_of(bucket % 6, pa, pb);
        u.aux = u.pn >> 1; const int e = g * 4 + (u.aux ? pb : pa);
        u.A = XB; u.lda2 = 2048; u.nt = 16; u.B = W13 + ((size_t)e * 512 + (u.pn & 1) * 256) * 2048; u.ldb2 = 2048; return true; }
    __device__ __forceinline__ unsigned row_off(const pg8::Unit& u, int r) const { int tok = IDX[u.pm * 256 + r]; tok = tok < 0 ? 0 : tok; return (unsigned)tok * 2048u; }
};
struct EpiMoe1 { bf16* HS; const float* WSORT; const float* RSORT;
    __device__ __forceinline__ bool operator()(const AccT& acc, const pg8::Unit& u, int wr, int wc, int fr, int fq) const {
        asm volatile("" : "+v"(fr), "+v"(fq));
        const int slot = u.aux, hcol = slot * 256 + (u.pn & 1) * 128 + wc * 32 + 8 * fq;
#pragma unroll
        for (int ai = 0; ai < 2; ++ai)
#pragma unroll
            for (int m = 0; m < 4; ++m) { const int row = u.pm * 256 + ai * 128 + wr * 64 + m * 16 + fr; const float wsel = WSORT[2 * row + slot], ri = RSORT[row]; f32x4 o[2];
#pragma unroll
                for (int n = 0; n < 2; ++n)
#pragma unroll
                    for (int j = 0; j < 4; ++j) { const float v1 = acc[ai][0][m][n][j] * ri, v3 = acc[ai][1][m][n][j] * ri; o[n][j] = v1 * sigmoidf_(v1) * v3 * wsel; }
                *(u32x4*)(HS + (size_t)row * 512 + hcol) = pack8(o[0], o[1]); }
        return false; } };
__device__ __forceinline__ void p4c_moe1_pg8(Frame& F, int l) {
    LAS int* tb = (LAS int*)(F.lds + TB_OFF);
    const int ntile = build_tile_table(F, tb);
    Moe1Sched S{(const char*)(F.ws + WS_XB), (const char*)(F.ws + WS_W13T) + (size_t)l * 16 * 512 * D * 2, (const int*)(F.ws + WS_IDX), tb, ntile, F.G, F.wg};
    EpiMoe1 E{(bf16*)(F.ws + WS_HS), (const float*)(F.ws + WS_WSORT), (const float*)(F.ws + WS_RSORT)};
    pg8::gemm_phase<EpiMoe1, Moe1Sched, true, 2>(F.lds, S, E, F.tid);
}
struct Moe2Sched { const char* HS; const char* W2; const LAS int* tb; int ntile, G, c;
    __device__ __forceinline__ bool next(int i, pg8::Unit& u) const {
        const int L = i * G + c; if (L >= ntile * 4) return false;
        u.pm = L >> 2; u.pn = L & 3; u.aux = 0; const int bucket = tb[1 + u.pm];
        u.A = HS + (size_t)u.pm * 256 * 1024; u.lda2 = 1024; u.nt = 8; u.B = W2 + ((size_t)bucket * D + u.pn * 256) * 1024; u.ldb2 = 1024; return true; }
    __device__ __forceinline__ unsigned row_off(const pg8::Unit&, int) const { return 0u; }
};
struct EpiMoe2 { float* X; bf16* XB; const int* IDX;
    __device__ __forceinline__ bool operator()(const AccT& acc, const pg8::Unit& u, int wr, int wc, int fr, int fq) const {
        asm volatile("" : "+v"(fr), "+v"(fq));
        int tk[2][4];
#pragma unroll
        for (int ai = 0; ai < 2; ++ai)
#pragma unroll
            for (int m = 0; m < 4; ++m) tk[ai][m] = IDX[u.pm * 256 + ai * 128 + wr * 64 + m * 16 + fr];
#pragma unroll
        for (int ai = 0; ai < 2; ++ai) {
#pragma unroll
            for (int mp = 0; mp < 2; ++mp) {
                f32x4 xv[2][2][2];
#pragma unroll
                for (int mm = 0; mm < 2; ++mm) { const int tok = tk[ai][2 * mp + mm]; const size_t rb = (size_t)(tok < 0 ? 0 : tok) * D + u.pn * 256 + wc * 32 + 8 * fq;
#pragma unroll
                    for (int bj = 0; bj < 2; ++bj) { xv[mm][bj][0] = *(const f32x4*)(X + rb + bj * 128); xv[mm][bj][1] = *(const f32x4*)(X + rb + bj * 128 + 4); } }
#pragma unroll
                for (int mm = 0; mm < 2; ++mm) { const int m = 2 * mp + mm, tok = tk[ai][m];
                    if (tok >= 0) { const size_t rb = (size_t)tok * D + u.pn * 256 + wc * 32 + 8 * fq;
#pragma unroll
                        for (int bj = 0; bj < 2; ++bj) { const f32x4 v0 = xv[mm][bj][0] + acc[ai][bj][m][0], v1 = xv[mm][bj][1] + acc[ai][bj][m][1];
                            *(f32x4*)(X + rb + bj * 128) = v0; *(f32x4*)(X + rb + bj * 128 + 4) = v1; *(u32x4*)(XB + rb + bj * 128) = pack8(v0, v1); } } }
                asm volatile("" ::: "memory"); } }
        return false; } };
__device__ __forceinline__ void p4d_moe2_pg8(Frame& F, int l) {
    LAS int* tb = (LAS int*)(F.lds + TB_OFF);
    const int ntile = build_tile_table(F, tb);
    Moe2Sched S{(const char*)(F.ws + WS_HS), (const char*)(F.ws + WS_W2TB) + (size_t)l * NBUCKET * D * 512 * 2, tb, ntile, F.G, F.wg};
    EpiMoe2 E{F.out, (bf16*)(F.ws + WS_XB), (const int*)(F.ws + WS_IDX)};
    pg8::gemm_phase<EpiMoe2, Moe2Sched, true, 0>(F.lds, S, E, F.tid);
}

__device__ __forceinline__ void p_rowstats(Frame& F) {
    const float* X = F.out; float* rinv = (float*)(F.ws + WS_RINV1);
    for (int m0 = 4 * F.gw; m0 < M; m0 += 4 * F.NGW) {
        f32x4 v[4][4];
#pragma unroll
        for (int a = 0; a < 4; ++a) { const f32x4* xr = (const f32x4*)(X + (size_t)(m0 + a) * D) + F.lane;
#pragma unroll
            for (int j = 0; j < 4; ++j) v[a][j] = xr[64 * j]; }
        float t[4];
#pragma unroll
        for (int a = 0; a < 4; ++a) { float s = 0.f;
#pragma unroll
            for (int j = 0; j < 4; ++j) s += (v[a][j].x * v[a][j].x + v[a][j].y * v[a][j].y) + (v[a][j].z * v[a][j].z + v[a][j].w * v[a][j].w);
            t[a] = wave_sum(s, F.lane); }
        if (F.lane < 4) { const float s = F.lane == 0 ? t[0] : (F.lane == 1 ? t[1] : (F.lane == 2 ? t[2] : t[3])); rinv[m0 + F.lane] = 1.0f / sqrtf(s * (1.0f / D) + NORM_EPS); }
    }
}
__device__ __forceinline__ void p_final_norm(Frame& F) {
    float* X = F.out;
    const f32x4* gp = (const f32x4*)F.in[I_FNG] + F.lane; f32x4 gv[4];
#pragma unroll
    for (int j = 0; j < 4; ++j) gv[j] = gp[64 * j];
    for (int m0 = 4 * F.gw; m0 < M; m0 += 4 * F.NGW) {
        f32x4 v[4][4];
#pragma unroll
        for (int a = 0; a < 4; ++a) { const f32x4* xr = (const f32x4*)(X + (size_t)(m0 + a) * D) + F.lane;
#pragma unroll
            for (int j = 0; j < 4; ++j) v[a][j] = xr[64 * j]; }
#pragma unroll
        for (int a = 0; a < 4; ++a) { float s = 0.f;
#pragma unroll
            for (int j = 0; j < 4; ++j) s += (v[a][j].x * v[a][j].x + v[a][j].y * v[a][j].y) + (v[a][j].z * v[a][j].z + v[a][j].w * v[a][j].w);
            s = wave_sum(s, F.lane); const float ri = 1.0f / sqrtf(s * (1.0f / D) + NORM_EPS);
            f32x4* xw = (f32x4*)(X + (size_t)(m0 + a) * D) + F.lane;
#pragma unroll
            for (int j = 0; j < 4; ++j) xw[64 * j] = v[a][j] * ri * gv[j]; }
    }
}

__device__ __forceinline__ bool fresh(Frame& F) {
    int t = threadIdx.x; asm volatile("" : "+v"(t));
    F.tid = t; F.lane = t & 63; F.wave = __builtin_amdgcn_readfirstlane(t >> 6); F.gw = F.wg * NWAVES + F.wave;
    const __attribute__((address_space(4))) Args* ap = (const __attribute__((address_space(4))) Args*)__builtin_amdgcn_kernarg_segment_ptr();
    asm volatile("" : "+s"(ap));
    F.in = ap->in; F.out = ap->out; F.ws = ap->ws;
    return true;
}
__global__ void __launch_bounds__(NTHREADS, 2) fwd(Args args) {
    extern __shared__ __attribute__((aligned(16))) unsigned char lds[];
    Frame F;
    F.lds = (LAS unsigned char*)lds;
    volatile LAS unsigned* MISC = (volatile LAS unsigned*)(F.lds + MISC_OFF);
    if (threadIdx.x < 32) MISC[threadIdx.x] = 0u;
    __syncthreads();
    F.tid = threadIdx.x; F.lane = F.tid & 63; F.wave = __builtin_amdgcn_readfirstlane(F.tid >> 6);
    F.wg = blockIdx.x; F.gw = F.wg * NWAVES + F.wave;
    F.in = nullptr; F.out = args.out; F.ws = args.ws;
    unsigned* ctl = (unsigned*)(F.ws + WS_CTL);
    XcdBarrier bar; bar.bar = ctl + CW_BAR; bar.x = 0; bar.st = nullptr;
    if (!MK_PER_PHASE) bar = xcd_barrier_post(ctl + CW_BAR, MISC + 8, F.tid == 0);
    const int lo = args.ph_lo, hi = args.ph_hi;
#define IN(k) (lo <= (k) && (k) < hi && fresh(F))
#define SEAM(k) do { if (IN(k) && IN((k) + 1)) xcd_barrier(bar, F.tid == 0); } while (0)

#ifndef DUP_MASK
#define DUP_MASK 0
#endif
#define RUN(k, body) do { int reps_ = 1 + ((DUP_MASK >> (k)) & 1); if (DUP_MASK) asm volatile("" : "+s"(reps_)); for (int rep_ = 0; rep_ < reps_; ++rep_) { body; if (DUP_MASK) __syncthreads(); } } while (0)
    if (IN(0)) { RUN(0, p0_prologue(F)); } SEAM(0);
    for (int l = 0; l < DEPTH; ++l) {
        const int pb = 1 + 10 * l;
        if (IN(pb + 0)) { RUN(1, p1_inproj_pg8(F, l)); } SEAM(pb + 0);
        if (IN(pb + 1)) { RUN(2, lru_mfma(F, l)); RUN(3, s5_mfma(F, l)); RUN(4, attn_mfma(F, l)); } SEAM(pb + 1);
        if (IN(pb + 2)) { RUN(5, p3a_glu_pg8(F, l)); } SEAM(pb + 2);
        if (IN(pb + 3)) { RUN(6, p3b_mix_pg8(F, l)); } SEAM(pb + 3);
        if (IN(pb + 4)) { p3c_outproj_pg8(F, l); } SEAM(pb + 4);
        if (IN(pb + 5)) { RUN(8, p4a_router(F, l)); } SEAM(pb + 5);
        if (IN(pb + 6)) { RUN(9, p4b_positions(F)); } SEAM(pb + 6);
        if (IN(pb + 7)) { RUN(10, p4c_moe1_pg8(F, l)); } SEAM(pb + 7);
        if (IN(pb + 8)) { p4d_moe2_pg8(F, l); } SEAM(pb + 8);
        if (IN(pb + 9)) { if (l == DEPTH - 1) p_final_norm(F); else { RUN(12, p_rowstats(F)); } }
        if (l < DEPTH - 1) SEAM(pb + 9);
    }
#undef IN
#undef SEAM
}

extern "C" void kernel_launch(void* const* d_in, const int* in_sizes, int n_in, void* d_out, int out_size, void* d_ws, size_t ws_size, hipStream_t stream) {
    static int grid = 0;
    if (grid == 0) {
        if (n_in != 32 || out_size != M * D || ws_size < WS_END) { fprintf(stderr, "kernel_launch: unexpected shapes (n_in %d, out %d, ws %zu)\n", n_in, out_size, ws_size); grid = -1; return; }
        if (hipFuncSetAttribute((const void*)fwd, hipFuncAttributeMaxDynamicSharedMemorySize, LDS_BYTES) != hipSuccess) { fprintf(stderr, "kernel_launch: hipFuncSetAttribute failed\n"); grid = -1; return; }
        int per_cu = 0;
        if (hipOccupancyMaxActiveBlocksPerMultiprocessor(&per_cu, (const void*)fwd, NTHREADS, LDS_BYTES) != hipSuccess || per_cu < 1) fprintf(stderr, "kernel_launch: occupancy query reports %d\n", per_cu);
        (void)hipGetLastError();
        grid = 256;
    }
    if (grid < 0) return;
    (void)hipMemsetAsync((char*)d_ws + WS_CTL, 0, CTL_ZERO_BYTES, stream);
    Args a{};
    for (int i = 0; i < 32; ++i) a.in[i] = (const float*)d_in[i];
    a.out = (float*)d_out; a.ws = (unsigned char*)d_ws; a.pad = 0;
#if MK_PER_PHASE
    for (int p = 0; p < NPHASE; ++p) { a.ph_lo = p; a.ph_hi = p + 1; a.li = p; hipLaunchKernelGGL(fwd, dim3(grid), dim3(NTHREADS), LDS_BYTES, stream, a); }
#else
    a.ph_lo = 0; a.ph_hi = NPHASE; a.li = 0;
    hipLaunchKernelGGL(fwd, dim3(grid), dim3(NTHREADS), LDS_BYTES, stream, a);
#endif
}
```

```cpp
#include <hip/hip_runtime.h>
#include <cstdio>
#include <cstdint>

#ifndef MK_PER_PHASE
#define MK_PER_PHASE 0
#endif

constexpr int D = 1024, BATCH = 16, SEQ = 2048, M = BATCH * SEQ, DEPTH = 2;
constexpr int NQ = 8, HD = 64, WIN = 128;
constexpr int BW = 512;
constexpr int ZC = 2304;
constexpr int IN_COLS = 5376;
constexpr int COL_Q = 0, COL_K = 512, COL_V = 640, COL_XR = 768, COL_GR = 1280, COL_U = 1792, COL_GATES = 2304;
constexpr int NBUCKET = 24;
constexpr int MS_MAX = (128 + NBUCKET) * 256;
constexpr float NORM_EPS = 1e-6f;
constexpr int NWAVES = 8, NTHREADS = 512;
constexpr int NPHASE = 21;

constexpr size_t MiB = 1u << 20;
constexpr size_t WS_CTL = 0, CTL_ZERO_BYTES = 1 * MiB;
constexpr size_t WS_RINV1 = 1 * MiB;
constexpr size_t WS_RINV2 = WS_RINV1 + 128 * 1024;
constexpr size_t WS_BUCKET = WS_RINV2 + 128 * 1024;
constexpr size_t WS_RANK = WS_BUCKET + 128 * 1024;
constexpr size_t WS_WTOK = WS_RANK + 128 * 1024;
constexpr size_t WS_HIST = WS_WTOK + 256 * 1024;
constexpr size_t WS_BBASE = WS_HIST + 32 * 1024;
constexpr size_t WS_IDX = WS_BBASE + 1024;
constexpr size_t WS_WSORT = WS_IDX + 160 * 1024;
constexpr size_t WS_RSORT = WS_WSORT + 320 * 1024;
constexpr size_t WS_S5TBL = 3 * MiB;
constexpr size_t WS_WRT = 5 * MiB;
constexpr size_t WS_LRUF = 7 * MiB;
constexpr size_t WS_WINT = 8 * MiB;
constexpr size_t WS_WGLUT = 29 * MiB;
constexpr size_t WS_WBRT = 31 * MiB;
constexpr size_t WS_WOUTT = 37 * MiB;
constexpr size_t WS_W13T = 41 * MiB;
constexpr size_t WS_W2TB = 73 * MiB;
constexpr size_t WS_S5MAT = 121 * MiB;
constexpr size_t WS_S5LAM = 6 * MiB;
constexpr size_t WS_XB = 145 * MiB;
constexpr size_t WS_Z1 = 209 * MiB;
constexpr size_t WS_MIXED = 209 * MiB;
constexpr size_t WS_HS = 273 * MiB;
constexpr size_t WS_OA = 353 * MiB, WS_OL = 385 * MiB, WS_YS = 417 * MiB, WS_OS = 449 * MiB;
constexpr size_t WS_END = 481 * MiB;
static_assert(WS_WSORT + (size_t)MS_MAX * 8 <= WS_RSORT && WS_RSORT + (size_t)MS_MAX * 4 <= WS_S5TBL, "small region");
constexpr size_t WS_P3BSCR = 273 * MiB;
constexpr int TB_OFF = 163840 - 2048;
static_assert(WS_Z1 + (size_t)M * ZC * 2 <= WS_OA, "z1");
static_assert(WS_HS + (size_t)MS_MAX * 512 * 2 <= WS_OA, "hs");

constexpr int CW_BAR = 4096;
constexpr int LDS_BYTES = 163840;
constexpr int MISC_OFF = 163840 - 256;

#define LAS __attribute__((address_space(3)))
typedef unsigned short bf16;
typedef short bf16x8 __attribute__((ext_vector_type(8)));
typedef float f32x4 __attribute__((ext_vector_type(4)));
typedef unsigned u32x4 __attribute__((ext_vector_type(4)));
typedef unsigned u32x2 __attribute__((ext_vector_type(2)));

__device__ __forceinline__ float bf2f(bf16 b) { return __uint_as_float(((unsigned)b) << 16); }
__device__ __forceinline__ unsigned f2bf(float f) { unsigned u = __float_as_uint(f); return (u + 0x7fffu + ((u >> 16) & 1u)) >> 16; }
__device__ __forceinline__ unsigned pk2(float lo, float hi) { return f2bf(lo) | (f2bf(hi) << 16); }
typedef __bf16 hwbf16x2 __attribute__((ext_vector_type(2)));
__device__ __forceinline__ unsigned pk2hw(float lo, float hi) { hwbf16x2 v; v.x = (__bf16)lo; v.y = (__bf16)hi; return __builtin_bit_cast(unsigned, v); }
__device__ __forceinline__ float sigmoidf_(float x) { return __builtin_amdgcn_rcpf(1.0f + __builtin_amdgcn_exp2f(-1.4426950408889634f * x)); }
__device__ __forceinline__ float gelu_tanh(float x) { return x * sigmoidf_(1.5957691216057308f * (x + 0.044715f * x * x * x)); }
template <int N> __device__ __forceinline__ float dpp_ror(float v) { return __int_as_float(__builtin_amdgcn_update_dpp(0, __float_as_int(v), 0x120 + N, 0xf, 0xf, false)); }
__device__ __forceinline__ float rlane(float v, int l) { return __int_as_float(__builtin_amdgcn_readlane(__float_as_int(v), l)); }
__device__ __forceinline__ float wave_sum(float v, int  ) {
    v += dpp_ror<8>(v); v += dpp_ror<4>(v); v += dpp_ror<2>(v); v += dpp_ror<1>(v);
    return (rlane(v, 0) + rlane(v, 16)) + (rlane(v, 32) + rlane(v, 48));
}
__device__ __forceinline__ float lane_xor(float v, int lane, int o) { return __int_as_float(__builtin_amdgcn_ds_bpermute((lane ^ o) << 2, __float_as_int(v))); }
#define LDS_WAIT() asm volatile("s_waitcnt lgkmcnt(0)" ::: "memory")

#define XB_TMO      128
#define XB_XCNT(j)  (256  + 64 * (j))
#define XB_XSUB(j)  (1280 + 64 * (j))
#define XB_XGEN(j)  (2304 + 64 * (j))
#define XB_TOP      3328
#define XB_TOPGEN   3392
#define XCD_BAR_WORDS 3456
#define XB_SPIN_CAP (1u << 20)
__device__ __forceinline__ unsigned xb_ld(unsigned* p)              { return __hip_atomic_load(p, __ATOMIC_RELAXED, __HIP_MEMORY_SCOPE_AGENT); }
__device__ __forceinline__ unsigned xb_add(unsigned* p, unsigned v) { return __hip_atomic_fetch_add(p, v, __ATOMIC_RELAXED, __HIP_MEMORY_SCOPE_AGENT); }
__device__ __forceinline__ unsigned xb_xcc_id() { return (unsigned)__builtin_amdgcn_s_getreg((3 << 11) | 20) & 0xFu; }
#define XB_SPIN(cond, bar) do { unsigned _sp = 0; while (cond) { __builtin_amdgcn_s_sleep(1); \
    if ((++_sp & 255u) == 0u) { if (xb_ld(&(bar)[XB_TMO])) break; if (_sp > XB_SPIN_CAP) { atomicAdd(&(bar)[XB_TMO], 1u); break; } } } } while (0)
struct XcdBarrier { unsigned* bar; unsigned x; volatile LAS unsigned* st; };
__device__ __forceinline__ XcdBarrier xcd_barrier_post(unsigned* bar, volatile LAS unsigned* st, bool leader) {
    XcdBarrier b; b.bar = bar; b.x = xb_xcc_id(); b.st = st;
    if (leader) (void)xb_add(&bar[XB_XCNT(b.x)], 1u);
    return b;
}
__device__ __forceinline__ void xcd_barrier_complete(unsigned* bar, unsigned x, unsigned& nloc, unsigned& nx) {
    const unsigned G = gridDim.x * gridDim.y * gridDim.z;
    unsigned sum, cnt, mine, sp = 0u;
    for (;;) {
        sum = 0u; cnt = 0u; mine = 0u;
#pragma unroll
        for (unsigned j = 0; j < 16; ++j) { const unsigned c = xb_ld(&bar[XB_XCNT(j)]); sum += c; cnt += (c > 0u) ? 1u : 0u; mine = (j == x) ? c : mine; }
        if (sum == G) break;
        __builtin_amdgcn_s_sleep(1);
        if ((++sp & 255u) == 0u) { if (xb_ld(&bar[XB_TMO])) break; if (sp > XB_SPIN_CAP) { atomicAdd(&bar[XB_TMO], 1u); break; } }
    }
    nloc = mine > 0u ? mine : 1u; nx = cnt > 0u ? cnt : 1u;
}
__device__ __forceinline__ void xcd_barrier(const XcdBarrier& b, bool leader) {
    asm volatile("s_waitcnt vmcnt(0)" ::: "memory");
    __syncthreads();
    if (leader) {
        unsigned* bar = b.bar;
        __builtin_amdgcn_s_waitcnt(0);
        unsigned nloc = b.st[0], nx = b.st[1];
        if (nloc == 0u) { xcd_barrier_complete(bar, b.x, nloc, nx); b.st[0] = nloc; b.st[1] = nx; }
        const unsigned old = xb_add(&bar[XB_XSUB(b.x)], 1u);
        const unsigned gen = old / nloc;
        if (old + 1u == (gen + 1u) * nloc) {
            __builtin_amdgcn_fence(__ATOMIC_RELEASE, "agent");
            asm volatile("s_waitcnt vmcnt(0)" ::: "memory");
            const unsigned og = xb_add(&bar[XB_TOP], 1u);
            const unsigned tg = og / nx;
            if (og + 1u == (tg + 1u) * nx) xb_add(&bar[XB_TOPGEN], 1u);
            else XB_SPIN(xb_ld(&bar[XB_TOPGEN]) == tg, bar);
            __builtin_amdgcn_fence(__ATOMIC_ACQUIRE, "agent");
            xb_add(&bar[XB_XGEN(b.x)], 1u);
            asm volatile("s_waitcnt vmcnt(0)" ::: "memory");
        } else {
            XB_SPIN(xb_ld(&bar[XB_XGEN(b.x)]) == gen, bar);
            __builtin_amdgcn_fence(__ATOMIC_ACQUIRE, "agent");
            asm volatile("s_waitcnt vmcnt(0)" ::: "memory");
        }
    }
    __syncthreads();
}

struct Args { const float* in[32]; float* out; unsigned char* ws; int ph_lo, ph_hi, li, pad; };
struct Frame {
    LAS unsigned char* lds;
    int tid, lane, wave, wg, gw;
    static constexpr int G = 256, NGW = 256 * NWAVES;
    const float* const __attribute__((address_space(4)))* in;
    float* out; unsigned char* ws;
};
enum { I_X = 0, I_N1G, I_WIN, I_SINK, I_CONVW, I_CONVB, I_LWR, I_LBR, I_LWI, I_LBI, I_LAM, I_ARE, I_AIM, I_LSTEP, I_BRE, I_BIM, I_CRE, I_CIM, I_SD, I_WGLU, I_BGLU,
       I_WBR, I_WOUT, I_N2G, I_WG, I_BG, I_WE, I_BE, I_W1, I_W3, I_W2, I_FNG };

__device__ __forceinline__ void pair_of(int p, int& a, int& b) {
    a = (p < 3) ? 0 : (p < 5 ? 1 : 2); b = (p < 3) ? p + 1 : (p < 5 ? p - 1 : 3);
}
__device__ __forceinline__ int pair_index(int a, int b) {
    return (a == 0) ? (b - 1) : (a == 1 ? (b + 1) : 5);
}


namespace pg8 {
typedef unsigned short bf16_t;
constexpr int BM = 256, BK = 64, HALF = 128, HTB = HALF * BK * 2, STAGE_BYTES = 8 * HTB, NXCD = 8, WGM = 8;
__host__ __device__ __forceinline__ int lds_byte(int r, int c) { const int st = (r >> 4) * 2 + (c >> 5), rr = r & 15, cc = c & 31, ob = rr * 64 + cc * 2; return st * 1024 + (ob ^ (((ob >> 9) & 1) << 5)); }
__host__ __device__ __forceinline__ void stage_rc(int b, int& R, int& C) { const int st = b / 1024, sb = b % 1024, swz = sb ^ (((sb >> 9) & 1) << 5); R = (st >> 1) * 16 + swz / 64; C = (st & 1) * 32 + (swz % 64) / 2; }
__host__ __device__ __forceinline__ int perm32(int rho) { const int n = rho >> 4, i = rho & 15; return 8 * (i >> 2) + 4 * n + (i & 3); }

struct Unit { int pm, pn, aux; int nt; unsigned lda2, ldb2; const char* A; const char* B; };

__device__ __forceinline__ void static_tile(int L, int nM, int nN, int& pm, int& pn) {
    const int nwg = nM * nN; int wgid = L; { const int q = nwg / NXCD, r = nwg % NXCD, xcd = wgid % NXCD, off = wgid / NXCD; wgid = (xcd < r ? xcd * (q + 1) : r * (q + 1) + (xcd - r) * q) + off; }
    const int nig = WGM * nN, gid = wgid / nig, fm = gid * WGM, gsz = (nM - fm) < WGM ? (nM - fm) : WGM;
    pm = fm + ((wgid % nig) % gsz); pn = (wgid % nig) / gsz;
}

template <class Epi, class Sched, bool ALIGN_EPI, int MODE>
__device__ __forceinline__ void gemm_phase(LAS unsigned char* lds, const Sched& S, const Epi& E, int tid) {
    const int wid = __builtin_amdgcn_readfirstlane(tid >> 6), lane = tid & 63, wr = wid >> 2, wc = wid & 3, fr = lane & 15, fq = lane >> 4;
    unsigned RA[2], C2[2];
#pragma unroll
    for (int i = 0; i < 2; ++i) { int R, C; stage_rc(tid * 16 + i * 8192, R, C); RA[i] = (unsigned)R; C2[i] = (unsigned)C * 2u; }
    const unsigned ldsw = (unsigned)wid * 1024u;
    const int aoff = lds_byte(wr * 64 + fr, fq * 8), boff = lds_byte(wc * 32 + fr, fq * 8);
#define PG8_SA(b, h) (((b) * 2 + (h)) * HTB)
#define PG8_SB(b, h) ((4 + (b) * 2 + (h)) * HTB)
#define PG8_STAGE_A(bufoff, gbase, h, ld2, go) do { _Pragma("unroll") for (int _i = 0; _i < 2; ++_i) { \
        const unsigned _vo = (MODE == 2) ? ((go)[h][_i] + C2[_i]) : ((RA[_i] + 128u * (h)) * (ld2) + C2[_i]); \
        __builtin_amdgcn_global_load_lds((const unsigned*)((gbase) + _vo), (LAS unsigned*)(lds + (bufoff) + ldsw + _i * 8192), 16, 0, 0); } } while (0)
#define PG8_STAGE_B(bufoff, gbase, h, ld2) do { _Pragma("unroll") for (int _i = 0; _i < 2; ++_i) { \
        const unsigned _vo = (((RA[_i] & ~31u) + (unsigned)perm32((int)(RA[_i] & 31u))) + 128u * (h)) * (ld2) + C2[_i]; \
        __builtin_amdgcn_global_load_lds((const unsigned*)((gbase) + _vo), (LAS unsigned*)(lds + (bufoff) + ldsw + _i * 8192), 16, 0, 0); } } while (0)
#define PG8_LDA(dst, b, h) do { _Pragma("unroll") for (int m = 0; m < 4; ++m) _Pragma("unroll") for (int k = 0; k < 2; ++k) dst[m][k] = *(const LAS bf16x8*)(lds + PG8_SA(b, h) + aoff + m * 2048 + k * 1024); } while (0)
#define PG8_LDB(dst, b, h) do { _Pragma("unroll") for (int n = 0; n < 2; ++n) _Pragma("unroll") for (int k = 0; k < 2; ++k) dst[n][k] = *(const LAS bf16x8*)(lds + PG8_SB(b, h) + boff + n * 2048 + k * 1024); } while (0)
#define PG8_MMA(ai, bj, At, Bt) do { __builtin_amdgcn_s_setprio(1); _Pragma("unroll") for (int m = 0; m < 4; ++m) _Pragma("unroll") for (int n = 0; n < 2; ++n) _Pragma("unroll") for (int k = 0; k < 2; ++k) \
        acc[ai][bj][m][n] = __builtin_amdgcn_mfma_f32_16x16x32_bf16(Bt[n][k], At[m][k], acc[ai][bj][m][n], 0, 0, 0); __builtin_amdgcn_s_setprio(0); } while (0)
#define PG8_WAIT_V(n) asm volatile("s_waitcnt vmcnt(" #n ")" ::: "memory")
#define PG8_WAIT_L(n) asm volatile("s_waitcnt lgkmcnt(" #n ")" ::: "memory")
#define PG8_BAR __builtin_amdgcn_s_barrier()
#define PG8_SCHED __builtin_amdgcn_sched_barrier(0)
    Unit cur, nxt; int ui = 0;
    if (!S.next(0, cur)) return;
    f32x4 acc[2][2][4][2];
#pragma unroll
    for (int a = 0; a < 2; ++a)
#pragma unroll
        for (int b = 0; b < 2; ++b)
#pragma unroll
            for (int m = 0; m < 4; ++m)
#pragma unroll
                for (int n = 0; n < 2; ++n) acc[a][b][m][n] = (f32x4){0.f, 0.f, 0.f, 0.f};
    bf16x8 At[4][2], B0[2][2], B1[2][2];
    unsigned cgo[2][2] = {{0u, 0u}, {0u, 0u}}, ngo[2][2] = {{0u, 0u}, {0u, 0u}};
    if (MODE == 2) {
#pragma unroll
        for (int h = 0; h < 2; ++h)
#pragma unroll
            for (int i = 0; i < 2; ++i) cgo[h][i] = S.row_off(cur, h * 128 + (int)RA[i]);
    }
    const size_t kstep = (size_t)(BK * 2);
    const char* cA = cur.A; const char* cB = cur.B;
    PG8_STAGE_B(PG8_SB(0, 0), cB, 0, cur.ldb2); PG8_STAGE_B(PG8_SB(0, 1), cB, 1, cur.ldb2); PG8_STAGE_A(PG8_SA(0, 0), cA, 0, cur.lda2, cgo); PG8_STAGE_A(PG8_SA(0, 1), cA, 1, cur.lda2, cgo);
    if (wr == 1) PG8_BAR;
    PG8_WAIT_V(2); PG8_BAR;
    PG8_STAGE_B(PG8_SB(1, 0), cB + kstep, 0, cur.ldb2); PG8_STAGE_A(PG8_SA(1, 0), cA + kstep, 0, cur.lda2, cgo); PG8_STAGE_B(PG8_SB(1, 1), cB + kstep, 1, cur.ldb2);
    PG8_WAIT_V(6); PG8_BAR;
    for (;;) {
        const bool has_next = S.next(ui + 1, nxt);
        if (!has_next) nxt = cur;
        if (MODE == 2) {
#pragma unroll
            for (int h = 0; h < 2; ++h)
#pragma unroll
                for (int i = 0; i < 2; ++i) ngo[h][i] = has_next ? S.row_off(nxt, h * 128 + (int)RA[i]) : cgo[h][i];
        }
        const char* nA = nxt.A; const char* nB = nxt.B;
        const int nt = cur.nt;
        for (int t = 0; t < nt; t += 2) {
            const bool last = (t == nt - 2);
            const char* a1 = cA + (size_t)(t + 1) * kstep;
            const char* a2 = last ? nA : cA + (size_t)(t + 2) * kstep; const char* b2 = last ? nB : cB + (size_t)(t + 2) * kstep;
            const char* a3 = a2 + kstep; const char* b3 = b2 + kstep;
            const unsigned la2 = last ? nxt.lda2 : cur.lda2, lb2 = last ? nxt.ldb2 : cur.ldb2;
            unsigned go2[2][2];
#pragma unroll
            for (int h = 0; h < 2; ++h)
#pragma unroll
                for (int i = 0; i < 2; ++i) go2[h][i] = last ? ngo[h][i] : cgo[h][i];
            PG8_LDB(B0, 0, 0); PG8_LDB(B1, 0, 1); PG8_SCHED; PG8_LDA(At, 0, 0); PG8_STAGE_A(PG8_SA(1, 1), a1, 1, cur.lda2, cgo);
            PG8_WAIT_V(8); PG8_WAIT_L(0); PG8_BAR; PG8_MMA(0, 0, At, B0); PG8_MMA(0, 1, At, B1); PG8_BAR; PG8_SCHED;
            PG8_LDA(At, 0, 1); PG8_STAGE_B(PG8_SB(0, 0), b2, 0, lb2); PG8_STAGE_B(PG8_SB(0, 1), b2, 1, lb2); PG8_STAGE_A(PG8_SA(0, 0), a2, 0, la2, go2);
            PG8_WAIT_V(8); PG8_WAIT_L(0); PG8_BAR; PG8_MMA(1, 0, At, B0); PG8_MMA(1, 1, At, B1); PG8_BAR; PG8_SCHED;
            PG8_LDB(B0, 1, 0); PG8_LDB(B1, 1, 1); PG8_SCHED; PG8_LDA(At, 1, 0); PG8_STAGE_A(PG8_SA(0, 1), a2, 1, la2, go2);
            PG8_WAIT_V(8); PG8_WAIT_L(0); PG8_BAR; PG8_MMA(0, 0, At, B0); PG8_MMA(0, 1, At, B1); PG8_BAR; PG8_SCHED;
            PG8_LDA(At, 1, 1); PG8_STAGE_B(PG8_SB(1, 0), b3, 0, lb2); PG8_STAGE_B(PG8_SB(1, 1), b3, 1, lb2); PG8_STAGE_A(PG8_SA(1, 0), a3, 0, la2, go2);
            PG8_WAIT_V(8); PG8_WAIT_L(0); PG8_BAR; PG8_MMA(1, 0, At, B0); PG8_MMA(1, 1, At, B1); PG8_BAR; PG8_SCHED;
        }
        if constexpr (ALIGN_EPI) { if (wr == 0) PG8_BAR; }
        const bool keep = E(acc, cur, wr, wc, fr, fq);
        if (!has_next) break;
        if (!keep) {
#pragma unroll
            for (int a = 0; a < 2; ++a)
#pragma unroll
                for (int b = 0; b < 2; ++b)
#pragma unroll
                    for (int m = 0; m < 4; ++m)
#pragma unroll
                        for (int n = 0; n < 2; ++n) acc[a][b][m][n] = (f32x4){0.f, 0.f, 0.f, 0.f};
        }
        cur = nxt; cA = nA; cB = nB; ++ui;
        if (MODE == 2) {
#pragma unroll
            for (int h = 0; h < 2; ++h)
#pragma unroll
                for (int i = 0; i < 2; ++i) cgo[h][i] = ngo[h][i];
        }
        if constexpr (ALIGN_EPI) { if (wr == 1) PG8_BAR; }
    }
    PG8_WAIT_V(0);
    if constexpr (!ALIGN_EPI) { if (wr == 0) PG8_BAR; }
    PG8_BAR;
#undef PG8_SA
#undef PG8_SB
#undef PG8_STAGE_A
#undef PG8_STAGE_B
#undef PG8_LDA
#undef PG8_LDB
#undef PG8_MMA
#undef PG8_WAIT_V
#undef PG8_WAIT_L
#undef PG8_BAR
#undef PG8_SCHED
}
}

__device__ __forceinline__ unsigned cvt_pk_bf16(float lo, float hi) { unsigned r; asm volatile("v_cvt_pk_bf16_f32 %0, %1, %2" : "=v"(r) : "v"(lo), "v"(hi)); return r; }
__device__ __forceinline__ u32x4 pack8(const f32x4& v0, const f32x4& v1) { u32x4 w; w.x = cvt_pk_bf16(v0[0], v0[1]); w.y = cvt_pk_bf16(v0[2], v0[3]); w.z = cvt_pk_bf16(v1[0], v1[1]); w.w = cvt_pk_bf16(v1[2], v1[3]); return w; }
__device__ __forceinline__ void unpack8(const u32x4& w, f32x4& v0, f32x4& v1) {
    v0[0] = __uint_as_float(w.x << 16); v0[1] = __uint_as_float(w.x & 0xffff0000u); v0[2] = __uint_as_float(w.y << 16); v0[3] = __uint_as_float(w.y & 0xffff0000u);
    v1[0] = __uint_as_float(w.z << 16); v1[1] = __uint_as_float(w.z & 0xffff0000u); v1[2] = __uint_as_float(w.w << 16); v1[3] = __uint_as_float(w.w & 0xffff0000u); }

struct DenseSched {
    const char* A; const char* B; int nM, nN, G, c, nt; unsigned lda2, ldb2;
    __device__ __forceinline__ bool next(int i, pg8::Unit& u) const {
        const int L = i * G + c; if (L >= nM * nN) return false;
        pg8::static_tile(L, nM, nN, u.pm, u.pn); u.aux = 0; u.nt = nt; u.lda2 = lda2; u.ldb2 = ldb2;
        u.A = A + (size_t)u.pm * 256 * lda2; u.B = B + (size_t)u.pn * 256 * ldb2; return true;
    }
    __device__ __forceinline__ unsigned row_off(const pg8::Unit&, int) const { return 0u; }
};

template <int MAP>
__device__ __forceinline__ int rowmap(int n) { if (MAP == 0) return n; return (n >> 7) * 256 + (n & 127) + (MAP == 2 ? 128 : 0); }
template <int MAP>
__device__ __forceinline__ void transpose_item(const float* W, int N, int ncol0, const float* gain, bf16* dst, int dld, int dcol0, LAS float* scr, int kb, int nb, int lane) {
    const int k0 = 64 * kb, n0 = 32 * nb;
    float tv_[32];
#pragma unroll
    for (int i = 0; i < 32; ++i) tv_[i] = W[(size_t)(k0 + 2 * i + (lane >> 5)) * N + ncol0 + n0 + (lane & 31)];
    if (gain) {
#pragma unroll
        for (int i = 0; i < 32; ++i) tv_[i] *= gain[k0 + 2 * i + (lane >> 5)];
    }
#pragma unroll
    for (int i = 0; i < 32; ++i) scr[(2 * i + (lane >> 5)) * 33 + (lane & 31)] = tv_[i];
    LDS_WAIT();
    const int c = lane & 7;
#pragma unroll
    for (int j = 0; j < 4; ++j) { const int n = (lane >> 3) + 8 * j; const LAS float* s = scr + (8 * c) * 33 + n;
        u32x4 o; o.x = pk2(s[0 * 33], s[1 * 33]); o.y = pk2(s[2 * 33], s[3 * 33]); o.z = pk2(s[4 * 33], s[5 * 33]); o.w = pk2(s[6 * 33], s[7 * 33]);
        *(u32x4*)(dst + (size_t)rowmap<MAP>(n0 + n) * dld + dcol0 + k0 + 8 * c) = o; }
    LDS_WAIT();
}

__device__ __forceinline__ void s5_setup_item(Frame& F, int l, int g);
#ifndef P0_LAYERS
#define P0_LAYERS 1
#endif
__device__ __forceinline__ void p0_weights(Frame& F, int l0, int l1, int worker, int nworkers) {
    LAS float* scr = (LAS float*)(F.lds + F.wave * 16384);
    unsigned char* ws = F.ws;
    constexpr int IT_WIN = 16 * 168, IT_GLU = 8 * 16 * 2, IT_BR = 3 * 8 * 32, IT_OUT = 16 * 32, IT_W13 = 16 * 2 * 16 * 8, IT_W2 = 48 * 4 * 32;
    constexpr int IT_LAYER = IT_WIN + IT_GLU + IT_BR + IT_OUT + IT_W13 + IT_W2;
    for (int it = l0 * IT_LAYER + worker; it < l1 * IT_LAYER; it += nworkers) {
        const int l = it / IT_LAYER; int r = it % IT_LAYER;
        if (r < IT_WIN) { transpose_item<0>(F.in[I_WIN] + (size_t)l * D * IN_COLS, IN_COLS, 0, F.in[I_N1G] + l * D, (bf16*)(ws + WS_WINT) + (size_t)l * IN_COLS * D, D, 0, scr, r / 168, r % 168, F.lane); continue; }
        r -= IT_WIN;
        if (r < IT_GLU) { const int half = r / (8 * 16); const int q = r % (8 * 16);
            const float* W = F.in[I_WGLU] + (size_t)l * BW * 1024; bf16* dst = (bf16*)(ws + WS_WGLUT) + (size_t)l * 1024 * BW;
            if (half == 0) transpose_item<1>(W, 1024, 0, nullptr, dst, BW, 0, scr, q / 16, q % 16, F.lane);
            else           transpose_item<2>(W, 1024, 512, nullptr, dst, BW, 0, scr, q / 16, q % 16, F.lane);
            continue; }
        r -= IT_GLU;
        if (r < IT_BR) { const int k = r / 256, q = r % 256; transpose_item<0>(F.in[I_WBR] + ((size_t)l * 3 + k) * BW * D, D, 0, nullptr, (bf16*)(ws + WS_WBRT) + ((size_t)l * 3 + k) * D * BW, BW, 0, scr, q / 32, q % 32, F.lane); continue; }
        r -= IT_BR;
        if (r < IT_OUT) { transpose_item<0>(F.in[I_WOUT] + (size_t)l * D * D, D, 0, nullptr, (bf16*)(ws + WS_WOUTT) + (size_t)l * D * D, D, 0, scr, r / 32, r % 32, F.lane); continue; }
        r -= IT_OUT;
        if (r < IT_W13) { const int ge = r / 256, q = r % 256, which = q / 128, qq = q % 128;
            const float* W = F.in[which ? I_W3 : I_W1] + ((size_t)l * 16 + ge) * D * 256; bf16* dst = (bf16*)(ws + WS_W13T) + ((size_t)l * 16 + ge) * 512 * D;
            if (which == 0) transpose_item<1>(W, 256, 0, F.in[I_N2G] + l * D, dst, D, 0, scr, qq / 8, qq % 8, F.lane);
            else            transpose_item<2>(W, 256, 0, F.in[I_N2G] + l * D, dst, D, 0, scr, qq / 8, qq % 8, F.lane);
            continue; }
        r -= IT_W13;
        { const int bs = r / 128, q = r % 128, bucket = bs >> 1, slot = bs & 1, g = bucket / 6; int pa, pb; pair_of(bucket % 6, pa, pb);
          const int e = g * 4 + (slot ? pb : pa);
          transpose_item<0>(F.in[I_W2] + ((size_t)l * 16 + e) * 256 * D, D, 0, nullptr, (bf16*)(ws + WS_W2TB) + ((size_t)l * NBUCKET + bucket) * D * 512, 512, slot * 256, scr, q / 32, q % 32, F.lane); }
    }
}
__device__ __forceinline__ void p0_prologue(Frame& F) {
    LAS float* scr = (LAS float*)(F.lds + F.wave * 16384);
    unsigned char* ws = F.ws;
    if (F.wg < DEPTH * 32) { s5_setup_item(F, F.wg >> 5, F.wg & 31); return; }
    const int gwx = (F.wg - DEPTH * 32) * NWAVES + F.wave; constexpr int NGX = (256 - DEPTH * 32) * NWAVES;
    p0_weights(F, 0, P0_LAYERS, gwx, NGX);
    {
        const float* x = F.in[I_X]; bf16* XB = (bf16*)(ws + WS_XB); float* rinv = (float*)(ws + WS_RINV1);
        for (int m0 = 4 * gwx; m0 < M; m0 += 4 * NGX) {
            f32x4 v[4][4]; float s4[4];
#pragma unroll
            for (int a = 0; a < 4; ++a) { const f32x4* xr = (const f32x4*)(x + (size_t)(m0 + a) * D) + F.lane;
#pragma unroll
                for (int j = 0; j < 4; ++j) v[a][j] = xr[64 * j]; }
#pragma unroll
            for (int a = 0; a < 4; ++a) { float s = 0.f;
#pragma unroll
                for (int j = 0; j < 4; ++j) s += (v[a][j].x * v[a][j].x + v[a][j].y * v[a][j].y) + (v[a][j].z * v[a][j].z + v[a][j].w * v[a][j].w);
                s4[a] = wave_sum(s, F.lane);
                u32x2* o = (u32x2*)(XB + (size_t)(m0 + a) * D) + F.lane;
#pragma unroll
                for (int j = 0; j < 4; ++j) { u32x2 w; w.x = pk2(v[a][j].x, v[a][j].y); w.y = pk2(v[a][j].z, v[a][j].w); o[64 * j] = w; } }
            if (F.lane < 4) { const float s = F.lane == 0 ? s4[0] : (F.lane == 1 ? s4[1] : (F.lane == 2 ? s4[2] : s4[3])); rinv[m0 + F.lane] = 1.0f / sqrtf(s * (1.0f / D) + NORM_EPS); }
        }
    }
    {
        bf16* lf = (bf16*)(ws + WS_LRUF);
        for (int i = gwx * 64 + F.lane; i < DEPTH * 2 * 8 * 2 * 2 * 4 * 64; i += NGX * 64) {
            const int ln = i & 63, ks = (i >> 6) & 3, gate = (i >> 8) & 1, nh = (i >> 9) & 1, hb = (i >> 10) & 7, ld = i >> 13;
            const float* W = F.in[gate ? I_LWI : I_LWR] + ((size_t)ld * 8 + hb) * 4096 + nh * 32 + (ln & 31);
            const int k0 = 16 * ks + 8 * (ln >> 5);
            u32x4 o; o.x = pk2(W[(size_t)(k0 + 0) * 64], W[(size_t)(k0 + 1) * 64]); o.y = pk2(W[(size_t)(k0 + 2) * 64], W[(size_t)(k0 + 3) * 64]);
            o.z = pk2(W[(size_t)(k0 + 4) * 64], W[(size_t)(k0 + 5) * 64]); o.w = pk2(W[(size_t)(k0 + 6) * 64], W[(size_t)(k0 + 7) * 64]);
            *(u32x4*)(lf + (size_t)i * 8) = o;
        }
    }
    {
        float* wrt = (float*)(ws + WS_WRT);
        for (int i = gwx * 64 + F.lane; i < DEPTH * 20 * D; i += NGX * 64) {
            const int k = i % D, j = (i / D) % 20, l = i / (20 * D);
            const float g2 = F.in[I_N2G][l * D + k];
            wrt[i] = g2 * (j < 4 ? F.in[I_WG][((size_t)l * D + k) * 4 + j] : F.in[I_WE][((size_t)l * D + k) * 16 + (j - 4)]);
        }
    }
}

typedef float f32x16 __attribute__((ext_vector_type(16)));
#define MFMA32(a, b, c) __builtin_amdgcn_mfma_f32_32x32x16_bf16((a), (b), (c), 0, 0, 0)
constexpr int S5_ETAB = 0, S5_UIMG = 8192, S5_HIMG = 8192 + 67584, S5_CSTR = 528;

__device__ __forceinline__ void s5_setup_item(Frame& F, int l, int g) {
    LAS float* PW = (LAS float*)F.lds;
    LAS float* BB = PW + 4352;
    LAS float* CC = BB + 4096;
    LAS float* KT = CC + 2048;
    const int tid = F.tid;
    __syncthreads();
    if (tid < 128) {
        const int d = tid >> 6, n = tid & 63, ld = l * 2 + d;
        const float are = F.in[I_ARE][(size_t)ld * 2048 + g * 64 + n], aim = F.in[I_AIM][(size_t)ld * 2048 + g * 64 + n];
        const float step = expf(F.in[I_LSTEP][ld * 32 + g]);
        const double ang1 = (double)aim * (double)step, lm1 = (double)are * (double)step;
        float abr = 0.f, abi = 0.f;
        for (int j = 0; j <= 16; ++j) { const double a = fmod(ang1 * j, 6.283185307179586); float sn, cs; sincosf((float)a, &sn, &cs); const float mg = expf((float)(lm1 * j));
            PW[((d * 64 + n) * 17 + j) * 2] = mg * cs; PW[((d * 64 + n) * 17 + j) * 2 + 1] = mg * sn; if (j == 1) { abr = mg * cs; abi = mg * sn; } }
        { float* lam = (float*)(F.ws + WS_S5LAM) + ((((size_t)l * 32 + g) * 2 + d) * 64 + n) * 4;
          const double a16 = fmod(ang1 * 16.0, 6.283185307179586), a256 = fmod(ang1 * 256.0, 6.283185307179586); float sn, cs;
          sincosf((float)a16, &sn, &cs); const float m16 = expf((float)(lm1 * 16.0)); lam[0] = m16 * cs; lam[1] = m16 * sn;
          sincosf((float)a256, &sn, &cs); const float m256 = expf((float)(lm1 * 256.0)); lam[2] = m256 * cs; lam[3] = m256 * sn; }
        const float den = are * are + aim * aim, nr = abr - 1.0f;
        const float sr = (nr * are + abi * aim) / den, si = (abi * are - nr * aim) / den;
        const float* bre = F.in[I_BRE] + ((size_t)ld * 2048 + g * 64 + n) * 16; const float* bim = F.in[I_BIM] + ((size_t)ld * 2048 + g * 64 + n) * 16;
        for (int c = 0; c < 16; ++c) { BB[((d * 64 + n) * 16 + c) * 2] = sr * bre[c] - si * bim[c]; BB[((d * 64 + n) * 16 + c) * 2 + 1] = sr * bim[c] + si * bre[c]; }
    }
    for (int i = tid; i < 1024; i += NTHREADS) { CC[i * 2] = F.in[I_CRE][((size_t)l * 32 + g) * 1024 + i]; CC[i * 2 + 1] = F.in[I_CIM][((size_t)l * 32 + g) * 1024 + i]; }
    __syncthreads();
    for (int q = tid; q < 8192; q += NTHREADS) {
        const int c = q & 15, cp = (q >> 4) & 15, dl = (q >> 8) & 15, d = q >> 12; float acc = 0.f;
        for (int n = 0; n < 64; ++n) { const float cr = CC[(cp * 64 + n) * 2], ci = CC[(cp * 64 + n) * 2 + 1], pr = PW[((d * 64 + n) * 17 + dl) * 2], pi = PW[((d * 64 + n) * 17 + dl) * 2 + 1];
            const float br = BB[((d * 64 + n) * 16 + c) * 2], bi = BB[((d * 64 + n) * 16 + c) * 2 + 1]; acc += (cr * pr - ci * pi) * br - (cr * pi + ci * pr) * bi; }
        KT[q] = acc;
    }
    __syncthreads();
    bf16* WsF = (bf16*)(F.ws + WS_S5MAT) + ((size_t)l * 32 + g) * 196608; bf16* W3F = WsF + 65536;
    for (int q = tid; q < 8192; q += NTHREADS) {
        const int row = q >> 5, kc = (q & 31) * 8, s_ = kc >> 4, c0 = kc & 15;
        const int nn = row & 31, ri = (row >> 5) & 1, sh = (row >> 6) & 1, d = row >> 7, n = sh * 32 + nn, e = d ? s_ : 15 - s_;
        const float pr = PW[((d * 64 + n) * 17 + e) * 2], pi = PW[((d * 64 + n) * 17 + e) * 2 + 1]; float v[8];
#pragma unroll
        for (int j = 0; j < 8; ++j) { const float br = BB[((d * 64 + n) * 16 + c0 + j) * 2], bi = BB[((d * 64 + n) * 16 + c0 + j) * 2 + 1]; v[j] = ri ? (pr * bi + pi * br) : (pr * br - pi * bi); }
        u32x4 o; o.x = pk2(v[0], v[1]); o.y = pk2(v[2], v[3]); o.z = pk2(v[4], v[5]); o.w = pk2(v[6], v[7]);
        const int tile = row >> 5, ks = kc >> 4, ln = (row & 31) + 32 * ((kc >> 3) & 1);
        *(u32x4*)(WsF + ((size_t)(tile * 16 + ks) * 64 + ln) * 8) = o;
    }
    const float* dsk = F.in[I_SD] + l * BW + g * 16;
    for (int q = tid; q < 16384; q += NTHREADS) {
        const int row = q >> 6, kc = (q & 63) * 8, tau = row >> 4, cp = row & 15; float v[8];
        if (kc < 256) { const int s_ = kc >> 4, c0 = kc & 15;
#pragma unroll
            for (int j = 0; j < 8; ++j) { float m = 0.f; if (s_ <= tau) m += KT[((0 * 16 + (tau - s_)) * 16 + cp) * 16 + c0 + j]; if (s_ >= tau) m += KT[((1 * 16 + (s_ - tau)) * 16 + cp) * 16 + c0 + j];
                if (s_ == tau && c0 + j == cp) m += dsk[cp]; v[j] = m; }
        } else {
#pragma unroll
            for (int j = 0; j < 8; ++j) { const int kh = kc - 256 + j, d = kh >> 7, n = (kh & 127) >> 1, ri = kh & 1, p = d ? 16 - tau : tau + 1;
                const float cr = CC[(cp * 64 + n) * 2], ci = CC[(cp * 64 + n) * 2 + 1], pr = PW[((d * 64 + n) * 17 + p) * 2], pi = PW[((d * 64 + n) * 17 + p) * 2 + 1];
                v[j] = ri ? -(cr * pi + ci * pr) : (cr * pr - ci * pi); }
        }
        u32x4 o; o.x = pk2(v[0], v[1]); o.y = pk2(v[2], v[3]); o.z = pk2(v[4], v[5]); o.w = pk2(v[6], v[7]);
        const int tile = row >> 5, ks = kc >> 4, ln = (row & 31) + 32 * ((kc >> 3) & 1);
        *(u32x4*)(W3F + ((size_t)(tile * 32 + ks) * 64 + ln) * 8) = o;
    }
}


__device__ __forceinline__ void s5_scan_a(f32x16& re, f32x16& im, float Lr, float Li, LAS float* e) {
#pragma unroll
    for (int i = 1; i < 16; ++i) { const float pr = re[i - 1], pi = im[i - 1]; re[i] += Lr * pr - Li * pi; im[i] += Lr * pi + Li * pr; }
    e[0] = re[15]; e[1] = im[15];
}
__device__ __forceinline__ void s5_scan_b(f32x16& re, f32x16& im, float Lr, float Li, float L16r, float L16i, const LAS float* et, int sg, LAS unsigned char* hp, int hstep) {
    float cr = 0.f, ci = 0.f;
#pragma unroll
    for (int sp = 0; sp < 8; ++sp) { const bool use = sp < sg; const float er = et[sp * 64], ei = et[sp * 64 + 1];
        const float nr_ = L16r * cr - L16i * ci + er, ni_ = L16r * ci + L16i * cr + ei; cr = use ? nr_ : cr; ci = use ? ni_ : ci; }
    float pr = Lr, pi = Li;
#pragma unroll
    for (int i = 0; i < 16; ++i) { re[i] += pr * cr - pi * ci; im[i] += pr * ci + pi * cr; const float t = pr * Lr - pi * Li; pi = pr * Li + pi * Lr; pr = t; }
#pragma unroll
    for (int i = 0; i < 16; ++i) *(LAS unsigned*)(hp + i * hstep) = pk2(re[i], im[i]);
}

__device__ __forceinline__ void s5_mfma(Frame& F, int l) {
    const bf16* Z1 = (const bf16*)(F.ws + WS_Z1); bf16* YS = (bf16*)(F.ws + WS_YS);
    LAS unsigned char* UIMG = F.lds + S5_UIMG; LAS unsigned char* HIMG = F.lds + S5_HIMG; LAS float* ETAB = (LAS float*)(F.lds + S5_ETAB);
    const int tid = F.tid, lane = F.lane, w = F.wave, r = lane & 31, h = lane >> 5;
    const int item0 = F.wg >= 128 ? (F.wg - 128) * 4 : 0, item1 = F.wg >= 128 ? item0 + 4 : 0;
    u32x4 uv[8];
#define S5_LOAD_U(IT) do { const int b_ = (IT) >> 5, g_ = (IT) & 31; _Pragma("unroll") for (int q = 0; q < 8; ++q) { const int p = tid + q * NTHREADS, token = p >> 1, half = p & 1; \
        uv[q] = *(const u32x4*)(Z1 + ((size_t)b_ * SEQ + token) * ZC + COL_U + g_ * 16 + half * 8); } } while (0)
    if (item0 < item1) S5_LOAD_U(item0);
    for (int item = item0; item < item1; ++item) {
        const int b = item >> 5, g = item & 31;
        const bf16* WsF = (const bf16*)(F.ws + WS_S5MAT) + ((size_t)l * 32 + g) * 196608; const bf16* W3F = WsF + 65536;
        __syncthreads();
        {
#pragma unroll
          for (int q = 0; q < 8; ++q) { const int p = tid + q * NTHREADS, token = p >> 1, half = p & 1; *(LAS u32x4*)(UIMG + (token >> 4) * S5_CSTR + (token & 15) * 32 + half * 16) = uv[q]; } }
        { unsigned z = 0u; asm volatile("" : "+v"(z));
          if (tid < 16) *(LAS u32x4*)(HIMG + 1 * S5_CSTR + tid * 16) = (u32x4){z, z, z, z};
          else if (tid < 32) *(LAS u32x4*)(HIMG + 128 * S5_CSTR + 256 + (tid - 16) * 16) = (u32x4){z, z, z, z}; }
        __syncthreads();
        if (item + 1 < item1) S5_LOAD_U(item + 1);
        const int d = w >> 2, sh = (w >> 1) & 1, mh = w & 1;
        f32x16 sre[2], sim[2];
#pragma unroll
        for (int i = 0; i < 16; ++i) { sre[0][i] = 0.f; sre[1][i] = 0.f; sim[0][i] = 0.f; sim[1][i] = 0.f; }
        {
            const int qf = 16 * ((r >> 2) & 1) + 4 * (r >> 3) + (r & 3);
            const int qr = d ? 127 - (64 * mh + qf) : 64 * mh + qf;
            const bf16* bre = WsF + ((size_t)(((d * 2 + sh) * 2 + 0) * 16) * 64 + lane) * 8; const bf16* bim = bre + (size_t)16 * 64 * 8;
            const LAS unsigned char* a0 = UIMG + qr * S5_CSTR + 16 * h; const LAS unsigned char* a1 = UIMG + (d ? qr - 32 : qr + 32) * S5_CSTR + 16 * h;
            unsigned zq = 0u; asm volatile("" : "+v"(zq));
            u32x4 gre[4], gim[4], l0, l1, ore, oim, ox0, ox1;
#pragma unroll
            for (int q = 0; q < 4; ++q) { gre[q] = *(const u32x4*)(bre + q * 512); gim[q] = *(const u32x4*)(bim + q * 512); }
            l0 = *(const LAS u32x4*)(a0); l1 = *(const LAS u32x4*)(a1);
            ore = oim = ox0 = ox1 = (u32x4){0u, 0u, 0u, 0u};
#pragma unroll
            for (int ks = 0; ks < 16; ++ks) {
                asm volatile("s_nop 15\n\ts_nop 15" : "+v"(zq), "+v"(ore), "+v"(oim), "+v"(ox0), "+v"(ox1));
                ore = gre[ks & 3] ^ zq; oim = gim[ks & 3] ^ zq; ox0 = l0 ^ zq; ox1 = l1 ^ zq;
                asm volatile("" : "+v"(ore), "+v"(oim), "+v"(ox0), "+v"(ox1));
                if (ks + 4 < 16) { gre[ks & 3] = *(const u32x4*)(bre + (ks + 4) * 512); gim[ks & 3] = *(const u32x4*)(bim + (ks + 4) * 512); }
                if (ks + 1 < 16) { l0 = *(const LAS u32x4*)(a0 + (ks + 1) * 32); l1 = *(const LAS u32x4*)(a1 + (ks + 1) * 32); }
                sre[0] = MFMA32(__builtin_bit_cast(bf16x8, ox0), __builtin_bit_cast(bf16x8, ore), sre[0]); sim[0] = MFMA32(__builtin_bit_cast(bf16x8, ox0), __builtin_bit_cast(bf16x8, oim), sim[0]);
                sre[1] = MFMA32(__builtin_bit_cast(bf16x8, ox1), __builtin_bit_cast(bf16x8, ore), sre[1]); sim[1] = MFMA32(__builtin_bit_cast(bf16x8, ox1), __builtin_bit_cast(bf16x8, oim), sim[1]);
            }
            asm volatile("" : "+v"(ore), "+v"(oim), "+v"(ox0), "+v"(ox1));
        }
        __builtin_amdgcn_sched_barrier(0);
        asm volatile("s_nop 15\n\ts_nop 15\n\ts_nop 15\n\ts_nop 15\n\ts_nop 15" : "+v"(sre[0]), "+v"(sre[1]), "+v"(sim[0]), "+v"(sim[1]));
        __builtin_amdgcn_sched_barrier(0);

        const int n = sh * 32 + r;
        const f32x4 lam = *(const f32x4*)((const float*)(F.ws + WS_S5LAM) + ((((size_t)l * 32 + g) * 2 + d) * 64 + n) * 4);
        LAS float* et = ETAB + ((d * 2 + sh) * 8) * 64 + r * 2;
        const int sg0 = 4 * mh + h, sg1 = sg0 + 2;
        s5_scan_a(sre[0], sim[0], lam[0], lam[1], et + sg0 * 64); s5_scan_a(sre[1], sim[1], lam[0], lam[1], et + sg1 * 64);
        __syncthreads();
        {
            const int cs0 = 16 * sg0, cs1 = 16 * sg1, hstep = d ? -S5_CSTR : S5_CSTR;
            LAS unsigned char* hcol = HIMG + d * 256 + 4 * n;
            s5_scan_b(sre[0], sim[0], lam[0], lam[1], lam[2], lam[3], et, sg0, hcol + (d ? 127 - cs0 : cs0 + 2) * S5_CSTR, hstep);
            s5_scan_b(sre[1], sim[1], lam[0], lam[1], lam[2], lam[3], et, sg1, hcol + (d ? 127 - cs1 : cs1 + 2) * S5_CSTR, hstep);
        }
        __syncthreads();
        f32x16 acc[4];
#pragma unroll
        for (int nt = 0; nt < 4; ++nt)
#pragma unroll
            for (int i = 0; i < 16; ++i) acc[nt][i] = 0.f;
        {
            const bf16* ap = W3F + ((size_t)(w * 32) * 64 + lane) * 8;
            unsigned bxa[4], bha[4];
#pragma unroll
            for (int nt = 0; nt < 4; ++nt) { bxa[nt] = (unsigned)(S5_UIMG + (nt * 32 + r) * S5_CSTR + 16 * h); bha[nt] = (unsigned)(S5_HIMG + (nt * 32 + r + 1) * S5_CSTR + 16 * h); }
            unsigned zq = 0u; asm volatile("" : "+v"(zq));
            u32x4 ga[4], lx[4], oa, ox[4];
#pragma unroll
            for (int q = 0; q < 4; ++q) ga[q] = *(const u32x4*)(ap + q * 512);
#pragma unroll
            for (int nt = 0; nt < 4; ++nt) { lx[nt] = *(const LAS u32x4*)(F.lds + bxa[nt]); ox[nt] = (u32x4){0u, 0u, 0u, 0u}; }
            oa = (u32x4){0u, 0u, 0u, 0u};
#pragma unroll
            for (int ks = 0; ks < 32; ++ks) {
                asm volatile("s_nop 15\n\ts_nop 15" : "+v"(zq), "+v"(oa), "+v"(ox[0]), "+v"(ox[1]), "+v"(ox[2]), "+v"(ox[3]));
                oa = ga[ks & 3] ^ zq;
#pragma unroll
                for (int nt = 0; nt < 4; ++nt) ox[nt] = lx[nt] ^ zq;
                asm volatile("" : "+v"(oa), "+v"(ox[0]), "+v"(ox[1]), "+v"(ox[2]), "+v"(ox[3]));
                if (ks + 4 < 32) ga[ks & 3] = *(const u32x4*)(ap + (ks + 4) * 512);
                if (ks + 1 < 32) {
#pragma unroll
                    for (int nt = 0; nt < 4; ++nt) lx[nt] = *(const LAS u32x4*)(F.lds + ((ks + 1) < 16 ? bxa[nt] + (ks + 1) * 32 : bha[nt] + (ks + 1 - 16) * 32));
                }
#pragma unroll
                for (int nt = 0; nt < 4; ++nt) acc[nt] = MFMA32(__builtin_bit_cast(bf16x8, oa), __builtin_bit_cast(bf16x8, ox[nt]), acc[nt]);
            }
            asm volatile("" : "+v"(oa), "+v"(ox[0]), "+v"(ox[1]), "+v"(ox[2]), "+v"(ox[3]));
            asm volatile("" :: "v"(bxa[0]), "v"(bxa[1]), "v"(bxa[2]), "v"(bxa[3]), "v"(bha[0]), "v"(bha[1]), "v"(bha[2]), "v"(bha[3]));
        }
        __builtin_amdgcn_sched_barrier(0);
        asm volatile("s_nop 15\n\ts_nop 15\n\ts_nop 15\n\ts_nop 15\n\ts_nop 15" : "+v"(acc[0]), "+v"(acc[1]), "+v"(acc[2]), "+v"(acc[3]));
        __builtin_amdgcn_sched_barrier(0);
#pragma unroll
        for (int nt = 0; nt < 4; ++nt)
#pragma unroll
            for (int gq = 0; gq < 4; ++gq) { const int tau = 2 * w + (gq >> 1), cp = 8 * (gq & 1) + 4 * h, token = (32 * nt + r) * 16 + tau;
                u32x2 o; o.x = pk2hw(gelu_tanh(acc[nt][4 * gq]), gelu_tanh(acc[nt][4 * gq + 1])); o.y = pk2hw(gelu_tanh(acc[nt][4 * gq + 2]), gelu_tanh(acc[nt][4 * gq + 3]));
                *(u32x2*)(YS + ((size_t)b * SEQ + token) * BW + g * 16 + cp) = o; }
    }
#undef S5_LOAD_U
    __syncthreads();
}


#define MFMA_FENCE3(a, b, c) asm volatile("s_nop 15\n\ts_nop 15\n\ts_nop 15\n\ts_nop 15\n\ts_nop 15" : "+v"(a), "+v"(b), "+v"(c))
__device__ __forceinline__ void lru_half_scan(f32x16& aR, f32x16& aI, const f32x16& aX, float br, float bi, float lamc, LAS float* sgw) {
    float Pp = 1.f, Hh = 0.f;
#pragma unroll
    for (int i = 0; i < 16; ++i) {
        const float rg = sigmoidf_(aR[i] + br), ig = sigmoidf_(aI[i] + bi), x2 = 2.0f * lamc * rg;
        const float a = __builtin_amdgcn_exp2f(0.72134752044f * x2);
        const float om = __builtin_fmaf(-a, a, 1.0f);
        const float u = __builtin_amdgcn_sqrtf(fmaxf(om, 0.f)) * ig * aX[i];
        Hh = a * Hh + u; Pp = a * Pp; aR[i] = Hh; aI[i] = Pp;
        if ((i & 3) == 3) asm volatile("" : "+v"(Hh), "+v"(Pp));
    }
    sgw[0] = Pp; sgw[1] = Hh;
}
constexpr int LRU_TILE = 16384, LRU_TILE_BYTES = 33 * 1024;
__device__ __forceinline__ void lru_mfma(Frame& F, int l) {
    const bf16* Z1 = (const bf16*)(F.ws + WS_Z1); bf16* OL = (bf16*)(F.ws + WS_OL);
    LAS float* CW = (LAS float*)F.lds;
    LAS float* SEG = CW + 320;
    const int tid = F.tid, lane = F.lane, w = F.wave, r = lane & 31, hh = lane >> 5;
    for (int item = F.wg; item < (F.wg < 128 ? BATCH * 8 : 0); item += 128) {
        const int b = item >> 3, hb = item & 7, ch0 = hb * 64 + r;
        __syncthreads();
        if (tid < 256) CW[tid] = F.in[I_CONVW][((size_t)l * 4 + (tid >> 6)) * BW + hb * 64 + (tid & 63)];
        else if (tid < 320) CW[tid] = F.in[I_CONVB][l * BW + hb * 64 + (tid - 256)];
        const int qf = 16 * ((r >> 2) & 1) + 4 * (r >> 3) + (r & 3);
        const bf16* xrb = Z1 + (size_t)b * SEQ * ZC + COL_XR + hb * 64 + (lane & 7) * 8;
#pragma unroll 1
        for (int dir = 0; dir < 2; ++dir) {
            bf16x8 wr[2][4], wi[2][4];
#pragma unroll
            for (int nh = 0; nh < 2; ++nh) { const bf16* lf = (const bf16*)(F.ws + WS_LRUF) + ((((((size_t)l * 2 + dir) * 8 + hb) * 2 + nh) * 2) * 4 * 64 + lane) * 8;
#pragma unroll
              for (int ks = 0; ks < 4; ++ks) { wr[nh][ks] = *(const bf16x8*)(lf + (size_t)ks * 512); wi[nh][ks] = *(const bf16x8*)(lf + (size_t)(4 + ks) * 512); } }
            float br[2], bi[2], lamc[2], carry[2] = {0.f, 0.f};
#pragma unroll
            for (int nh = 0; nh < 2; ++nh) { const int ch = ch0 + 32 * nh; br[nh] = F.in[I_LBR][((size_t)l * 2 + dir) * BW + ch]; bi[nh] = F.in[I_LBI][((size_t)l * 2 + dir) * BW + ch];
                lamc[nh] = -8.0f * log1pf(expf(-F.in[I_LAM][((size_t)l * 2 + dir) * BW + ch])); }
#define LRU_STAGE(SC) do { const int tlo_ = dir ? SEQ - 256 * ((SC) + 1) : 256 * (SC); \
                for (int j_ = w; j_ < 33; j_ += NWAVES) { int t_ = tlo_ - 2 + 8 * j_ + (lane >> 3); t_ = t_ < 0 ? 0 : (t_ >= SEQ ? SEQ - 1 : t_); \
                    __builtin_amdgcn_global_load_lds((const unsigned*)(xrb + (size_t)t_ * ZC), (LAS unsigned*)(F.lds + LRU_TILE + ((SC) & 1) * LRU_TILE_BYTES + j_ * 1024), 16, 0, 0); } } while (0)
            LRU_STAGE(0);
#pragma unroll 1
            for (int sc = 0; sc < 8; ++sc) {
                asm volatile("s_waitcnt vmcnt(0)" ::: "memory"); __syncthreads();
                if (sc + 1 < 8) LRU_STAGE(sc + 1);
                const int srow = sc * 256 + w * 32 + qf, trow = dir ? (SEQ - 1 - srow) : srow, tlo = dir ? SEQ - 256 * (sc + 1) : 256 * sc;
                const LAS unsigned char* tl = F.lds + LRU_TILE + (sc & 1) * LRU_TILE_BYTES + (trow - tlo) * 128 + 16 * hh;
                bf16x8 av[4];
#pragma unroll
                for (int ks = 0; ks < 4; ++ks) {
                    const int c0 = 16 * ks + 8 * hh;
                    float xv[8];
#pragma unroll
                    for (int j = 0; j < 8; ++j) xv[j] = CW[256 + c0 + j];
#pragma unroll
                    for (int tap = 0; tap < 4; ++tap) { const int tt = trow + tap - 2; const float msk = (tt >= 0 && tt < SEQ) ? 1.0f : 0.0f;
                        const bf16x8 v = *(const LAS bf16x8*)(tl + tap * 128 + ks * 32);
#pragma unroll
                        for (int j = 0; j < 8; ++j) xv[j] += (CW[tap * 64 + c0 + j] * msk) * bf2f((bf16)v[j]); }
                    u32x4 pa; pa.x = pk2hw(xv[0], xv[1]); pa.y = pk2hw(xv[2], xv[3]); pa.z = pk2hw(xv[4], xv[5]); pa.w = pk2hw(xv[6], xv[7]);
                    av[ks] = __builtin_bit_cast(bf16x8, pa);
                }
                const int st0 = sc * 256 + w * 32 + 16 * hh; const size_t tok0 = (size_t)b * SEQ + (dir ? (SEQ - 1 - st0) : st0); const long tstep = dir ? -1 : 1;
#pragma unroll
                for (int nh = 0; nh < 2; ++nh) {
                    const int ch = ch0 + 32 * nh;
                    f32x16 aR, aI, aX;
#pragma unroll
                    for (int i = 0; i < 16; ++i) { aR[i] = 0.f; aI[i] = 0.f; aX[i] = 0.f; }
                    bf16x8 idf[4];
#pragma unroll
                    for (int ks = 0; ks < 4; ++ks) { u32x4 pd_;
#pragma unroll
                        for (int jj = 0; jj < 4; ++jj) { const int k0 = 16 * ks + 8 * hh + 2 * jj; pd_[jj] = (k0 == nh * 32 + r ? 0x3f80u : 0u) | (k0 + 1 == nh * 32 + r ? 0x3f800000u : 0u); }
                        idf[ks] = __builtin_bit_cast(bf16x8, pd_); }
                    __builtin_amdgcn_sched_barrier(0);
#pragma unroll
                    for (int ks = 0; ks < 4; ++ks) { aR = MFMA32(av[ks], wr[nh][ks], aR); aI = MFMA32(av[ks], wi[nh][ks], aI); aX = MFMA32(av[ks], idf[ks], aX); }
                    __builtin_amdgcn_sched_barrier(0);
                    MFMA_FENCE3(aR, aI, aX);
                    __builtin_amdgcn_sched_barrier(0);
                    bf16 hfv[16], grv[16];
                    if (dir) {
#pragma unroll
                        for (int i = 0; i < 16; ++i) { const size_t tok = tok0 + tstep * i; hfv[i] = OL[tok * BW + ch]; grv[i] = Z1[tok * ZC + COL_GR + ch]; }
                    }
                    LAS float* sg = SEG + nh * 1024;
                    lru_half_scan(aR, aI, aX, br[nh], bi[nh], lamc[nh], sg + ((2 * w + hh) * 32 + r) * 2);
                    __syncthreads();
                    float cin = 0.f, X = carry[nh];
#pragma unroll
                    for (int sp = 0; sp < 16; ++sp) { cin = (sp == 2 * w + hh) ? X : cin; X = sg[(sp * 32 + r) * 2] * X + sg[(sp * 32 + r) * 2 + 1]; }
                    carry[nh] = X;
                    if (dir == 0) {
#pragma unroll
                        for (int i = 0; i < 16; i += 2) { const unsigned p = pk2hw(aR[i] + aI[i] * cin, aR[i + 1] + aI[i + 1] * cin);
                            OL[(tok0 + tstep * i) * BW + ch] = (bf16)(p & 0xffffu); OL[(tok0 + tstep * (i + 1)) * BW + ch] = (bf16)(p >> 16); }
                    } else {
#pragma unroll
                        for (int i = 0; i < 16; i += 2) { const unsigned p = pk2hw(gelu_tanh(bf2f(grv[i])) * (bf2f(hfv[i]) + aR[i] + aI[i] * cin), gelu_tanh(bf2f(grv[i + 1])) * (bf2f(hfv[i + 1]) + aR[i + 1] + aI[i + 1] * cin));
                            OL[(tok0 + tstep * i) * BW + ch] = (bf16)(p & 0xffffu); OL[(tok0 + tstep * (i + 1)) * BW + ch] = (bf16)(p >> 16); }
                    }
                }
            }
            asm volatile("s_waitcnt vmcnt(0)" ::: "memory"); __syncthreads();
        }
    }
    __syncthreads();
}

#ifndef ATT_LO
#define ATT_LO 1
#endif
constexpr int AT_KSTR = 144, AT_VSTR = 776, AT_K = 0, AT_V = 384 * AT_KSTR;
__device__ __forceinline__ void attn_mfma(Frame& F, int l) {
    const bf16* Z1 = (const bf16*)(F.ws + WS_Z1); bf16* OA = (bf16*)(F.ws + WS_OA);
    LAS unsigned char* KL = F.lds + AT_K; LAS unsigned char* VT = F.lds + AT_V;
    const int tid = F.tid, lane = F.lane, w = F.wave, r = lane & 31, hh = lane >> 5;
    const float LOG2E = 1.4426950408889634f;
    for (int k = 0; k < (F.wg < 128 ? ATT_LO : 4 - ATT_LO); ++k) {
        const int item = F.wg < 128 ? F.wg * ATT_LO + k : 128 * ATT_LO + (F.wg - 128) * (4 - ATT_LO) + k;
        const int b = item >> 5, nb = (item >> 1) & 15, kvh = item & 1;
        __syncthreads();
        { u32x4 kq[6], vq[6];
#pragma unroll
          for (int q = 0; q < 6; ++q) { const int p = tid + q * NTHREADS, kj = p >> 3, dc = p & 7, sp = nb * 128 - 128 + kj; const bool ok = (sp >= 0 && sp < SEQ);
              const bf16* base = Z1 + ((size_t)b * SEQ + (ok ? sp : 0)) * ZC + kvh * 64 + dc * 8; kq[q] = *(const u32x4*)(base + COL_K); vq[q] = *(const u32x4*)(base + COL_V);
              if (!ok) { kq[q] = (u32x4){0u, 0u, 0u, 0u}; vq[q] = (u32x4){0u, 0u, 0u, 0u}; } }
#pragma unroll
          for (int q = 0; q < 6; ++q) { const int p = tid + q * NTHREADS, kj = p >> 3, dc = p & 7; const u32x4 vv = vq[q];
              *(LAS u32x4*)(KL + kj * AT_KSTR + dc * 16) = kq[q];
              LAS bf16* vt = (LAS bf16*)(VT + (dc * 8) * AT_VSTR + kj * 2);
              vt[0 * (AT_VSTR / 2)] = (bf16)(vv.x & 0xffffu); vt[1 * (AT_VSTR / 2)] = (bf16)(vv.x >> 16); vt[2 * (AT_VSTR / 2)] = (bf16)(vv.y & 0xffffu); vt[3 * (AT_VSTR / 2)] = (bf16)(vv.y >> 16);
              vt[4 * (AT_VSTR / 2)] = (bf16)(vv.z & 0xffffu); vt[5 * (AT_VSTR / 2)] = (bf16)(vv.z >> 16); vt[6 * (AT_VSTR / 2)] = (bf16)(vv.w & 0xffffu); vt[7 * (AT_VSTR / 2)] = (bf16)(vv.w >> 16); } }
        __syncthreads();
#pragma unroll 1
        for (int task = w; task < 16; task += NWAVES) {
            const int g = task >> 2, qt = task & 3, hq = kvh * 4 + g;
            const size_t tokq = (size_t)b * SEQ + nb * 128 + 32 * qt + r;
            bf16x8 qf[4];
#pragma unroll
            for (int ks = 0; ks < 4; ++ks) qf[ks] = *(const bf16x8*)(Z1 + tokq * ZC + COL_Q + hq * 64 + 16 * ks + 8 * hh);
            const float slope2 = exp2f(-(float)(hq + 1)) * LOG2E, sink2 = F.in[I_SINK][l * NQ + hq] * LOG2E;
            float m = sink2, lsum = 1.0f;
            f32x16 o0, o1;
#pragma unroll
            for (int i = 0; i < 16; ++i) { o0[i] = 0.f; o1[i] = 0.f; }
            u32x4 ka[4] = {(u32x4){0u, 0u, 0u, 0u}, (u32x4){0u, 0u, 0u, 0u}, (u32x4){0u, 0u, 0u, 0u}, (u32x4){0u, 0u, 0u, 0u}};
            u32x4 pp0 = (u32x4){0u, 0u, 0u, 0u}, pp1 = pp0, va0 = pp0, va1 = pp0, va2 = pp0, va3 = pp0;
#pragma unroll 1
            for (int kt = qt; kt < qt + 9; ++kt) {
                f32x16 sc;
#pragma unroll
                for (int i = 0; i < 16; ++i) sc[i] = 0.f;
                { const LAS unsigned char* kp = KL + (32 * kt + r) * AT_KSTR + 16 * hh;
#pragma unroll
                  for (int ks = 0; ks < 4; ++ks) ka[ks] = *(const LAS u32x4*)(kp + ks * 32);
#pragma unroll
                  for (int ks = 0; ks < 4; ++ks) sc = MFMA32(__builtin_bit_cast(bf16x8, ka[ks]), qf[ks], sc); }
                __builtin_amdgcn_sched_barrier(0);
                asm volatile("s_nop 15\n\ts_nop 15\n\ts_nop 15\n\ts_nop 15\n\ts_nop 15" : "+v"(sc), "+v"(o0), "+v"(o1), "+v"(pp0), "+v"(pp1), "+v"(va0), "+v"(va1), "+v"(va2), "+v"(va3), "+v"(ka[0]), "+v"(ka[1]), "+v"(ka[2]), "+v"(ka[3]));
                __builtin_amdgcn_sched_barrier(0);
                const float fd0 = (float)(128 + 32 * qt + r - 32 * kt - 4 * hh);
                const bool inwin = (kt > qt) && (kt < qt + 8), inseq = (nb * 128 - 128 + 32 * kt >= 0) && (nb * 128 - 128 + 32 * kt + 31 < SEQ);
                float tmax = -1e30f;
                if (inwin && inseq) {
#pragma unroll
                    for (int i = 0; i < 16; ++i) { const float dd = fd0 - (float)((i & 3) + 8 * (i >> 2)); const float v = sc[i] * (0.125f * LOG2E) - slope2 * __builtin_fabsf(dd); sc[i] = v; tmax = fmaxf(tmax, v); }
                } else {
#pragma unroll
                    for (int i = 0; i < 16; ++i) { const int kj = 32 * kt + (i & 3) + 8 * (i >> 2) + 4 * hh, sp = nb * 128 - 128 + kj; const float dd = fd0 - (float)((i & 3) + 8 * (i >> 2)), ad = __builtin_fabsf(dd);
                        const bool valid = (ad <= (float)WIN) && (sp >= 0) && (sp < SEQ);
                        const float v = valid ? (sc[i] * (0.125f * LOG2E) - slope2 * ad) : -1e30f; sc[i] = v; tmax = fmaxf(tmax, v); }
                }
                { const auto sw = __builtin_amdgcn_permlane32_swap(__float_as_uint(tmax), __float_as_uint(tmax), false, false); tmax = fmaxf(__uint_as_float(sw[0]), __uint_as_float(sw[1])); }
                const float mnew = fmaxf(m, tmax), alpha = __builtin_amdgcn_exp2f(m - mnew); m = mnew;
                float psum = 0.f;
#pragma unroll
                for (int i = 0; i < 16; ++i) { const float p = __builtin_amdgcn_exp2f(sc[i] - mnew); sc[i] = p; psum += p; }
                { const auto sw = __builtin_amdgcn_permlane32_swap(__float_as_uint(psum), __float_as_uint(psum), false, false); psum = __uint_as_float(sw[0]) + __uint_as_float(sw[1]); }
                lsum = lsum * alpha + psum;
#pragma unroll
                for (int i = 0; i < 16; ++i) { o0[i] *= alpha; o1[i] *= alpha; }
                pp0.x = pk2hw(sc[0], sc[1]); pp0.y = pk2hw(sc[2], sc[3]); pp0.z = pk2hw(sc[4], sc[5]); pp0.w = pk2hw(sc[6], sc[7]);
                pp1.x = pk2hw(sc[8], sc[9]); pp1.y = pk2hw(sc[10], sc[11]); pp1.z = pk2hw(sc[12], sc[13]); pp1.w = pk2hw(sc[14], sc[15]);
                {   const LAS unsigned char* vp = VT + r * AT_VSTR + (32 * kt + 4 * hh) * 2;
#define AT_LDV(dst, off) do { const u32x2 lo_ = *(const LAS u32x2*)(vp + (off)), hi_ = *(const LAS u32x2*)(vp + (off) + 16); dst.x = lo_.x; dst.y = lo_.y; dst.z = hi_.x; dst.w = hi_.y; } while (0)
                    AT_LDV(va0, 0); AT_LDV(va1, 32 * AT_VSTR); AT_LDV(va2, 32); AT_LDV(va3, 32 * AT_VSTR + 32);
#undef AT_LDV
                    o0 = MFMA32(__builtin_bit_cast(bf16x8, va0), __builtin_bit_cast(bf16x8, pp0), o0); o1 = MFMA32(__builtin_bit_cast(bf16x8, va1), __builtin_bit_cast(bf16x8, pp0), o1);
                    o0 = MFMA32(__builtin_bit_cast(bf16x8, va2), __builtin_bit_cast(bf16x8, pp1), o0); o1 = MFMA32(__builtin_bit_cast(bf16x8, va3), __builtin_bit_cast(bf16x8, pp1), o1); }
            }
            __builtin_amdgcn_sched_barrier(0);
            asm volatile("s_nop 15\n\ts_nop 15\n\ts_nop 15\n\ts_nop 15\n\ts_nop 15" : "+v"(o0), "+v"(o1), "+v"(pp0), "+v"(pp1), "+v"(va0), "+v"(va1), "+v"(va2), "+v"(va3));
            __builtin_amdgcn_sched_barrier(0);
            const float inv = 1.0f / lsum;
            bf16* op = OA + tokq * BW + hq * 64 + 4 * hh;
#pragma unroll
            for (int gq = 0; gq < 4; ++gq) {
                u32x2 w0, w1; w0.x = pk2hw(o0[4 * gq] * inv, o0[4 * gq + 1] * inv); w0.y = pk2hw(o0[4 * gq + 2] * inv, o0[4 * gq + 3] * inv);
                w1.x = pk2hw(o1[4 * gq] * inv, o1[4 * gq + 1] * inv); w1.y = pk2hw(o1[4 * gq + 2] * inv, o1[4 * gq + 3] * inv);
                *(u32x2*)(op + 8 * gq) = w0; *(u32x2*)(op + 32 + 8 * gq) = w1; }
        }
    }
    __syncthreads();
}

__device__ __forceinline__ void p4a_router(Frame& F, int l) {
    LAS float* wl = (LAS float*)F.lds;
    LAS int* bk = (LAS int*)(F.lds + 81920);
    const float* wrt = (const float*)(F.ws + WS_WRT) + (size_t)l * 20 * D;
    for (int i = F.tid; i < 20 * D / 4; i += NTHREADS) ((LAS f32x4*)wl)[i] = ((const f32x4*)wrt)[i];
    __syncthreads();
    const float* X = F.out; float* rinv2 = (float*)(F.ws + WS_RINV2); int* BUCKET = (int*)(F.ws + WS_BUCKET); float* WTOK = (float*)(F.ws + WS_WTOK);
    const int lane = F.lane, tok0 = F.wg * 128 + F.wave * 16;
    float lgv[20], ssv = 0.f;
#pragma unroll
    for (int o = 0; o < 20; ++o) lgv[o] = 0.f;
#pragma unroll 1
    for (int q = 0; q < 8; ++q) {
        f32x4 xv[2][4];
#pragma unroll
        for (int a = 0; a < 2; ++a) { const f32x4* xr = (const f32x4*)(X + (size_t)(tok0 + q * 2 + a) * D) + lane;
#pragma unroll
            for (int j = 0; j < 4; ++j) xv[a][j] = xr[64 * j]; }
#pragma unroll
        for (int a = 0; a < 2; ++a) { float s = 0.f;
#pragma unroll
            for (int j = 0; j < 4; ++j) s += (xv[a][j].x * xv[a][j].x + xv[a][j].y * xv[a][j].y) + (xv[a][j].z * xv[a][j].z + xv[a][j].w * xv[a][j].w);
            const float t = wave_sum(s, lane); ssv = (lane == q * 2 + a) ? t : ssv; }
#pragma unroll
        for (int o = 0; o < 20; ++o) {
            f32x4 w[4];
#pragma unroll
            for (int j = 0; j < 4; ++j) w[j] = ((const LAS f32x4*)(wl + o * D))[lane + 64 * j];
#pragma unroll
            for (int a = 0; a < 2; ++a) { float s = 0.f;
#pragma unroll
                for (int j = 0; j < 4; ++j) s += (xv[a][j].x * w[j].x + xv[a][j].y * w[j].y) + (xv[a][j].z * w[j].z + xv[a][j].w * w[j].w);
                const float t = wave_sum(s, lane); lgv[o] = (lane == q * 2 + a) ? t : lgv[o]; }
            if (o & 1) asm volatile("" ::: "memory");
        }
    }
    {
        const int tok = tok0 + (lane & 15); const float ri = 1.0f / sqrtf(ssv * (1.0f / D) + NORM_EPS);
        float gl[4]; int gi = 0; float gm;
#pragma unroll
        for (int j = 0; j < 4; ++j) gl[j] = lgv[j] * ri + F.in[I_BG][l * 4 + j];
        gm = gl[0];
#pragma unroll
        for (int j = 1; j < 4; ++j) if (gl[j] > gm) { gm = gl[j]; gi = j; }
        float gs = 0.f;
#pragma unroll
        for (int j = 0; j < 4; ++j) gs += expf(gl[j] - gm);
        const float gw = 1.0f / gs;
        float el[4];
#pragma unroll
        for (int e = 0; e < 4; ++e) { float v = 0.f;
#pragma unroll
            for (int g = 0; g < 4; ++g) v = (gi == g) ? (lgv[4 + g * 4 + e] * ri + F.in[I_BE][l * 16 + g * 4 + e]) : v;
            el[e] = v; }
        int i1 = 0; float v1 = el[0];
#pragma unroll
        for (int e = 1; e < 4; ++e) if (el[e] > v1) { v1 = el[e]; i1 = e; }
        int i2 = -1; float v2 = -3.4e38f;
#pragma unroll
        for (int e = 0; e < 4; ++e) if (e != i1 && el[e] > v2) { v2 = el[e]; i2 = e; }
        const float e2 = expf(v2 - v1), w1 = gw / (1.0f + e2), w2 = gw * e2 / (1.0f + e2);
        const int ea = i1 < i2 ? i1 : i2, eb = i1 < i2 ? i2 : i1; const float wa = i1 < i2 ? w1 : w2, wb = i1 < i2 ? w2 : w1;
        const int bucket = gi * 6 + pair_index(ea, eb);
        if (lane < 16) { rinv2[tok] = ri; BUCKET[tok] = bucket; WTOK[2 * tok] = wa; WTOK[2 * tok + 1] = wb; bk[F.wave * 16 + lane] = bucket; }
    }
    __syncthreads();
    if (F.tid < 128) { const int b = bk[F.tid]; int r = 0; for (int i = 0; i < F.tid; ++i) r += (bk[i] == b) ? 1 : 0; ((int*)(F.ws + WS_RANK))[F.wg * 128 + F.tid] = r; }
    if (F.tid >= 128 && F.tid < 128 + 32) { const int b = F.tid - 128; int c = 0; if (b < NBUCKET) for (int i = 0; i < 128; ++i) c += (bk[i] == b) ? 1 : 0; ((int*)(F.ws + WS_HIST))[F.wg * 32 + b] = c; }
    __syncthreads();
}

__device__ __forceinline__ void p4b_positions(Frame& F) {
    LAS int* tot = (LAS int*)F.lds; LAS int* pre = tot + 32; LAS int* base = tot + 64;
    const int* HIST = (const int*)(F.ws + WS_HIST);
    if (F.tid < NBUCKET) { int t = 0, p = 0; for (int w = 0; w < 256; ++w) { const int h = HIST[w * 32 + F.tid]; if (w < F.wg) p += h; t += h; } tot[F.tid] = t; pre[F.tid] = p; }
    __syncthreads();
    if (F.tid == 0) { int a = 0; for (int b = 0; b < NBUCKET; ++b) { base[b] = a; a += (tot[b] + 255) & ~255; } base[NBUCKET] = a; }
    __syncthreads();
    int* IDX = (int*)(F.ws + WS_IDX); float* WSORT = (float*)(F.ws + WS_WSORT); float* RSORT = (float*)(F.ws + WS_RSORT); const float* WTOK = (const float*)(F.ws + WS_WTOK);
    if (F.tid < 128) { const int tok = F.wg * 128 + F.tid; const int b = ((const int*)(F.ws + WS_BUCKET))[tok]; const int pos = base[b] + pre[b] + ((const int*)(F.ws + WS_RANK))[tok];
        IDX[pos] = tok; *(u32x2*)(WSORT + 2 * pos) = (u32x2){__float_as_uint(WTOK[2 * tok]), __float_as_uint(WTOK[2 * tok + 1])}; RSORT[pos] = ((const float*)(F.ws + WS_RINV2))[tok]; }
    if (F.wg == 0) {
        float z = 0.f; asm volatile("" : "+v"(z));
        for (int b = 0; b < NBUCKET; ++b) for (int p = base[b] + tot[b] + F.tid; p < base[b + 1]; p += NTHREADS) { IDX[p] = -1; WSORT[2 * p] = z; WSORT[2 * p + 1] = z; RSORT[p] = z; }
        if (F.tid <= NBUCKET) ((int*)(F.ws + WS_BBASE))[F.tid] = base[F.tid];
    }
    __syncthreads();
}

__device__ __forceinline__ int build_tile_table(Frame& F, LAS int* tb) {
    const int* BB = (const int*)(F.ws + WS_BBASE);
    if (F.tid < 160) { const int r0 = F.tid * 256; int bkt = -1; for (int b = 0; b < NBUCKET; ++b) if (r0 >= BB[b] && r0 < BB[b + 1]) bkt = b; tb[1 + F.tid] = bkt; }
    if (F.tid == 0) tb[0] = BB[NBUCKET] / 256;
    __syncthreads();
    return tb[0];
}

typedef f32x4 AccT[2][2][4][2];
struct EpiZ1 { bf16* Z1; const float* rinv;
    __device__ __forceinline__ bool operator()(const AccT& acc, const pg8::Unit& u, int wr, int wc, int fr, int fq) const {
        asm volatile("" : "+v"(fr), "+v"(fq));
#pragma unroll
        for (int ai = 0; ai < 2; ++ai)
#pragma unroll
            for (int m = 0; m < 4; ++m) { const int row = u.pm * 256 + ai * 128 + wr * 64 + m * 16 + fr; const float ri = rinv[row]; bf16* rowp = Z1 + (size_t)row * ZC + u.pn * 256 + wc * 32 + 8 * fq;
#pragma unroll
                for (int bj = 0; bj < 2; ++bj) *(u32x4*)(rowp + bj * 128) = pack8(acc[ai][bj][m][0] * ri, acc[ai][bj][m][1] * ri); }
        return false; } };
__device__ __forceinline__ void p1_inproj_pg8(Frame& F, int l) {
    DenseSched S{(const char*)(F.ws + WS_XB), (const char*)(F.ws + WS_WINT) + (size_t)l * IN_COLS * D * 2, M / 256, ZC / 256, F.G, F.wg, D / 64, D * 2, D * 2};
    EpiZ1 E{(bf16*)(F.ws + WS_Z1), (const float*)(F.ws + WS_RINV1)};
    pg8::gemm_phase<EpiZ1, DenseSched, true, 0>(F.lds, S, E, F.tid);
    if (P0_LAYERS < DEPTH && l == 0 && F.wg >= 128) p0_weights(F, P0_LAYERS, DEPTH, (F.wg - 128) * NWAVES + F.wave, 128 * NWAVES);
}
struct EpiGlu { bf16* OS; const float* bg;
    __device__ __forceinline__ bool operator()(const AccT& acc, const pg8::Unit& u, int wr, int wc, int fr, int fq) const {
        asm volatile("" : "+v"(fr), "+v"(fq));
        const int col = u.pn * 128 + wc * 32 + 8 * fq;
        f32x4 bv[2], bgt[2];
#pragma unroll
        for (int n = 0; n < 2; ++n) { bv[n] = *(const f32x4*)(bg + col + 4 * n); bgt[n] = *(const f32x4*)(bg + 512 + col + 4 * n); }
#pragma unroll
        for (int ai = 0; ai < 2; ++ai)
#pragma unroll
            for (int m = 0; m < 4; ++m) { const int row = u.pm * 256 + ai * 128 + wr * 64 + m * 16 + fr; f32x4 o[2];
#pragma unroll
                for (int n = 0; n < 2; ++n) { const f32x4 v = acc[ai][0][m][n] + bv[n], g = acc[ai][1][m][n] + bgt[n];
#pragma unroll
                    for (int j = 0; j < 4; ++j) o[n][j] = v[j] * sigmoidf_(g[j]); }
                *(u32x4*)(OS + (size_t)row * BW + col) = pack8(o[0], o[1]); }
        return false; } };
__device__ __forceinline__ void p3a_glu_pg8(Frame& F, int l) {
    DenseSched S{(const char*)(F.ws + WS_YS), (const char*)(F.ws + WS_WGLUT) + (size_t)l * 1024 * BW * 2, M / 256, 4, F.G, F.wg, BW / 64, BW * 2, BW * 2};
    EpiGlu E{(bf16*)(F.ws + WS_OS), F.in[I_BGLU] + l * 1024};
    pg8::gemm_phase<EpiGlu, DenseSched, true, 0>(F.lds, S, E, F.tid);
}
struct EpiOut { const float* xin; float* X; bf16* XB;
    __device__ __forceinline__ bool operator()(const AccT& acc, const pg8::Unit& u, int wr, int wc, int fr, int fq) const {
        asm volatile("" : "+v"(fr), "+v"(fq));
#pragma unroll
        for (int ai = 0; ai < 2; ++ai) {
#pragma unroll
            for (int mp = 0; mp < 2; ++mp) {
                f32x4 xv[2][2][2];
#pragma unroll
                for (int mm = 0; mm < 2; ++mm) { const size_t row = u.pm * 256 + ai * 128 + wr * 64 + (2 * mp + mm) * 16 + fr;
#pragma unroll
                    for (int bj = 0; bj < 2; ++bj) { const size_t o = row * D + u.pn * 256 + bj * 128 + wc * 32 + 8 * fq; xv[mm][bj][0] = *(const f32x4*)(xin + o); xv[mm][bj][1] = *(const f32x4*)(xin + o + 4); } }
#pragma unroll
                for (int mm = 0; mm < 2; ++mm) { const int m = 2 * mp + mm; const size_t row = u.pm * 256 + ai * 128 + wr * 64 + m * 16 + fr;
#pragma unroll
                    for (int bj = 0; bj < 2; ++bj) { const size_t o = row * D + u.pn * 256 + bj * 128 + wc * 32 + 8 * fq;
                        const f32x4 v0 = xv[mm][bj][0] + acc[ai][bj][m][0], v1 = xv[mm][bj][1] + acc[ai][bj][m][1];
                        *(f32x4*)(X + o) = v0; *(f32x4*)(X + o + 4) = v1; *(u32x4*)(XB + o) = pack8(v0, v1); } }
                asm volatile("" ::: "memory"); } }
        return false; } };
__device__ __forceinline__ void p3c_outproj_pg8(Frame& F, int l) {
    DenseSched S{(const char*)(F.ws + WS_MIXED), (const char*)(F.ws + WS_WOUTT) + (size_t)l * D * D * 2, M / 256, 4, F.G, F.wg, D / 64, D * 2, D * 2};
    EpiOut E{(l == 0) ? F.in[I_X] : F.out, F.out, (bf16*)(F.ws + WS_XB)};
    pg8::gemm_phase<EpiOut, DenseSched, true, 0>(F.lds, S, E, F.tid);
}
struct MixSched { const char* XB; const char* WG; const char* WB; const char* ws; int G, c;
    __device__ __forceinline__ bool next(int i, pg8::Unit& u) const {
        const int sub = i % 6, L = (i / 6) * G + c; if (L >= 512) return false;
        pg8::static_tile(L, M / 256, 4, u.pm, u.pn); u.aux = sub; const int k = sub >> 1;
        if (!(sub & 1)) { u.A = XB + (size_t)u.pm * 256 * 2048; u.lda2 = 2048; u.nt = 16; u.B = WG + ((size_t)k * D + u.pn * 256) * 2048; u.ldb2 = 2048; }
        else { const char* br = ws + (k == 0 ? WS_OA : (k == 1 ? WS_OL : WS_OS)); u.A = br + (size_t)u.pm * 256 * 1024; u.lda2 = 1024; u.nt = 8; u.B = WB + ((size_t)k * D + u.pn * 256) * 1024; u.ldb2 = 1024; }
        return true; }
    __device__ __forceinline__ unsigned row_off(const pg8::Unit&, int) const { return 0u; }
};
struct EpiMix { u32x2* SIG; u32x4* MIXS; bf16* MX; const float* rinv;
    __device__ __forceinline__ bool operator()(const AccT& acc, const pg8::Unit& u, int wr, int wc, int fr, int fq) const {
        asm volatile("" : "+v"(fr), "+v"(fq));
        const int tid = (wr * 4 + wc) * 64 + fq * 16 + fr, sub = u.aux, k = sub >> 1;
        if (!(sub & 1)) {
            float ri[2][4];
#pragma unroll
            for (int ai = 0; ai < 2; ++ai)
#pragma unroll
                for (int m = 0; m < 4; ++m) ri[ai][m] = rinv[u.pm * 256 + ai * 128 + wr * 64 + m * 16 + fr];
#pragma unroll
            for (int ai = 0; ai < 2; ++ai)
#pragma unroll
                for (int m = 0; m < 4; ++m)
#pragma unroll
                    for (int bj = 0; bj < 2; ++bj) { unsigned q0 = 0u, q1 = 0u;
#pragma unroll
                        for (int j = 0; j < 4; ++j) { q0 |= (unsigned)__builtin_rintf(255.0f * sigmoidf_(acc[ai][bj][m][0][j] * ri[ai][m])) << (8 * j); q1 |= (unsigned)__builtin_rintf(255.0f * sigmoidf_(acc[ai][bj][m][1][j] * ri[ai][m])) << (8 * j); }
                        SIG[((ai * 4 + m) * 2 + bj) * 512 + tid] = (u32x2){q0, q1}; }
        } else {
#pragma unroll
            for (int ai = 0; ai < 2; ++ai)
#pragma unroll
            for (int mp = 0; mp < 2; ++mp) {
                u32x2 sv[2][2]; u32x4 mv[2][2];
#pragma unroll
                for (int mm = 0; mm < 2; ++mm)
#pragma unroll
                    for (int bj = 0; bj < 2; ++bj) { const int slot = ((ai * 4 + 2 * mp + mm) * 2 + bj) * 512 + tid; sv[mm][bj] = SIG[slot]; if (k > 0) mv[mm][bj] = MIXS[slot]; }
#pragma unroll
                for (int mm = 0; mm < 2; ++mm) { const int m = 2 * mp + mm; const size_t row = u.pm * 256 + ai * 128 + wr * 64 + m * 16 + fr;
#pragma unroll
                    for (int bj = 0; bj < 2; ++bj) { const int slot = ((ai * 4 + m) * 2 + bj) * 512 + tid; f32x4 s0, s1;
#pragma unroll
                        for (int j = 0; j < 4; ++j) { s0[j] = (float)((sv[mm][bj].x >> (8 * j)) & 255u) * (1.0f / 255.0f); s1[j] = (float)((sv[mm][bj].y >> (8 * j)) & 255u) * (1.0f / 255.0f); }
                        f32x4 v0 = acc[ai][bj][m][0] * s0, v1 = acc[ai][bj][m][1] * s1;
                        if (k > 0) { f32x4 p0, p1; unpack8(mv[mm][bj], p0, p1); v0 += p0; v1 += p1; }
                        if (k < 2) MIXS[slot] = pack8(v0, v1);
                        else *(u32x4*)(MX + row * D + u.pn * 256 + bj * 128 + wc * 32 + 8 * fq) = pack8(v0, v1); } }
                asm volatile("" ::: "memory"); }
        }
        return false; } };
__device__ __forceinline__ void p3b_mix_pg8(Frame& F, int l) {
    MixSched S{(const char*)(F.ws + WS_XB), (const char*)(F.ws + WS_WINT) + ((size_t)l * IN_COLS + COL_GATES) * D * 2, (const char*)(F.ws + WS_WBRT) + (size_t)l * 3 * D * BW * 2, (const char*)F.ws, F.G, F.wg};
    EpiMix E{(u32x2*)(F.ws + WS_P3BSCR + (size_t)F.wg * 262144), (u32x4*)(F.ws + WS_P3BSCR + (size_t)F.wg * 262144 + 131072), (bf16*)(F.ws + WS_MIXED), (const float*)(F.ws + WS_RINV1)};
    pg8::gemm_phase<EpiMix, MixSched, true, 0>(F.lds, S, E, F.tid);
}
struct Moe1Sched { const char* XB; const char* W13; const int* IDX; const LAS int* tb; int ntile, G, c;
    __device__ __forceinline__ bool next(int i, pg8::Unit& u) const {
        const int L = i * G + c; if (L >= ntile * 4) return false;
        u.pm = L >> 2; u.pn = L & 3; const int bucket = tb[1 + u.pm], g = bucket / 6; int pa, pb; pair_of(bucket % 6, pa, pb);
        u.aux = u.pn >> 1; const int e = g * 4 + (u.aux ? pb : pa);
        u.A = XB; u.lda2 = 2048; u.nt = 16; u.B = W13 + ((size_t)e * 512 + (u.pn & 1) * 256) * 2048; u.ldb2 = 2048; return true; }
    __device__ __forceinline__ unsigned row_off(const pg8::Unit& u, int r) const { int tok = IDX[u.pm * 256 + r]; tok = tok < 0 ? 0 : tok; return (unsigned)tok * 2048u; }
};
struct EpiMoe1 { bf16* HS; const float* WSORT; const float* RSORT;
    __device__ __forceinline__ bool operator()(const AccT& acc, const pg8::Unit& u, int wr, int wc, int fr, int fq) const {
        asm volatile("" : "+v"(fr), "+v"(fq));
        const int slot = u.aux, hcol = slot * 256 + (u.pn & 1) * 128 + wc * 32 + 8 * fq;
#pragma unroll
        for (int ai = 0; ai < 2; ++ai)
#pragma unroll
            for (int m = 0; m < 4; ++m) { const int row = u.pm * 256 + ai * 128 + wr * 64 + m * 16 + fr; const float wsel = WSORT[2 * row + slot], ri = RSORT[row]; f32x4 o[2];
#pragma unroll
                for (int n = 0; n < 2; ++n)
#pragma unroll
                    for (int j = 0; j < 4; ++j) { const float v1 = acc[ai][0][m][n][j] * ri, v3 = acc[ai][1][m][n][j] * ri; o[n][j] = v1 * sigmoidf_(v1) * v3 * wsel; }
                *(u32x4*)(HS + (size_t)row * 512 + hcol) = pack8(o[0], o[1]); }
        return false; } };
__device__ __forceinline__ void p4c_moe1_pg8(Frame& F, int l) {
    LAS int* tb = (LAS int*)(F.lds + TB_OFF);
    const int ntile = build_tile_table(F, tb);
    Moe1Sched S{(const char*)(F.ws + WS_XB), (const char*)(F.ws + WS_W13T) + (size_t)l * 16 * 512 * D * 2, (const int*)(F.ws + WS_IDX), tb, ntile, F.G, F.wg};
    EpiMoe1 E{(bf16*)(F.ws + WS_HS), (const float*)(F.ws + WS_WSORT), (const float*)(F.ws + WS_RSORT)};
    pg8::gemm_phase<EpiMoe1, Moe1Sched, true, 2>(F.lds, S, E, F.tid);
}
struct Moe2Sched { const char* HS; const char* W2; const LAS int* tb; int ntile, G, c;
    __device__ __forceinline__ bool next(int i, pg8::Unit& u) const {
        const int L = i * G + c; if (L >= ntile * 4) return false;
        u.pm = L >> 2; u.pn = L & 3; u.aux = 0; const int bucket = tb[1 + u.pm];
        u.A = HS + (size_t)u.pm * 256 * 1024; u.lda2 = 1024; u.nt = 8; u.B = W2 + ((size_t)bucket * D + u.pn * 256) * 1024; u.ldb2 = 1024; return true; }
    __device__ __forceinline__ unsigned row_off(const pg8::Unit&, int) const { return 0u; }
};
struct EpiMoe2 { float* X; bf16* XB; const int* IDX;
    __device__ __forceinline__ bool operator()(const AccT& acc, const pg8::Unit& u, int wr, int wc, int fr, int fq) const {
        asm volatile("" : "+v"(fr), "+v"(fq));
        int tk[2][4];
#pragma unroll
        for (int ai = 0; ai < 2; ++ai)
#pragma unroll
            for (int m = 0; m < 4; ++m) tk[ai][m] = IDX[u.pm * 256 + ai * 128 + wr * 64 + m * 16 + fr];
#pragma unroll
        for (int ai = 0; ai < 2; ++ai) {
#pragma unroll
            for (int mp = 0; mp < 2; ++mp) {
                f32x4 xv[2][2][2];
#pragma unroll
                for (int mm = 0; mm < 2; ++mm) { const int tok = tk[ai][2 * mp + mm]; const size_t rb = (size_t)(tok < 0 ? 0 : tok) * D + u.pn * 256 + wc * 32 + 8 * fq;
#pragma unroll
                    for (int bj = 0; bj < 2; ++bj) { xv[mm][bj][0] = *(const f32x4*)(X + rb + bj * 128); xv[mm][bj][1] = *(const f32x4*)(X + rb + bj * 128 + 4); } }
#pragma unroll
                for (int mm = 0; mm < 2; ++mm) { const int m = 2 * mp + mm, tok = tk[ai][m];
                    if (tok >= 0) { const size_t rb = (size_t)tok * D + u.pn * 256 + wc * 32 + 8 * fq;
#pragma unroll
                        for (int bj = 0; bj < 2; ++bj) { const f32x4 v0 = xv[mm][bj][0] + acc[ai][bj][m][0], v1 = xv[mm][bj][1] + acc[ai][bj][m][1];
                            *(f32x4*)(X + rb + bj * 128) = v0; *(f32x4*)(X + rb + bj * 128 + 4) = v1; *(u32x4*)(XB + rb + bj * 128) = pack8(v0, v1); } } }
                asm volatile("" ::: "memory"); } }
        return false; } };
__device__ __forceinline__ void p4d_moe2_pg8(Frame& F, int l) {
    LAS int* tb = (LAS int*)(F.lds + TB_OFF);
    const int ntile = build_tile_table(F, tb);
    Moe2Sched S{(const char*)(F.ws + WS_HS), (const char*)(F.ws + WS_W2TB) + (size_t)l * NBUCKET * D * 512 * 2, tb, ntile, F.G, F.wg};
    EpiMoe2 E{F.out, (bf16*)(F.ws + WS_XB), (const int*)(F.ws + WS_IDX)};
    pg8::gemm_phase<EpiMoe2, Moe2Sched, true, 0>(F.lds, S, E, F.tid);
}

__device__ __forceinline__ void p_rowstats(Frame& F) {
    const float* X = F.out; float* rinv = (float*)(F.ws + WS_RINV1);
    for (int m0 = 4 * F.gw; m0 < M; m0 += 4 * F.NGW) {
        f32x4 v[4][4];
#pragma unroll
        for (int a = 0; a < 4; ++a) { const f32x4* xr = (const f32x4*)(X + (size_t)(m0 + a) * D) + F.lane;
#pragma unroll
            for (int j = 0; j < 4; ++j) v[a][j] = xr[64 * j]; }
        float t[4];
#pragma unroll
        for (int a = 0; a < 4; ++a) { float s = 0.f;
#pragma unroll
            for (int j = 0; j < 4; ++j) s += (v[a][j].x * v[a][j].x + v[a][j].y * v[a][j].y) + (v[a][j].z * v[a][j].z + v[a][j].w * v[a][j].w);
            t[a] = wave_sum(s, F.lane); }
        if (F.lane < 4) { const float s = F.lane == 0 ? t[0] : (F.lane == 1 ? t[1] : (F.lane == 2 ? t[2] : t[3])); rinv[m0 + F.lane] = 1.0f / sqrtf(s * (1.0f / D) + NORM_EPS); }
    }
}
__device__ __forceinline__ void p_final_norm(Frame& F) {
    float* X = F.out;
    const f32x4* gp = (const f32x4*)F.in[I_FNG] + F.lane; f32x4 gv[4];
#pragma unroll
    for (int j = 0; j < 4; ++j) gv[j] = gp[64 * j];
    for (int m0 = 4 * F.gw; m0 < M; m0 += 4 * F.NGW) {
        f32x4 v[4][4];
#pragma unroll
        for (int a = 0; a < 4; ++a) { const f32x4* xr = (const f32x4*)(X + (size_t)(m0 + a) * D) + F.lane;
#pragma unroll
            for (int j = 0; j < 4; ++j) v[a][j] = xr[64 * j]; }
#pragma unroll
        for (int a = 0; a < 4; ++a) { float s = 0.f;
#pragma unroll
            for (int j = 0; j < 4; ++j) s += (v[a][j].x * v[a][j].x + v[a][j].y * v[a][j].y) + (v[a][j].z * v[a][j].z + v[a][j].w * v[a][j].w);
            s = wave_sum(s, F.lane); const float ri = 1.0f / sqrtf(s * (1.0f / D) + NORM_EPS);
            f32x4* xw = (f32x4*)(X + (size_t)(m0 + a) * D) + F.lane;
#pragma unroll
            for (int j = 0; j < 4; ++j) xw[64 * j] = v[a][j] * ri * gv[j]; }
    }
}

__device__ __forceinline__ bool fresh(Frame& F) {
    int t = threadIdx.x; asm volatile("" : "+v"(t));
    F.tid = t; F.lane = t & 63; F.wave = __builtin_amdgcn_readfirstlane(t >> 6); F.gw = F.wg * NWAVES + F.wave;
    const __attribute__((address_space(4))) Args* ap = (const __attribute__((address_space(4))) Args*)__builtin_amdgcn_kernarg_segment_ptr();
    asm volatile("" : "+s"(ap));
    F.in = ap->in; F.out = ap->out; F.ws = ap->ws;
    return true;
}
__global__ void __launch_bounds__(NTHREADS, 2) fwd(Args args) {
    extern __shared__ __attribute__((aligned(16))) unsigned char lds[];
    Frame F;
    F.lds = (LAS unsigned char*)lds;
    volatile LAS unsigned* MISC = (volatile LAS unsigned*)(F.lds + MISC_OFF);
    if (threadIdx.x < 32) MISC[threadIdx.x] = 0u;
    __syncthreads();
    F.tid = threadIdx.x; F.lane = F.tid & 63; F.wave = __builtin_amdgcn_readfirstlane(F.tid >> 6);
    F.wg = blockIdx.x; F.gw = F.wg * NWAVES + F.wave;
    F.in = nullptr; F.out = args.out; F.ws = args.ws;
    unsigned* ctl = (unsigned*)(F.ws + WS_CTL);
    XcdBarrier bar; bar.bar = ctl + CW_BAR; bar.x = 0; bar.st = nullptr;
    if (!MK_PER_PHASE) bar = xcd_barrier_post(ctl + CW_BAR, MISC + 8, F.tid == 0);
    const int lo = args.ph_lo, hi = args.ph_hi;
#define IN(k) (lo <= (k) && (k) < hi && fresh(F))
#define SEAM(k) do { if (IN(k) && IN((k) + 1)) xcd_barrier(bar, F.tid == 0); } while (0)

#ifndef DUP_MASK
#define DUP_MASK 0
#endif
#define RUN(k, body) do { int reps_ = 1 + ((DUP_MASK >> (k)) & 1); if (DUP_MASK) asm volatile("" : "+s"(reps_)); for (int rep_ = 0; rep_ < reps_; ++rep_) { body; if (DUP_MASK) __syncthreads(); } } while (0)
    if (IN(0)) { RUN(0, p0_prologue(F)); } SEAM(0);
    for (int l = 0; l < DEPTH; ++l) {
        const int pb = 1 + 10 * l;
        if (IN(pb + 0)) { RUN(1, p1_inproj_pg8(F, l)); } SEAM(pb + 0);
        if (IN(pb + 1)) { RUN(2, lru_mfma(F, l)); RUN(3, s5_mfma(F, l)); RUN(4, attn_mfma(F, l)); } SEAM(pb + 1);
        if (IN(pb + 2)) { RUN(5, p3a_glu_pg8(F, l)); } SEAM(pb + 2);
        if (IN(pb + 3)) { RUN(6, p3b_mix_pg8(F, l)); } SEAM(pb + 3);
        if (IN(pb + 4)) { p3c_outproj_pg8(F, l); } SEAM(pb + 4);
        if (IN(pb + 5)) { RUN(8, p4a_router(F, l)); } SEAM(pb + 5);
        if (IN(pb + 6)) { RUN(9, p4b_positions(F)); } SEAM(pb + 6);
        if (IN(pb + 7)) { RUN(10, p4c_moe1_pg8(F, l)); } SEAM(pb + 7);
        if (IN(pb + 8)) { p4d_moe2_pg8(F, l); } SEAM(pb + 8);
        if (IN(pb + 9)) { if (l == DEPTH - 1) p_final_norm(F); else { RUN(12, p_rowstats(F)); } }
        if (l < DEPTH - 1) SEAM(pb + 9);
    }
#undef IN
#undef SEAM
}

extern "C" void kernel_launch(void* const* d_in, const int* in_sizes, int n_in, void* d_out, int out_size, void* d_ws, size_t ws_size, hipStream_t stream) {
    static int grid = 0;
    if (grid == 0) {
        if (n_in != 32 || out_size != M * D || ws_size < WS_END) { fprintf(stderr, "kernel_launch: unexpected shapes (n_in %d, out %d, ws %zu)\n", n_in, out_size, ws_size); grid = -1; return; }
        if (hipFuncSetAttribute((const void*)fwd, hipFuncAttributeMaxDynamicSharedMemorySize, LDS_BYTES) != hipSuccess) { fprintf(stderr, "kernel_launch: hipFuncSetAttribute failed\n"); grid = -1; return; }
        int per_cu = 0;
        if (hipOccupancyMaxActiveBlocksPerMultiprocessor(&per_cu, (const void*)fwd, NTHREADS, LDS_BYTES) != hipSuccess || per_cu < 1) fprintf(stderr, "kernel_launch: occupancy query reports %d\n", per_cu);
        (void)hipGetLastError();
        grid = 256;
    }
    if (grid < 0) return;
    (void)hipMemsetAsync((char*)d_ws + WS_CTL, 0, CTL_ZERO_BYTES, stream);
    Args a{};
    for (int i = 0; i < 32; ++i) a.in[i] = (const float*)d_in[i];
    a.out = (float*)d_out; a.ws = (unsigned char*)d_ws; a.pad = 0;
#if MK_PER_PHASE
    for (int p = 0; p < NPHASE; ++p) { a.ph_lo = p; a.ph_hi = p + 1; a.li = p; hipLaunchKernelGGL(fwd, dim3(grid), dim3(NTHREADS), LDS_BYTES, stream, a); }
#else
    a.ph_lo = 0; a.ph_hi = NPHASE; a.li = 0;
    hipLaunchKernelGGL(fwd, dim3(grid), dim3(NTHREADS), LDS_BYTES, stream, a);
#endif
}
```

```cpp
#include <hip/hip_runtime.h>
#include <cstdio>
#include <cstdint>

#ifndef MK_PER_PHASE
#define MK_PER_PHASE 0
#endif

constexpr int D = 1024, BATCH = 16, SEQ = 2048, M = BATCH * SEQ, DEPTH = 2;
constexpr int NQ = 8, HD = 64, WIN = 128;
constexpr int BW = 512;
constexpr int ZC = 2304;
constexpr int IN_COLS = 5376;
constexpr int COL_Q = 0, COL_K = 512, COL_V = 640, COL_XR = 768, COL_GR = 1280, COL_U = 1792, COL_GATES = 2304;
constexpr int NBUCKET = 24;
constexpr int MS_MAX = (128 + NBUCKET) * 256;
constexpr float NORM_EPS = 1e-6f;
constexpr int NWAVES = 8, NTHREADS = 512;
constexpr int NPHASE = 21;

constexpr size_t MiB = 1u << 20;
constexpr size_t WS_CTL = 0, CTL_ZERO_BYTES = 1 * MiB;
constexpr size_t WS_RINV1 = 1 * MiB;
constexpr size_t WS_RINV2 = WS_RINV1 + 128 * 1024;
constexpr size_t WS_BUCKET = WS_RINV2 + 128 * 1024;
constexpr size_t WS_RANK = WS_BUCKET + 128 * 1024;
constexpr size_t WS_WTOK = WS_RANK + 128 * 1024;
constexpr size_t WS_HIST = WS_WTOK + 256 * 1024;
constexpr size_t WS_BBASE = WS_HIST + 32 * 1024;
constexpr size_t WS_IDX = WS_BBASE + 1024;
constexpr size_t WS_WSORT = WS_IDX + 160 * 1024;
constexpr size_t WS_RSORT = WS_WSORT + 320 * 1024;
constexpr size_t WS_S5TBL = 3 * MiB;
constexpr size_t WS_WRT = 5 * MiB;
constexpr size_t WS_LRUF = 7 * MiB;
constexpr size_t WS_WINT = 8 * MiB;
constexpr size_t WS_WGLUT = 29 * MiB;
constexpr size_t WS_WBRT = 31 * MiB;
constexpr size_t WS_WOUTT = 37 * MiB;
constexpr size_t WS_W13T = 41 * MiB;
constexpr size_t WS_W2TB = 73 * MiB;
constexpr size_t WS_S5MAT = 121 * MiB;
constexpr size_t WS_S5LAM = 6 * MiB;
constexpr size_t WS_XB = 145 * MiB;
constexpr size_t WS_Z1 = 209 * MiB;
constexpr size_t WS_MIXED = 209 * MiB;
constexpr size_t WS_HS = 273 * MiB;
constexpr size_t WS_OA = 353 * MiB, WS_OL = 385 * MiB, WS_YS = 417 * MiB, WS_OS = 449 * MiB;
constexpr size_t WS_END = 481 * MiB;
static_assert(WS_WSORT + (size_t)MS_MAX * 8 <= WS_RSORT && WS_RSORT + (size_t)MS_MAX * 4 <= WS_S5TBL, "small region");
constexpr size_t WS_P3BSCR = 273 * MiB;
constexpr int TB_OFF = 163840 - 2048;
static_assert(WS_Z1 + (size_t)M * ZC * 2 <= WS_OA, "z1");
static_assert(WS_HS + (size_t)MS_MAX * 512 * 2 <= WS_OA, "hs");

constexpr int CW_BAR = 4096;
constexpr int LDS_BYTES = 163840;
constexpr int MISC_OFF = 163840 - 256;

#define LAS __attribute__((address_space(3)))
typedef unsigned short bf16;
typedef short bf16x8 __attribute__((ext_vector_type(8)));
typedef float f32x4 __attribute__((ext_vector_type(4)));
typedef unsigned u32x4 __attribute__((ext_vector_type(4)));
typedef unsigned u32x2 __attribute__((ext_vector_type(2)));

__device__ __forceinline__ float bf2f(bf16 b) { return __uint_as_float(((unsigned)b) << 16); }
__device__ __forceinline__ unsigned f2bf(float f) { unsigned u = __float_as_uint(f); return (u + 0x7fffu + ((u >> 16) & 1u)) >> 16; }
__device__ __forceinline__ unsigned pk2(float lo, float hi) { return f2bf(lo) | (f2bf(hi) << 16); }
typedef __bf16 hwbf16x2 __attribute__((ext_vector_type(2)));
__device__ __forceinline__ unsigned pk2hw(float lo, float hi) { hwbf16x2 v; v.x = (__bf16)lo; v.y = (__bf16)hi; return __builtin_bit_cast(unsigned, v); }
__device__ __forceinline__ float sigmoidf_(float x) { return __builtin_amdgcn_rcpf(1.0f + __builtin_amdgcn_exp2f(-1.4426950408889634f * x)); }
__device__ __forceinline__ float gelu_tanh(float x) { return x * sigmoidf_(1.5957691216057308f * (x + 0.044715f * x * x * x)); }
template <int N> __device__ __forceinline__ float dpp_ror(float v) { return __int_as_float(__builtin_amdgcn_update_dpp(0, __float_as_int(v), 0x120 + N, 0xf, 0xf, false)); }
__device__ __forceinline__ float rlane(float v, int l) { return __int_as_float(__builtin_amdgcn_readlane(__float_as_int(v), l)); }
__device__ __forceinline__ float wave_sum(float v, int  ) {
    v += dpp_ror<8>(v); v += dpp_ror<4>(v); v += dpp_ror<2>(v); v += dpp_ror<1>(v);
    return (rlane(v, 0) + rlane(v, 16)) + (rlane(v, 32) + rlane(v, 48));
}
__device__ __forceinline__ float lane_xor(float v, int lane, int o) { return __int_as_float(__builtin_amdgcn_ds_bpermute((lane ^ o) << 2, __float_as_int(v))); }
#define LDS_WAIT() asm volatile("s_waitcnt lgkmcnt(0)" ::: "memory")

#define XB_TMO      128
#define XB_XCNT(j)  (256  + 64 * (j))
#define XB_XSUB(j)  (1280 + 64 * (j))
#define XB_XGEN(j)  (2304 + 64 * (j))
#define XB_TOP      3328
#define XB_TOPGEN   3392
#define XCD_BAR_WORDS 3456
#define XB_SPIN_CAP (1u << 20)
__device__ __forceinline__ unsigned xb_ld(unsigned* p)              { return __hip_atomic_load(p, __ATOMIC_RELAXED, __HIP_MEMORY_SCOPE_AGENT); }
__device__ __forceinline__ unsigned xb_add(unsigned* p, unsigned v) { return __hip_atomic_fetch_add(p, v, __ATOMIC_RELAXED, __HIP_MEMORY_SCOPE_AGENT); }
__device__ __forceinline__ unsigned xb_xcc_id() { return (unsigned)__builtin_amdgcn_s_getreg((3 << 11) | 20) & 0xFu; }
#define XB_SPIN(cond, bar) do { unsigned _sp = 0; while (cond) { __builtin_amdgcn_s_sleep(1); \
    if ((++_sp & 255u) == 0u) { if (xb_ld(&(bar)[XB_TMO])) break; if (_sp > XB_SPIN_CAP) { atomicAdd(&(bar)[XB_TMO], 1u); break; } } } } while (0)
struct XcdBarrier { unsigned* bar; unsigned x; volatile LAS unsigned* st; };
__device__ __forceinline__ XcdBarrier xcd_barrier_post(unsigned* bar, volatile LAS unsigned* st, bool leader) {
    XcdBarrier b; b.bar = bar; b.x = xb_xcc_id(); b.st = st;
    if (leader) (void)xb_add(&bar[XB_XCNT(b.x)], 1u);
    return b;
}
__device__ __forceinline__ void xcd_barrier_complete(unsigned* bar, unsigned x, unsigned& nloc, unsigned& nx) {
    const unsigned G = gridDim.x * gridDim.y * gridDim.z;
    unsigned sum, cnt, mine, sp = 0u;
    for (;;) {
        sum = 0u; cnt = 0u; mine = 0u;
#pragma unroll
        for (unsigned j = 0; j < 16; ++j) { const unsigned c = xb_ld(&bar[XB_XCNT(j)]); sum += c; cnt += (c > 0u) ? 1u : 0u; mine = (j == x) ? c : mine; }
        if (sum == G) break;
        __builtin_amdgcn_s_sleep(1);
        if ((++sp & 255u) == 0u) { if (xb_ld(&bar[XB_TMO])) break; if (sp > XB_SPIN_CAP) { atomicAdd(&bar[XB_TMO], 1u); break; } }
    }
    nloc = mine > 0u ? mine : 1u; nx = cnt > 0u ? cnt : 1u;
}
__device__ __forceinline__ void xcd_barrier(const XcdBarrier& b, bool leader) {
    asm volatile("s_waitcnt vmcnt(0)" ::: "memory");
    __syncthreads();
    if (leader) {
        unsigned* bar = b.bar;
        __builtin_amdgcn_s_waitcnt(0);
        unsigned nloc = b.st[0], nx = b.st[1];
        if (nloc == 0u) { xcd_barrier_complete(bar, b.x, nloc, nx); b.st[0] = nloc; b.st[1] = nx; }
        const unsigned old = xb_add(&bar[XB_XSUB(b.x)], 1u);
        const unsigned gen = old / nloc;
        if (old + 1u == (gen + 1u) * nloc) {
            __builtin_amdgcn_fence(__ATOMIC_RELEASE, "agent");
            asm volatile("s_waitcnt vmcnt(0)" ::: "memory");
            const unsigned og = xb_add(&bar[XB_TOP], 1u);
            const unsigned tg = og / nx;
            if (og + 1u == (tg + 1u) * nx) xb_add(&bar[XB_TOPGEN], 1u);
            else XB_SPIN(xb_ld(&bar[XB_TOPGEN]) == tg, bar);
            __builtin_amdgcn_fence(__ATOMIC_ACQUIRE, "agent");
            xb_add(&bar[XB_XGEN(b.x)], 1u);
            asm volatile("s_waitcnt vmcnt(0)" ::: "memory");
        } else {
            XB_SPIN(xb_ld(&bar[XB_XGEN(b.x)]) == gen, bar);
            __builtin_amdgcn_fence(__ATOMIC_ACQUIRE, "agent");
            asm volatile("s_waitcnt vmcnt(0)" ::: "memory");
        }
    }
    __syncthreads();
}

struct Args { const float* in[32]; float* out; unsigned char* ws; int ph_lo, ph_hi, li, pad; };
struct Frame {
    LAS unsigned char* lds;
    int tid, lane, wave, wg, gw;
    static constexpr int G = 256, NGW = 256 * NWAVES;
    const float* const __attribute__((address_space(4)))* in;
    float* out; unsigned char* ws;
};
enum { I_X = 0, I_N1G, I_WIN, I_SINK, I_CONVW, I_CONVB, I_LWR, I_LBR, I_LWI, I_LBI, I_LAM, I_ARE, I_AIM, I_LSTEP, I_BRE, I_BIM, I_CRE, I_CIM, I_SD, I_WGLU, I_BGLU,
       I_WBR, I_WOUT, I_N2G, I_WG, I_BG, I_WE, I_BE, I_W1, I_W3, I_W2, I_FNG };

__device__ __forceinline__ void pair_of(int p, int& a, int& b) {
    a = (p < 3) ? 0 : (p < 5 ? 1 : 2); b = (p < 3) ? p + 1 : (p < 5 ? p - 1 : 3);
}
__device__ __forceinline__ int pair_index(int a, int b) {
    return (a == 0) ? (b - 1) : (a == 1 ? (b + 1) : 5);
}


namespace pg8 {
typedef unsigned short bf16_t;
constexpr int BM = 256, BK = 64, HALF = 128, HTB = HALF * BK * 2, STAGE_BYTES = 8 * HTB, NXCD = 8, WGM = 8;
__host__ __device__ __forceinline__ int lds_byte(int r, int c) { const int st = (r >> 4) * 2 + (c >> 5), rr = r & 15, cc = c & 31, ob = rr * 64 + cc * 2; return st * 1024 + (ob ^ (((ob >> 9) & 1) << 5)); }
__host__ __device__ __forceinline__ void stage_rc(int b, int& R, int& C) { const int st = b / 1024, sb = b % 1024, swz = sb ^ (((sb >> 9) & 1) << 5); R = (st >> 1) * 16 + swz / 64; C = (st & 1) * 32 + (swz % 64) / 2; }
__host__ __device__ __forceinline__ int perm32(int rho) { const int n = rho >> 4, i = rho & 15; return 8 * (i >> 2) + 4 * n + (i & 3); }

struct Unit { int pm, pn, aux; int nt; unsigned lda2, ldb2; const char* A; const char* B; };

__device__ __forceinline__ void static_tile(int L, int nM, int nN, int& pm, int& pn) {
    const int nwg = nM * nN; int wgid = L; { const int q = nwg / NXCD, r = nwg % NXCD, xcd = wgid % NXCD, off = wgid / NXCD; wgid = (xcd < r ? xcd * (q + 1) : r * (q + 1) + (xcd - r) * q) + off; }
    const int nig = WGM * nN, gid = wgid / nig, fm = gid * WGM, gsz = (nM - fm) < WGM ? (nM - fm) : WGM;
    pm = fm + ((wgid % nig) % gsz); pn = (wgid % nig) / gsz;
}

template <class Epi, class Sched, bool ALIGN_EPI, int MODE>
__device__ __forceinline__ void gemm_phase(LAS unsigned char* lds, const Sched& S, const Epi& E, int tid) {
    const int wid = __builtin_amdgcn_readfirstlane(tid >> 6), lane = tid & 63, wr = wid >> 2, wc = wid & 3, fr = lane & 15, fq = lane >> 4;
    unsigned RA[2], C2[2];
#pragma unroll
    for (int i = 0; i < 2; ++i) { int R, C; stage_rc(tid * 16 + i * 8192, R, C); RA[i] = (unsigned)R; C2[i] = (unsigned)C * 2u; }
    const unsigned ldsw = (unsigned)wid * 1024u;
    const int aoff = lds_byte(wr * 64 + fr, fq * 8), boff = lds_byte(wc * 32 + fr, fq * 8);
#define PG8_SA(b, h) (((b) * 2 + (h)) * HTB)
#define PG8_SB(b, h) ((4 + (b) * 2 + (h)) * HTB)
#define PG8_STAGE_A(bufoff, gbase, h, ld2, go) do { _Pragma("unroll") for (int _i = 0; _i < 2; ++_i) { \
        const unsigned _vo = (MODE == 2) ? ((go)[h][_i] + C2[_i]) : ((RA[_i] + 128u * (h)) * (ld2) + C2[_i]); \
        __builtin_amdgcn_global_load_lds((const unsigned*)((gbase) + _vo), (LAS unsigned*)(lds + (bufoff) + ldsw + _i * 8192), 16, 0, 0); } } while (0)
#define PG8_STAGE_B(bufoff, gbase, h, ld2) do { _Pragma("unroll") for (int _i = 0; _i < 2; ++_i) { \
        const unsigned _vo = (((RA[_i] & ~31u) + (unsigned)perm32((int)(RA[_i] & 31u))) + 128u * (h)) * (ld2) + C2[_i]; \
        __builtin_amdgcn_global_load_lds((const unsigned*)((gbase) + _vo), (LAS unsigned*)(lds + (bufoff) + ldsw + _i * 8192), 16, 0, 0); } } while (0)
#define PG8_LDA(dst, b, h) do { _Pragma("unroll") for (int m = 0; m < 4; ++m) _Pragma("unroll") for (int k = 0; k < 2; ++k) dst[m][k] = *(const LAS bf16x8*)(lds + PG8_SA(b, h) + aoff + m * 2048 + k * 1024); } while (0)
#define PG8_LDB(dst, b, h) do { _Pragma("unroll") for (int n = 0; n < 2; ++n) _Pragma("unroll") for (int k = 0; k < 2; ++k) dst[n][k] = *(const LAS bf16x8*)(lds + PG8_SB(b, h) + boff + n * 2048 + k * 1024); } while (0)
#define PG8_MMA(ai, bj, At, Bt) do { __builtin_amdgcn_s_setprio(1); _Pragma("unroll") for (int m = 0; m < 4; ++m) _Pragma("unroll") for (int n = 0; n < 2; ++n) _Pragma("unroll") for (int k = 0; k < 2; ++k) \
        acc[ai][bj][m][n] = __builtin_amdgcn_mfma_f32_16x16x32_bf16(Bt[n][k], At[m][k], acc[ai][bj][m][n], 0, 0, 0); __builtin_amdgcn_s_setprio(0); } while (0)
#define PG8_WAIT_V(n) asm volatile("s_waitcnt vmcnt(" #n ")" ::: "memory")
#define PG8_WAIT_L(n) asm volatile("s_waitcnt lgkmcnt(" #n ")" ::: "memory")
#define PG8_BAR __builtin_amdgcn_s_barrier()
#define PG8_SCHED __builtin_amdgcn_sched_barrier(0)
    Unit cur, nxt; int ui = 0;
    if (!S.next(0, cur)) return;
    f32x4 acc[2][2][4][2];
#pragma unroll
    for (int a = 0; a < 2; ++a)
#pragma unroll
        for (int b = 0; b < 2; ++b)
#pragma unroll
            for (int m = 0; m < 4; ++m)
#pragma unroll
                for (int n = 0; n < 2; ++n) acc[a][b][m][n] = (f32x4){0.f, 0.f, 0.f, 0.f};
    bf16x8 At[4][2], B0[2][2], B1[2][2];
    unsigned cgo[2][2] = {{0u, 0u}, {0u, 0u}}, ngo[2][2] = {{0u, 0u}, {0u, 0u}};
    if (MODE == 2) {
#pragma unroll
        for (int h = 0; h < 2; ++h)
#pragma unroll
            for (int i = 0; i < 2; ++i) cgo[h][i] = S.row_off(cur, h * 128 + (int)RA[i]);
    }
    const size_t kstep = (size_t)(BK * 2);
    const char* cA = cur.A; const char* cB = cur.B;
    PG8_STAGE_B(PG8_SB(0, 0), cB, 0, cur.ldb2); PG8_STAGE_B(PG8_SB(0, 1), cB, 1, cur.ldb2); PG8_STAGE_A(PG8_SA(0, 0), cA, 0, cur.lda2, cgo); PG8_STAGE_A(PG8_SA(0, 1), cA, 1, cur.lda2, cgo);
    if (wr == 1) PG8_BAR;
    PG8_WAIT_V(2); PG8_BAR;
    PG8_STAGE_B(PG8_SB(1, 0), cB + kstep, 0, cur.ldb2); PG8_STAGE_A(PG8_SA(1, 0), cA + kstep, 0, cur.lda2, cgo); PG8_STAGE_B(PG8_SB(1, 1), cB + kstep, 1, cur.ldb2);
    PG8_WAIT_V(6); PG8_BAR;
    for (;;) {
        const bool has_next = S.next(ui + 1, nxt);
        if (!has_next) nxt = cur;
        if (MODE == 2) {
#pragma unroll
            for (int h = 0; h < 2; ++h)
#pragma unroll
                for (int i = 0; i < 2; ++i) ngo[h][i] = has_next ? S.row_off(nxt, h * 128 + (int)RA[i]) : cgo[h][i];
        }
        const char* nA = nxt.A; const char* nB = nxt.B;
        const int nt = cur.nt;
        for (int t = 0; t < nt; t += 2) {
            const bool last = (t == nt - 2);
            const char* a1 = cA + (size_t)(t + 1) * kstep;
            const char* a2 = last ? nA : cA + (size_t)(t + 2) * kstep; const char* b2 = last ? nB : cB + (size_t)(t + 2) * kstep;
            const char* a3 = a2 + kstep; const char* b3 = b2 + kstep;
            const unsigned la2 = last ? nxt.lda2 : cur.lda2, lb2 = last ? nxt.ldb2 : cur.ldb2;
            unsigned go2[2][2];
#pragma unroll
            for (int h = 0; h < 2; ++h)
#pragma unroll
                for (int i = 0; i < 2; ++i) go2[h][i] = last ? ngo[h][i] : cgo[h][i];
            PG8_LDB(B0, 0, 0); PG8_LDB(B1, 0, 1); PG8_SCHED; PG8_LDA(At, 0, 0); PG8_STAGE_A(PG8_SA(1, 1), a1, 1, cur.lda2, cgo);
            PG8_WAIT_V(8); PG8_WAIT_L(0); PG8_BAR; PG8_MMA(0, 0, At, B0); PG8_MMA(0, 1, At, B1); PG8_BAR; PG8_SCHED;
            PG8_LDA(At, 0, 1); PG8_STAGE_B(PG8_SB(0, 0), b2, 0, lb2); PG8_STAGE_B(PG8_SB(0, 1), b2, 1, lb2); PG8_STAGE_A(PG8_SA(0, 0), a2, 0, la2, go2);
            PG8_WAIT_V(8); PG8_WAIT_L(0); PG8_BAR; PG8_MMA(1, 0, At, B0); PG8_MMA(1, 1, At, B1); PG8_BAR; PG8_SCHED;
            PG8_LDB(B0, 1, 0); PG8_LDB(B1, 1, 1); PG8_SCHED; PG8_LDA(At, 1, 0); PG8_STAGE_A(PG8_SA(0, 1), a2, 1, la2, go2);
            PG8_WAIT_V(8); PG8_WAIT_L(0); PG8_BAR; PG8_MMA(0, 0, At, B0); PG8_MMA(0, 1, At, B1); PG8_BAR; PG8_SCHED;
            PG8_LDA(At, 1, 1); PG8_STAGE_B(PG8_SB(1, 0), b3, 0, lb2); PG8_STAGE_B(PG8_SB(1, 1), b3, 1, lb2); PG8_STAGE_A(PG8_SA(1, 0), a3, 0, la2, go2);
            PG8_WAIT_V(8); PG8_WAIT_L(0); PG8_BAR; PG8_MMA(1, 0, At, B0); PG8_MMA(1, 1, At, B1); PG8_BAR; PG8_SCHED;
        }
        if constexpr (ALIGN_EPI) { if (wr == 0) PG8_BAR; }
        const bool keep = E(acc, cur, wr, wc, fr, fq);
        if (!has_next) break;
        if (!keep) {
#pragma unroll
            for (int a = 0; a < 2; ++a)
#pragma unroll
                for (int b = 0; b < 2; ++b)
#pragma unroll
                    for (int m = 0; m < 4; ++m)
#pragma unroll
                        for (int n = 0; n < 2; ++n) acc[a][b][m][n] = (f32x4){0.f, 0.f, 0.f, 0.f};
        }
        cur = nxt; cA = nA; cB = nB; ++ui;
        if (MODE == 2) {
#pragma unroll
            for (int h = 0; h < 2; ++h)
#pragma unroll
                for (int i = 0; i < 2; ++i) cgo[h][i] = ngo[h][i];
        }
        if constexpr (ALIGN_EPI) { if (wr == 1) PG8_BAR; }
    }
    PG8_WAIT_V(0);
    if constexpr (!ALIGN_EPI) { if (wr == 0) PG8_BAR; }
    PG8_BAR;
#undef PG8_SA
#undef PG8_SB
#undef PG8_STAGE_A
#undef PG8_STAGE_B
#undef PG8_LDA
#undef PG8_LDB
#undef PG8_MMA
#undef PG8_WAIT_V
#undef PG8_WAIT_L
#undef PG8_BAR
#undef PG8_SCHED
}
}

__device__ __forceinline__ unsigned cvt_pk_bf16(float lo, float hi) { unsigned r; asm volatile("v_cvt_pk_bf16_f32 %0, %1, %2" : "=v"(r) : "v"(lo), "v"(hi)); return r; }
__device__ __forceinline__ u32x4 pack8(const f32x4& v0, const f32x4& v1) { u32x4 w; w.x = cvt_pk_bf16(v0[0], v0[1]); w.y = cvt_pk_bf16(v0[2], v0[3]); w.z = cvt_pk_bf16(v1[0], v1[1]); w.w = cvt_pk_bf16(v1[2], v1[3]); return w; }
__device__ __forceinline__ void unpack8(const u32x4& w, f32x4& v0, f32x4& v1) {
    v0[0] = __uint_as_float(w.x << 16); v0[1] = __uint_as_float(w.x & 0xffff0000u); v0[2] = __uint_as_float(w.y << 16); v0[3] = __uint_as_float(w.y & 0xffff0000u);
    v1[0] = __uint_as_float(w.z << 16); v1[1] = __uint_as_float(w.z & 0xffff0000u); v1[2] = __uint_as_float(w.w << 16); v1[3] = __uint_as_float(w.w & 0xffff0000u); }

struct DenseSched {
    const char* A; const char* B; int nM, nN, G, c, nt; unsigned lda2, ldb2;
    __device__ __forceinline__ bool next(int i, pg8::Unit& u) const {
        const int L = i * G + c; if (L >= nM * nN) return false;
        pg8::static_tile(L, nM, nN, u.pm, u.pn); u.aux = 0; u.nt = nt; u.lda2 = lda2; u.ldb2 = ldb2;
        u.A = A + (size_t)u.pm * 256 * lda2; u.B = B + (size_t)u.pn * 256 * ldb2; return true;
    }
    __device__ __forceinline__ unsigned row_off(const pg8::Unit&, int) const { return 0u; }
};

template <int MAP>
__device__ __forceinline__ int rowmap(int n) { if (MAP == 0) return n; return (n >> 7) * 256 + (n & 127) + (MAP == 2 ? 128 : 0); }
template <int MAP>
__device__ __forceinline__ void transpose_item(const float* W, int N, int ncol0, const float* gain, bf16* dst, int dld, int dcol0, LAS float* scr, int kb, int nb, int lane) {
    const int k0 = 64 * kb, n0 = 32 * nb;
    float tv_[32];
#pragma unroll
    for (int i = 0; i < 32; ++i) tv_[i] = W[(size_t)(k0 + 2 * i + (lane >> 5)) * N + ncol0 + n0 + (lane & 31)];
    if (gain) {
#pragma unroll
        for (int i = 0; i < 32; ++i) tv_[i] *= gain[k0 + 2 * i + (lane >> 5)];
    }
#pragma unroll
    for (int i = 0; i < 32; ++i) scr[(2 * i + (lane >> 5)) * 33 + (lane & 31)] = tv_[i];
    LDS_WAIT();
    const int c = lane & 7;
#pragma unroll
    for (int j = 0; j < 4; ++j) { const int n = (lane >> 3) + 8 * j; const LAS float* s = scr + (8 * c) * 33 + n;
        u32x4 o; o.x = pk2(s[0 * 33], s[1 * 33]); o.y = pk2(s[2 * 33], s[3 * 33]); o.z = pk2(s[4 * 33], s[5 * 33]); o.w = pk2(s[6 * 33], s[7 * 33]);
        *(u32x4*)(dst + (size_t)rowmap<MAP>(n0 + n) * dld + dcol0 + k0 + 8 * c) = o; }
    LDS_WAIT();
}

__device__ __forceinline__ void s5_setup_item(Frame& F, int l, int g);
#ifndef P0_LAYERS
#define P0_LAYERS 1
#endif
__device__ __forceinline__ void p0_weights(Frame& F, int l0, int l1, int worker, int nworkers) {
    LAS float* scr = (LAS float*)(F.lds + F.wave * 16384);
    unsigned char* ws = F.ws;
    constexpr int IT_WIN = 16 * 168, IT_GLU = 8 * 16 * 2, IT_BR = 3 * 8 * 32, IT_OUT = 16 * 32, IT_W13 = 16 * 2 * 16 * 8, IT_W2 = 48 * 4 * 32;
    constexpr int IT_LAYER = IT_WIN + IT_GLU + IT_BR + IT_OUT + IT_W13 + IT_W2;
    for (int it = l0 * IT_LAYER + worker; it < l1 * IT_LAYER; it += nworkers) {
        const int l = it / IT_LAYER; int r = it % IT_LAYER;
        if (r < IT_WIN) { transpose_item<0>(F.in[I_WIN] + (size_t)l * D * IN_COLS, IN_COLS, 0, F.in[I_N1G] + l * D, (bf16*)(ws + WS_WINT) + (size_t)l * IN_COLS * D, D, 0, scr, r / 168, r % 168, F.lane); continue; }
        r -= IT_WIN;
        if (r < IT_GLU) { const int half = r / (8 * 16); const int q = r % (8 * 16);
            const float* W = F.in[I_WGLU] + (size_t)l * BW * 1024; bf16* dst = (bf16*)(ws + WS_WGLUT) + (size_t)l * 1024 * BW;
            if (half == 0) transpose_item<1>(W, 1024, 0, nullptr, dst, BW, 0, scr, q / 16, q % 16, F.lane);
            else           transpose_item<2>(W, 1024, 512, nullptr, dst, BW, 0, scr, q / 16, q % 16, F.lane);
            continue; }
        r -= IT_GLU;
        if (r < IT_BR) { const int k = r / 256, q = r % 256; transpose_item<0>(F.in[I_WBR] + ((size_t)l * 3 + k) * BW * D, D, 0, nullptr, (bf16*)(ws + WS_WBRT) + ((size_t)l * 3 + k) * D * BW, BW, 0, scr, q / 32, q % 32, F.lane); continue; }
        r -= IT_BR;
        if (r < IT_OUT) { transpose_item<0>(F.in[I_WOUT] + (size_t)l * D * D, D, 0, nullptr, (bf16*)(ws + WS_WOUTT) + (size_t)l * D * D, D, 0, scr, r / 32, r % 32, F.lane); continue; }
        r -= IT_OUT;
        if (r < IT_W13) { const int ge = r / 256, q = r % 256, which = q / 128, qq = q % 128;
            const float* W = F.in[which ? I_W3 : I_W1] + ((size_t)l * 16 + ge) * D * 256; bf16* dst = (bf16*)(ws + WS_W13T) + ((size_t)l * 16 + ge) * 512 * D;
            if (which == 0) transpose_item<1>(W, 256, 0, F.in[I_N2G] + l * D, dst, D, 0, scr, qq / 8, qq % 8, F.lane);
            else            transpose_item<2>(W, 256, 0, F.in[I_N2G] + l * D, dst, D, 0, scr, qq / 8, qq % 8, F.lane);
            continue; }
        r -= IT_W13;
        { const int bs = r / 128, q = r % 128, bucket = bs >> 1, slot = bs & 1, g = bucket / 6; int pa, pb; pair_of(bucket % 6, pa, pb);
          const int e = g * 4 + (slot ? pb : pa);
          transpose_item<0>(F.in[I_W2] + ((size_t)l * 16 + e) * 256 * D, D, 0, nullptr, (bf16*)(ws + WS_W2TB) + ((size_t)l * NBUCKET + bucket) * D * 512, 512, slot * 256, scr, q / 32, q % 32, F.lane); }
    }
}
__device__ __forceinline__ void p0_prologue(Frame& F) {
    LAS float* scr = (LAS float*)(F.lds + F.wave * 16384);
    unsigned char* ws = F.ws;
    if (F.wg < DEPTH * 32) { s5_setup_item(F, F.wg >> 5, F.wg & 31); return; }
    const int gwx = (F.wg - DEPTH * 32) * NWAVES + F.wave; constexpr int NGX = (256 - DEPTH * 32) * NWAVES;
    p0_weights(F, 0, P0_LAYERS, gwx, NGX);
    {
        const float* x = F.in[I_X]; bf16* XB = (bf16*)(ws + WS_XB); float* rinv = (float*)(ws + WS_RINV1);
        for (int m0 = 4 * gwx; m0 < M; m0 += 4 * NGX) {
            f32x4 v[4][4]; float s4[4];
#pragma unroll
            for (int a = 0; a < 4; ++a) { const f32x4* xr = (const f32x4*)(x + (size_t)(m0 + a) * D) + F.lane;
#pragma unroll
                for (int j = 0; j < 4; ++j) v[a][j] = xr[64 * j]; }
#pragma unroll
            for (int a = 0; a < 4; ++a) { float s = 0.f;
#pragma unroll
                for (int j = 0; j < 4; ++j) s += (v[a][j].x * v[a][j].x + v[a][j].y * v[a][j].y) + (v[a][j].z * v[a][j].z + v[a][j].w * v[a][j].w);
                s4[a] = wave_sum(s, F.lane);
                u32x2* o = (u32x2*)(XB + (size_t)(m0 + a) * D) + F.lane;
#pragma unroll
                for (int j = 0; j < 4; ++j) { u32x2 w; w.x = pk2(v[a][j].x, v[a][j].y); w.y = pk2(v[a][j].z, v[a][j].w); o[64 * j] = w; } }
            if (F.lane < 4) { const float s = F.lane == 0 ? s4[0] : (F.lane == 1 ? s4[1] : (F.lane == 2 ? s4[2] : s4[3])); rinv[m0 + F.lane] = 1.0f / sqrtf(s * (1.0f / D) + NORM_EPS); }
        }
    }
    {
        bf16* lf = (bf16*)(ws + WS_LRUF);
        for (int i = gwx * 64 + F.lane; i < DEPTH * 2 * 8 * 2 * 2 * 4 * 64; i += NGX * 64) {
            const int ln = i & 63, ks = (i >> 6) & 3, gate = (i >> 8) & 1, nh = (i >> 9) & 1, hb = (i >> 10) & 7, ld = i >> 13;
            const float* W = F.in[gate ? I_LWI : I_LWR] + ((size_t)ld * 8 + hb) * 4096 + nh * 32 + (ln & 31);
            const int k0 = 16 * ks + 8 * (ln >> 5);
            u32x4 o; o.x = pk2(W[(size_t)(k0 + 0) * 64], W[(size_t)(k0 + 1) * 64]); o.y = pk2(W[(size_t)(k0 + 2) * 64], W[(size_t)(k0 + 3) * 64]);
            o.z = pk2(W[(size_t)(k0 + 4) * 64], W[(size_t)(k0 + 5) * 64]); o.w = pk2(W[(size_t)(k0 + 6) * 64], W[(size_t)(k0 + 7) * 64]);
            *(u32x4*)(lf + (size_t)i * 8) = o;
        }
    }
    {
        float* wrt = (float*)(ws + WS_WRT);
        for (int i = gwx * 64 + F.lane; i < DEPTH * 20 * D; i += NGX * 64) {
            const int k = i % D, j = (i / D) % 20, l = i / (20 * D);
            const float g2 = F.in[I_N2G][l * D + k];
            wrt[i] = g2 * (j < 4 ? F.in[I_WG][((size_t)l * D + k) * 4 + j] : F.in[I_WE][((size_t)l * D + k) * 16 + (j - 4)]);
        }
    }
}

typedef float f32x16 __attribute__((ext_vector_type(16)));
#define MFMA32(a, b, c) __builtin_amdgcn_mfma_f32_32x32x16_bf16((a), (b), (c), 0, 0, 0)
constexpr int S5_ETAB = 0, S5_UIMG = 8192, S5_HIMG = 8192 + 67584, S5_CSTR = 528;

__device__ __forceinline__ void s5_setup_item(Frame& F, int l, int g) {
    LAS float* PW = (LAS float*)F.lds;
    LAS float* BB = PW + 4352;
    LAS float* CC = BB + 4096;
    LAS float* KT = CC + 2048;
    const int tid = F.tid;
    __syncthreads();
    if (tid < 128) {
        const int d = tid >> 6, n = tid & 63, ld = l * 2 + d;
        const float are = F.in[I_ARE][(size_t)ld * 2048 + g * 64 + n], aim = F.in[I_AIM][(size_t)ld * 2048 + g * 64 + n];
        const float step = expf(F.in[I_LSTEP][ld * 32 + g]);
        const double ang1 = (double)aim * (double)step, lm1 = (double)are * (double)step;
        float abr = 0.f, abi = 0.f;
        for (int j = 0; j <= 16; ++j) { const double a = fmod(ang1 * j, 6.283185307179586); float sn, cs; sincosf((float)a, &sn, &cs); const float mg = expf((float)(lm1 * j));
            PW[((d * 64 + n) * 17 + j) * 2] = mg * cs; PW[((d * 64 + n) * 17 + j) * 2 + 1] = mg * sn; if (j == 1) { abr = mg * cs; abi = mg * sn; } }
        { float* lam = (float*)(F.ws + WS_S5LAM) + ((((size_t)l * 32 + g) * 2 + d) * 64 + n) * 4;
          const double a16 = fmod(ang1 * 16.0, 6.283185307179586), a256 = fmod(ang1 * 256.0, 6.283185307179586); float sn, cs;
          sincosf((float)a16, &sn, &cs); const float m16 = expf((float)(lm1 * 16.0)); lam[0] = m16 * cs; lam[1] = m16 * sn;
          sincosf((float)a256, &sn, &cs); const float m256 = expf((float)(lm1 * 256.0)); lam[2] = m256 * cs; lam[3] = m256 * sn; }
        const float den = are * are + aim * aim, nr = abr - 1.0f;
        const float sr = (nr * are + abi * aim) / den, si = (abi * are - nr * aim) / den;
        const float* bre = F.in[I_BRE] + ((size_t)ld * 2048 + g * 64 + n) * 16; const float* bim = F.in[I_BIM] + ((size_t)ld * 2048 + g * 64 + n) * 16;
        for (int c = 0; c < 16; ++c) { BB[((d * 64 + n) * 16 + c) * 2] = sr * bre[c] - si * bim[c]; BB[((d * 64 + n) * 16 + c) * 2 + 1] = sr * bim[c] + si * bre[c]; }
    }
    for (int i = tid; i < 1024; i += NTHREADS) { CC[i * 2] = F.in[I_CRE][((size_t)l * 32 + g) * 1024 + i]; CC[i * 2 + 1] = F.in[I_CIM][((size_t)l * 32 + g) * 1024 + i]; }
    __syncthreads();
    for (int q = tid; q < 8192; q += NTHREADS) {
        const int c = q & 15, cp = (q >> 4) & 15, dl = (q >> 8) & 15, d = q >> 12; float acc = 0.f;
        for (int n = 0; n < 64; ++n) { const float cr = CC[(cp * 64 + n) * 2], ci = CC[(cp * 64 + n) * 2 + 1], pr = PW[((d * 64 + n) * 17 + dl) * 2], pi = PW[((d * 64 + n) * 17 + dl) * 2 + 1];
            const float br = BB[((d * 64 + n) * 16 + c) * 2], bi = BB[((d * 64 + n) * 16 + c) * 2 + 1]; acc += (cr * pr - ci * pi) * br - (cr * pi + ci * pr) * bi; }
        KT[q] = acc;
    }
    __syncthreads();
    bf16* WsF = (bf16*)(F.ws + WS_S5MAT) + ((size_t)l * 32 + g) * 196608; bf16* W3F = WsF + 65536;
    for (int q = tid; q < 8192; q += NTHREADS) {
        const int row = q >> 5, kc = (q & 31) * 8, s_ = kc >> 4, c0 = kc & 15;
        const int nn = row & 31, ri = (row >> 5) & 1, sh = (row >> 6) & 1, d = row >> 7, n = sh * 32 + nn, e = d ? s_ : 15 - s_;
        const float pr = PW[((d * 64 + n) * 17 + e) * 2], pi = PW[((d * 64 + n) * 17 + e) * 2 + 1]; float v[8];
#pragma unroll
        for (int j = 0; j < 8; ++j) { const float br = BB[((d * 64 + n) * 16 + c0 + j) * 2], bi = BB[((d * 64 + n) * 16 + c0 + j) * 2 + 1]; v[j] = ri ? (pr * bi + pi * br) : (pr * br - pi * bi); }
        u32x4 o; o.x = pk2(v[0], v[1]); o.y = pk2(v[2], v[3]); o.z = pk2(v[4], v[5]); o.w = pk2(v[6], v[7]);
        const int tile = row >> 5, ks = kc >> 4, ln = (row & 31) + 32 * ((kc >> 3) & 1);
        *(u32x4*)(WsF + ((size_t)(tile * 16 + ks) * 64 + ln) * 8) = o;
    }
    const float* dsk = F.in[I_SD] + l * BW + g * 16;
    for (int q = tid; q < 16384; q += NTHREADS) {
        const int row = q >> 6, kc = (q & 63) * 8, tau = row >> 4, cp = row & 15; float v[8];
        if (kc < 256) { const int s_ = kc >> 4, c0 = kc & 15;
#pragma unroll
            for (int j = 0; j < 8; ++j) { float m = 0.f; if (s_ <= tau) m += KT[((0 * 16 + (tau - s_)) * 16 + cp) * 16 + c0 + j]; if (s_ >= tau) m += KT[((1 * 16 + (s_ - tau)) * 16 + cp) * 16 + c0 + j];
                if (s_ == tau && c0 + j == cp) m += dsk[cp]; v[j] = m; }
        } else {
#pragma unroll
            for (int j = 0; j < 8; ++j) { const int kh = kc - 256 + j, d = kh >> 7, n = (kh & 127) >> 1, ri = kh & 1, p = d ? 16 - tau : tau + 1;
                const float cr = CC[(cp * 64 + n) * 2], ci = CC[(cp * 64 + n) * 2 + 1], pr = PW[((d * 64 + n) * 17 + p) * 2], pi = PW[((d * 64 + n) * 17 + p) * 2 + 1];
                v[j] = ri ? -(cr * pi + ci * pr) : (cr * pr - ci * pi); }
        }
        u32x4 o; o.x = pk2(v[0], v[1]); o.y = pk2(v[2], v[3]); o.z = pk2(v[4], v[5]); o.w = pk2(v[6], v[7]);
        const int tile = row >> 5, ks = kc >> 4, ln = (row & 31) + 32 * ((kc >> 3) & 1);
        *(u32x4*)(W3F + ((size_t)(tile * 32 + ks) * 64 + ln) * 8) = o;
    }
}


__device__ __forceinline__ void s5_scan_a(f32x16& re, f32x16& im, float Lr, float Li, LAS float* e) {
#pragma unroll
    for (int i = 1; i < 16; ++i) { const float pr = re[i - 1], pi = im[i - 1]; re[i] += Lr * pr - Li * pi; im[i] += Lr * pi + Li * pr; }
    e[0] = re[15]; e[1] = im[15];
}
__device__ __forceinline__ void s5_scan_b(f32x16& re, f32x16& im, float Lr, float Li, float L16r, float L16i, const LAS float* et, int sg, LAS unsigned char* hp, int hstep) {
    float cr = 0.f, ci = 0.f;
#pragma unroll
    for (int sp = 0; sp < 8; ++sp) { const bool use = sp < sg; const float er = et[sp * 64], ei = et[sp * 64 + 1];
        const float nr_ = L16r * cr - L16i * ci + er, ni_ = L16r * ci + L16i * cr + ei; cr = use ? nr_ : cr; ci = use ? ni_ : ci; }
    float pr = Lr, pi = Li;
#pragma unroll
    for (int i = 0; i < 16; ++i) { re[i] += pr * cr - pi * ci; im[i] += pr * ci + pi * cr; const float t = pr * Lr - pi * Li; pi = pr * Li + pi * Lr; pr = t; }
#pragma unroll
    for (int i = 0; i < 16; ++i) *(LAS unsigned*)(hp + i * hstep) = pk2(re[i], im[i]);
}

__device__ __forceinline__ void s5_mfma(Frame& F, int l) {
    const bf16* Z1 = (const bf16*)(F.ws + WS_Z1); bf16* YS = (bf16*)(F.ws + WS_YS);
    LAS unsigned char* UIMG = F.lds + S5_UIMG; LAS unsigned char* HIMG = F.lds + S5_HIMG; LAS float* ETAB = (LAS float*)(F.lds + S5_ETAB);
    const int tid = F.tid, lane = F.lane, w = F.wave, r = lane & 31, h = lane >> 5;
    const int item0 = F.wg >= 128 ? (F.wg - 128) * 4 : 0, item1 = F.wg >= 128 ? item0 + 4 : 0;
    u32x4 uv[8];
#define S5_LOAD_U(IT) do { const int b_ = (IT) >> 5, g_ = (IT) & 31; _Pragma("unroll") for (int q = 0; q < 8; ++q) { const int p = tid + q * NTHREADS, token = p >> 1, half = p & 1; \
        uv[q] = *(const u32x4*)(Z1 + ((size_t)b_ * SEQ + token) * ZC + COL_U + g_ * 16 + half * 8); } } while (0)
    if (item0 < item1) S5_LOAD_U(item0);
    for (int item = item0; item < item1; ++item) {
        const int b = item >> 5, g = item & 31;
        const bf16* WsF = (const bf16*)(F.ws + WS_S5MAT) + ((size_t)l * 32 + g) * 196608; const bf16* W3F = WsF + 65536;
        __syncthreads();
        {
#pragma unroll
          for (int q = 0; q < 8; ++q) { const int p = tid + q * NTHREADS, token = p >> 1, half = p & 1; *(LAS u32x4*)(UIMG + (token >> 4) * S5_CSTR + (token & 15) * 32 + half * 16) = uv[q]; } }
        { unsigned z = 0u; asm volatile("" : "+v"(z));
          if (tid < 16) *(LAS u32x4*)(HIMG + 1 * S5_CSTR + tid * 16) = (u32x4){z, z, z, z};
          else if (tid < 32) *(LAS u32x4*)(HIMG + 128 * S5_CSTR + 256 + (tid - 16) * 16) = (u32x4){z, z, z, z}; }
        __syncthreads();
        if (item + 1 < item1) S5_LOAD_U(item + 1);
        const int d = w >> 2, sh = (w >> 1) & 1, mh = w & 1;
        f32x16 sre[2], sim[2];
#pragma unroll
        for (int i = 0; i < 16; ++i) { sre[0][i] = 0.f; sre[1][i] = 0.f; sim[0][i] = 0.f; sim[1][i] = 0.f; }
        {
            const int qf = 16 * ((r >> 2) & 1) + 4 * (r >> 3) + (r & 3);
            const int qr = d ? 127 - (64 * mh + qf) : 64 * mh + qf;
            const bf16* bre = WsF + ((size_t)(((d * 2 + sh) * 2 + 0) * 16) * 64 + lane) * 8; const bf16* bim = bre + (size_t)16 * 64 * 8;
            const LAS unsigned char* a0 = UIMG + qr * S5_CSTR + 16 * h; const LAS unsigned char* a1 = UIMG + (d ? qr - 32 : qr + 32) * S5_CSTR + 16 * h;
            unsigned zq = 0u; asm volatile("" : "+v"(zq));
            u32x4 gre[4], gim[4], l0, l1, ore, oim, ox0, ox1;
#pragma unroll
            for (int q = 0; q < 4; ++q) { gre[q] = *(const u32x4*)(bre + q * 512); gim[q] = *(const u32x4*)(bim + q * 512); }
            l0 = *(const LAS u32x4*)(a0); l1 = *(const LAS u32x4*)(a1);
            ore = oim = ox0 = ox1 = (u32x4){0u, 0u, 0u, 0u};
#pragma unroll
            for (int ks = 0; ks < 16; ++ks) {
                asm volatile("s_nop 15\n\ts_nop 15" : "+v"(zq), "+v"(ore), "+v"(oim), "+v"(ox0), "+v"(ox1));
                ore = gre[ks & 3] ^ zq; oim = gim[ks & 3] ^ zq; ox0 = l0 ^ zq; ox1 = l1 ^ zq;
                asm volatile("" : "+v"(ore), "+v"(oim), "+v"(ox0), "+v"(ox1));
                if (ks + 4 < 16) { gre[ks & 3] = *(const u32x4*)(bre + (ks + 4) * 512); gim[ks & 3] = *(const u32x4*)(bim + (ks + 4) * 512); }
                if (ks + 1 < 16) { l0 = *(const LAS u32x4*)(a0 + (ks + 1) * 32); l1 = *(const LAS u32x4*)(a1 + (ks + 1) * 32); }
                sre[0] = MFMA32(__builtin_bit_cast(bf16x8, ox0), __builtin_bit_cast(bf16x8, ore), sre[0]); sim[0] = MFMA32(__builtin_bit_cast(bf16x8, ox0), __builtin_bit_cast(bf16x8, oim), sim[0]);
                sre[1] = MFMA32(__builtin_bit_cast(bf16x8, ox1), __builtin_bit_cast(bf16x8, ore), sre[1]); sim[1] = MFMA32(__builtin_bit_cast(bf16x8, ox1), __builtin_bit_cast(bf16x8, oim), sim[1]);
            }
            asm volatile("" : "+v"(ore), "+v"(oim), "+v"(ox0), "+v"(ox1));
        }
        __builtin_amdgcn_sched_barrier(0);
        asm volatile("s_nop 15\n\ts_nop 15\n\ts_nop 15\n\ts_nop 15\n\ts_nop 15" : "+v"(sre[0]), "+v"(sre[1]), "+v"(sim[0]), "+v"(sim[1]));
        __builtin_amdgcn_sched_barrier(0);

        const int n = sh * 32 + r;
        const f32x4 lam = *(const f32x4*)((const float*)(F.ws + WS_S5LAM) + ((((size_t)l * 32 + g) * 2 + d) * 64 + n) * 4);
        LAS float* et = ETAB + ((d * 2 + sh) * 8) * 64 + r * 2;
        const int sg0 = 4 * mh + h, sg1 = sg0 + 2;
        s5_scan_a(sre[0], sim[0], lam[0], lam[1], et + sg0 * 64); s5_scan_a(sre[1], sim[1], lam[0], lam[1], et + sg1 * 64);
        __syncthreads();
        {
            const int cs0 = 16 * sg0, cs1 = 16 * sg1, hstep = d ? -S5_CSTR : S5_CSTR;
            LAS unsigned char* hcol = HIMG + d * 256 + 4 * n;
            s5_scan_b(sre[0], sim[0], lam[0], lam[1], lam[2], lam[3], et, sg0, hcol + (d ? 127 - cs0 : cs0 + 2) * S5_CSTR, hstep);
            s5_scan_b(sre[1], sim[1], lam[0], lam[1], lam[2], lam[3], et, sg1, hcol + (d ? 127 - cs1 : cs1 + 2) * S5_CSTR, hstep);
        }
        __syncthreads();
        f32x16 acc[4];
#pragma unroll
        for (int nt = 0; nt < 4; ++nt)
#pragma unroll
            for (int i = 0; i < 16; ++i) acc[nt][i] = 0.f;
        {
            const bf16* ap = W3F + ((size_t)(w * 32) * 64 + lane) * 8;
            unsigned bxa[4], bha[4];
#pragma unroll
            for (int nt = 0; nt < 4; ++nt) { bxa[nt] = (unsigned)(S5_UIMG + (nt * 32 + r) * S5_CSTR + 16 * h); bha[nt] = (unsigned)(S5_HIMG + (nt * 32 + r + 1) * S5_CSTR + 16 * h); }
            unsigned zq = 0u; asm volatile("" : "+v"(zq));
            u32x4 ga[4], lx[4], oa, ox[4];
#pragma unroll
            for (int q = 0; q < 4; ++q) ga[q] = *(const u32x4*)(ap + q * 512);
#pragma unroll
            for (int nt = 0; nt < 4; ++nt) { lx[nt] = *(const LAS u32x4*)(F.lds + bxa[nt]); ox[nt] = (u32x4){0u, 0u, 0u, 0u}; }
            oa = (u32x4){0u, 0u, 0u, 0u};
#pragma unroll
            for (int ks = 0; ks < 32; ++ks) {
                asm volatile("s_nop 15\n\ts_nop 15" : "+v"(zq), "+v"(oa), "+v"(ox[0]), "+v"(ox[1]), "+v"(ox[2]), "+v"(ox[3]));
                oa = ga[ks & 3] ^ zq;
#pragma unroll
                for (int nt = 0; nt < 4; ++nt) ox[nt] = lx[nt] ^ zq;
                asm volatile("" : "+v"(oa), "+v"(ox[0]), "+v"(ox[1]), "+v"(ox[2]), "+v"(ox[3]));
                if (ks + 4 < 32) ga[ks & 3] = *(const u32x4*)(ap + (ks + 4) * 512);
                if (ks + 1 < 32) {
#pragma unroll
                    for (int nt = 0; nt < 4; ++nt) lx[nt] = *(const LAS u32x4*)(F.lds + ((ks + 1) < 16 ? bxa[nt] + (ks + 1) * 32 : bha[nt] + (ks + 1 - 16) * 32));
                }
#pragma unroll
                for (int nt = 0; nt < 4; ++nt) acc[nt] = MFMA32(__builtin_bit_cast(bf16x8, oa), __builtin_bit_cast(bf16x8, ox[nt]), acc[nt]);
            }
            asm volatile("" : "+v"(oa), "+v"(ox[0]), "+v"(ox[1]), "+v"(ox[2]), "+v"(ox[3]));
            asm volatile("" :: "v"(bxa[0]), "v"(bxa[1]), "v"(bxa[2]), "v"(bxa[3]), "v"(bha[0]), "v"(bha[1]), "v"(bha[2]), "v"(bha[3]));
        }
        __builtin_amdgcn_sched_barrier(0);
        asm volatile("s_nop 15\n\ts_nop 15\n\ts_nop 15\n\ts_nop 15\n\ts_nop 15" : "+v"(acc[0]), "+v"(acc[1]), "+v"(acc[2]), "+v"(acc[3]));
        __builtin_amdgcn_sched_barrier(0);
#pragma unroll
        for (int nt = 0; nt < 4; ++nt)
#pragma unroll
            for (int gq = 0; gq < 4; ++gq) { const int tau = 2 * w + (gq >> 1), cp = 8 * (gq & 1) + 4 * h, token = (32 * nt + r) * 16 + tau;
                u32x2 o; o.x = pk2hw(gelu_tanh(acc[nt][4 * gq]), gelu_tanh(acc[nt][4 * gq + 1])); o.y = pk2hw(gelu_tanh(acc[nt][4 * gq + 2]), gelu_tanh(acc[nt][4 * gq + 3]));
                *(u32x2*)(YS + ((size_t)b * SEQ + token) * BW + g * 16 + cp) = o; }
    }
#undef S5_LOAD_U
    __syncthreads();
}


#define MFMA_FENCE3(a, b, c) asm volatile("s_nop 15\n\ts_nop 15\n\ts_nop 15\n\ts_nop 15\n\ts_nop 15" : "+v"(a), "+v"(b), "+v"(c))
__device__ __forceinline__ void lru_half_scan(f32x16& aR, f32x16& aI, const f32x16& aX, float br, float bi, float lamc, LAS float* sgw) {
    float Pp = 1.f, Hh = 0.f;
#pragma unroll
    for (int i = 0; i < 16; ++i) {
        const float rg = sigmoidf_(aR[i] + br), ig = sigmoidf_(aI[i] + bi), x2 = 2.0f * lamc * rg;
        const float a = __builtin_amdgcn_exp2f(0.72134752044f * x2);
        const float om = __builtin_fmaf(-a, a, 1.0f);
        const float u = __builtin_amdgcn_sqrtf(fmaxf(om, 0.f)) * ig * aX[i];
        Hh = a * Hh + u; Pp = a * Pp; aR[i] = Hh; aI[i] = Pp;
        if ((i & 3) == 3) asm volatile("" : "+v"(Hh), "+v"(Pp));
    }
    sgw[0] = Pp; sgw[1] = Hh;
}
constexpr int LRU_TILE = 16384, LRU_TILE_BYTES = 33 * 1024;
__device__ __forceinline__ void lru_mfma(Frame& F, int l) {
    const bf16* Z1 = (const bf16*)(F.ws + WS_Z1); bf16* OL = (bf16*)(F.ws + WS_OL);
    LAS float* CW = (LAS float*)F.lds;
    LAS float* SEG = CW + 320;
    const int tid = F.tid, lane = F.lane, w = F.wave, r = lane & 31, hh = lane >> 5;
    for (int item = F.wg; item < (F.wg < 128 ? BATCH * 8 : 0); item += 128) {
        const int b = item >> 3, hb = item & 7, ch0 = hb * 64 + r;
        __syncthreads();
        if (tid < 256) CW[tid] = F.in[I_CONVW][((size_t)l * 4 + (tid >> 6)) * BW + hb * 64 + (tid & 63)];
        else if (tid < 320) CW[tid] = F.in[I_CONVB][l * BW + hb * 64 + (tid - 256)];
        const int qf = 16 * ((r >> 2) & 1) + 4 * (r >> 3) + (r & 3);
        const bf16* xrb = Z1 + (size_t)b * SEQ * ZC + COL_XR + hb * 64 + (lane & 7) * 8;
#pragma unroll 1
        for (int dir = 0; dir < 2; ++dir) {
            bf16x8 wr[2][4], wi[2][4];
#pragma unroll
            for (int nh = 0; nh < 2; ++nh) { const bf16* lf = (const bf16*)(F.ws + WS_LRUF) + ((((((size_t)l * 2 + dir) * 8 + hb) * 2 + nh) * 2) * 4 * 64 + lane) * 8;
#pragma unroll
              for (int ks = 0; ks < 4; ++ks) { wr[nh][ks] = *(const bf16x8*)(lf + (size_t)ks * 512); wi[nh][ks] = *(const bf16x8*)(lf + (size_t)(4 + ks) * 512); } }
            float br[2], bi[2], lamc[2], carry[2] = {0.f, 0.f};
#pragma unroll
            for (int nh = 0; nh < 2; ++nh) { const int ch = ch0 + 32 * nh; br[nh] = F.in[I_LBR][((size_t)l * 2 + dir) * BW + ch]; bi[nh] = F.in[I_LBI][((size_t)l * 2 + dir) * BW + ch];
                lamc[nh] = -8.0f * log1pf(expf(-F.in[I_LAM][((size_t)l * 2 + dir) * BW + ch])); }
#define LRU_STAGE(SC) do { const int tlo_ = dir ? SEQ - 256 * ((SC) + 1) : 256 * (SC); \
                for (int j_ = w; j_ < 33; j_ += NWAVES) { int t_ = tlo_ - 2 + 8 * j_ + (lane >> 3); t_ = t_ < 0 ? 0 : (t_ >= SEQ ? SEQ - 1 : t_); \
                    __builtin_amdgcn_global_load_lds((const unsigned*)(xrb + (size_t)t_ * ZC), (LAS unsigned*)(F.lds + LRU_TILE + ((SC) & 1) * LRU_TILE_BYTES + j_ * 1024), 16, 0, 0); } } while (0)
            LRU_STAGE(0);
#pragma unroll 1
            for (int sc = 0; sc < 8; ++sc) {
                asm volatile("s_waitcnt vmcnt(0)" ::: "memory"); __syncthreads();
                if (sc + 1 < 8) LRU_STAGE(sc + 1);
                const int srow = sc * 256 + w * 32 + qf, trow = dir ? (SEQ - 1 - srow) : srow, tlo = dir ? SEQ - 256 * (sc + 1) : 256 * sc;
                const LAS unsigned char* tl = F.lds + LRU_TILE + (sc & 1) * LRU_TILE_BYTES + (trow - tlo) * 128 + 16 * hh;
                bf16x8 av[4];
#pragma unroll
                for (int ks = 0; ks < 4; ++ks) {
                    const int c0 = 16 * ks + 8 * hh;
                    float xv[8];
#pragma unroll
                    for (int j = 0; j < 8; ++j) xv[j] = CW[256 + c0 + j];
#pragma unroll
                    for (int tap = 0; tap < 4; ++tap) { const int tt = trow + tap - 2; const float msk = (tt >= 0 && tt < SEQ) ? 1.0f : 0.0f;
                        const bf16x8 v = *(const LAS bf16x8*)(tl + tap * 128 + ks * 32);
#pragma unroll
                        for (int j = 0; j < 8; ++j) xv[j] += (CW[tap * 64 + c0 + j] * msk) * bf2f((bf16)v[j]); }
                    u32x4 pa; pa.x = pk2hw(xv[0], xv[1]); pa.y = pk2hw(xv[2], xv[3]); pa.z = pk2hw(xv[4], xv[5]); pa.w = pk2hw(xv[6], xv[7]);
                    av[ks] = __builtin_bit_cast(bf16x8, pa);
                }
                const int st0 = sc * 256 + w * 32 + 16 * hh; const size_t tok0 = (size_t)b * SEQ + (dir ? (SEQ - 1 - st0) : st0); const long tstep = dir ? -1 : 1;
#pragma unroll
                for (int nh = 0; nh < 2; ++nh) {
                    const int ch = ch0 + 32 * nh;
                    f32x16 aR, aI, aX;
#pragma unroll
                    for (int i = 0; i < 16; ++i) { aR[i] = 0.f; aI[i] = 0.f; aX[i] = 0.f; }
                    bf16x8 idf[4];
#pragma unroll
                    for (int ks = 0; ks < 4; ++ks) { u32x4 pd_;
#pragma unroll
                        for (int jj = 0; jj < 4; ++jj) { const int k0 = 16 * ks + 8 * hh + 2 * jj; pd_[jj] = (k0 == nh * 32 + r ? 0x3f80u : 0u) | (k0 + 1 == nh * 32 + r ? 0x3f800000u : 0u); }
                        idf[ks] = __builtin_bit_cast(bf16x8, pd_); }
                    __builtin_amdgcn_sched_barrier(0);
#pragma unroll
                    for (int ks = 0; ks < 4; ++ks) { aR = MFMA32(av[ks], wr[nh][ks], aR); aI = MFMA32(av[ks], wi[nh][ks], aI); aX = MFMA32(av[ks], idf[ks], aX); }
                    __builtin_amdgcn_sched_barrier(0);
                    MFMA_FENCE3(aR, aI, aX);
                    __builtin_amdgcn_sched_barrier(0);
                    bf16 hfv[16], grv[16];
                    if (dir) {
#pragma unroll
                        for (int i = 0; i < 16; ++i) { const size_t tok = tok0 + tstep * i; hfv[i] = OL[tok * BW + ch]; grv[i] = Z1[tok * ZC + COL_GR + ch]; }
                    }
                    LAS float* sg = SEG + nh * 1024;
                    lru_half_scan(aR, aI, aX, br[nh], bi[nh], lamc[nh], sg + ((2 * w + hh) * 32 + r) * 2);
                    __syncthreads();
                    float cin = 0.f, X = carry[nh];
#pragma unroll
                    for (int sp = 0; sp < 16; ++sp) { cin = (sp == 2 * w + hh) ? X : cin; X = sg[(sp * 32 + r) * 2] * X + sg[(sp * 32 + r) * 2 + 1]; }
                    carry[nh] = X;
                    if (dir == 0) {
#pragma unroll
                        for (int i = 0; i < 16; i += 2) { const unsigned p = pk2hw(aR[i] + aI[i] * cin, aR[i + 1] + aI[i + 1] * cin);
                            OL[(tok0 + tstep * i) * BW + ch] = (bf16)(p & 0xffffu); OL[(tok0 + tstep * (i + 1)) * BW + ch] = (bf16)(p >> 16); }
                    } else {
#pragma unroll
                        for (int i = 0; i < 16; i += 2) { const unsigned p = pk2hw(gelu_tanh(bf2f(grv[i])) * (bf2f(hfv[i]) + aR[i] + aI[i] * cin), gelu_tanh(bf2f(grv[i + 1])) * (bf2f(hfv[i + 1]) + aR[i + 1] + aI[i + 1] * cin));
                            OL[(tok0 + tstep * i) * BW + ch] = (bf16)(p & 0xffffu); OL[(tok0 + tstep * (i + 1)) * BW + ch] = (bf16)(p >> 16); }
                    }
                }
            }
            asm volatile("s_waitcnt vmcnt(0)" ::: "memory"); __syncthreads();
        }
    }
    __syncthreads();
}

#ifndef ATT_LO
#define ATT_LO 1
#endif
constexpr int AT_KSTR = 144, AT_VSTR = 776, AT_K = 0, AT_V = 384 * AT_KSTR;
__device__ __forceinline__ void attn_mfma(Frame& F, int l) {
    const bf16* Z1 = (const bf16*)(F.ws + WS_Z1); bf16* OA = (bf16*)(F.ws + WS_OA);
    LAS unsigned char* KL = F.lds + AT_K; LAS unsigned char* VT = F.lds + AT_V;
    const int tid = F.tid, lane = F.lane, w = F.wave, r = lane & 31, hh = lane >> 5;
    const float LOG2E = 1.4426950408889634f;
    for (int k = 0; k < (F.wg < 128 ? ATT_LO : 4 - ATT_LO); ++k) {
        const int item = F.wg < 128 ? F.wg * ATT_LO + k : 128 * ATT_LO + (F.wg - 128) * (4 - ATT_LO) + k;
        const int b = item >> 5, nb = (item >> 1) & 15, kvh = item & 1;
        __syncthreads();
        { u32x4 kq[6], vq[6];
#pragma unroll
          for (int q = 0; q < 6; ++q) { const int p = tid + q * NTHREADS, kj = p >> 3, dc = p & 7, sp = nb * 128 - 128 + kj; const bool ok = (sp >= 0 && sp < SEQ);
              const bf16* base = Z1 + ((size_t)b * SEQ + (ok ? sp : 0)) * ZC + kvh * 64 + dc * 8; kq[q] = *(const u32x4*)(base + COL_K); vq[q] = *(const u32x4*)(base + COL_V);
              if (!ok) { kq[q] = (u32x4){0u, 0u, 0u, 0u}; vq[q] = (u32x4){0u, 0u, 0u, 0u}; } }
#pragma unroll
          for (int q = 0; q < 6; ++q) { const int p = tid + q * NTHREADS, kj = p >> 3, dc = p & 7; const u32x4 vv = vq[q];
              *(LAS u32x4*)(KL + kj * AT_KSTR + dc * 16) = kq[q];
              LAS bf16* vt = (LAS bf16*)(VT + (dc * 8) * AT_VSTR + kj * 2);
              vt[0 * (AT_VSTR / 2)] = (bf16)(vv.x & 0xffffu); vt[1 * (AT_VSTR / 2)] = (bf16)(vv.x >> 16); vt[2 * (AT_VSTR / 2)] = (bf16)(vv.y & 0xffffu); vt[3 * (AT_VSTR / 2)] = (bf16)(vv.y >> 16);
              vt[4 * (AT_VSTR / 2)] = (bf16)(vv.z & 0xffffu); vt[5 * (AT_VSTR / 2)] = (bf16)(vv.z >> 16); vt[6 * (AT_VSTR / 2)] = (bf16)(vv.w & 0xffffu); vt[7 * (AT_VSTR / 2)] = (bf16)(vv.w >> 16); } }
        __syncthreads();
#pragma unroll 1
        for (int task = w; task < 16; task += NWAVES) {
            const int g = task >> 2, qt = task & 3, hq = kvh * 4 + g;
            const size_t tokq = (size_t)b * SEQ + nb * 128 + 32 * qt + r;
            bf16x8 qf[4];
#pragma unroll
            for (int ks = 0; ks < 4; ++ks) qf[ks] = *(const bf16x8*)(Z1 + tokq * ZC + COL_Q + hq * 64 + 16 * ks + 8 * hh);
            const float slope2 = exp2f(-(float)(hq + 1)) * LOG2E, sink2 = F.in[I_SINK][l * NQ + hq] * LOG2E;
            float m = sink2, lsum = 1.0f;
            f32x16 o0, o1;
#pragma unroll
            for (int i = 0; i < 16; ++i) { o0[i] = 0.f; o1[i] = 0.f; }
            u32x4 ka[4] = {(u32x4){0u, 0u, 0u, 0u}, (u32x4){0u, 0u, 0u, 0u}, (u32x4){0u, 0u, 0u, 0u}, (u32x4){0u, 0u, 0u, 0u}};
            u32x4 pp0 = (u32x4){0u, 0u, 0u, 0u}, pp1 = pp0, va0 = pp0, va1 = pp0, va2 = pp0, va3 = pp0;
#pragma unroll 1
            for (int kt = qt; kt < qt + 9; ++kt) {
                f32x16 sc;
#pragma unroll
                for (int i = 0; i < 16; ++i) sc[i] = 0.f;
                { const LAS unsigned char* kp = KL + (32 * kt + r) * AT_KSTR + 16 * hh;
#pragma unroll
                  for (int ks = 0; ks < 4; ++ks) ka[ks] = *(const LAS u32x4*)(kp + ks * 32);
#pragma unroll
                  for (int ks = 0; ks < 4; ++ks) sc = MFMA32(__builtin_bit_cast(bf16x8, ka[ks]), qf[ks], sc); }
                __builtin_amdgcn_sched_barrier(0);
                asm volatile("s_nop 15\n\ts_nop 15\n\ts_nop 15\n\ts_nop 15\n\ts_nop 15" : "+v"(sc), "+v"(o0), "+v"(o1), "+v"(pp0), "+v"(pp1), "+v"(va0), "+v"(va1), "+v"(va2), "+v"(va3), "+v"(ka[0]), "+v"(ka[1]), "+v"(ka[2]), "+v"(ka[3]));
                __builtin_amdgcn_sched_barrier(0);
                const float fd0 = (float)(128 + 32 * qt + r - 32 * kt - 4 * hh);
                const bool inwin = (kt > qt) && (kt < qt + 8), inseq = (nb * 128 - 128 + 32 * kt >= 0) && (nb * 128 - 128 + 32 * kt + 31 < SEQ);
                float tmax = -1e30f;
                if (inwin && inseq) {
#pragma unroll
                    for (int i = 0; i < 16; ++i) { const float dd = fd0 - (float)((i & 3) + 8 * (i >> 2)); const float v = sc[i] * (0.125f * LOG2E) - slope2 * __builtin_fabsf(dd); sc[i] = v; tmax = fmaxf(tmax, v); }
                } else {
#pragma unroll
                    for (int i = 0; i < 16; ++i) { const int kj = 32 * kt + (i & 3) + 8 * (i >> 2) + 4 * hh, sp = nb * 128 - 128 + kj; const float dd = fd0 - (float)((i & 3) + 8 * (i >> 2)), ad = __builtin_fabsf(dd);
                        const bool valid = (ad <= (float)WIN) && (sp >= 0) && (sp < SEQ);
                        const float v = valid ? (sc[i] * (0.125f * LOG2E) - slope2 * ad) : -1e30f; sc[i] = v; tmax = fmaxf(tmax, v); }
                }
                { const auto sw = __builtin_amdgcn_permlane32_swap(__float_as_uint(tmax), __float_as_uint(tmax), false, false); tmax = fmaxf(__uint_as_float(sw[0]), __uint_as_float(sw[1])); }
                const float mnew = fmaxf(m, tmax), alpha = __builtin_amdgcn_exp2f(m - mnew); m = mnew;
                float psum = 0.f;
#pragma unroll
                for (int i = 0; i < 16; ++i) { const float p = __builtin_amdgcn_exp2f(sc[i] - mnew); sc[i] = p; psum += p; }
                { const auto sw = __builtin_amdgcn_permlane32_swap(__float_as_uint(psum), __float_as_uint(psum), false, false); psum = __uint_as_float(sw[0]) + __uint_as_float(sw[1]); }
                lsum = lsum * alpha + psum;
#pragma unroll
                for (int i = 0; i < 16; ++i) { o0[i] *= alpha; o1[i] *= alpha; }
                pp0.x = pk2hw(sc[0], sc[1]); pp0.y = pk2hw(sc[2], sc[3]); pp0.z = pk2hw(sc[4], sc[5]); pp0.w = pk2hw(sc[6], sc[7]);
                pp1.x = pk2hw(sc[8], sc[9]); pp1.y = pk2hw(sc[10], sc[11]); pp1.z = pk2hw(sc[12], sc[13]); pp1.w = pk2hw(sc[14], sc[15]);
                {   const LAS unsigned char* vp = VT + r * AT_VSTR + (32 * kt + 4 * hh) * 2;
#define AT_LDV(dst, off) do { const u32x2 lo_ = *(const LAS u32x2*)(vp + (off)), hi_ = *(const LAS u32x2*)(vp + (off) + 16); dst.x = lo_.x; dst.y = lo_.y; dst.z = hi_.x; dst.w = hi_.y; } while (0)
                    AT_LDV(va0, 0); AT_LDV(va1, 32 * AT_VSTR); AT_LDV(va2, 32); AT_LDV(va3, 32 * AT_VSTR + 32);
#undef AT_LDV
                    o0 = MFMA32(__builtin_bit_cast(bf16x8, va0), __builtin_bit_cast(bf16x8, pp0), o0); o1 = MFMA32(__builtin_bit_cast(bf16x8, va1), __builtin_bit_cast(bf16x8, pp0), o1);
                    o0 = MFMA32(__builtin_bit_cast(bf16x8, va2), __builtin_bit_cast(bf16x8, pp1), o0); o1 = MFMA32(__builtin_bit_cast(bf16x8, va3), __builtin_bit_cast(bf16x8, pp1), o1); }
            }
            __builtin_amdgcn_sched_barrier(0);
            asm volatile("s_nop 15\n\ts_nop 15\n\ts_nop 15\n\ts_nop 15\n\ts_nop 15" : "+v"(o0), "+v"(o1), "+v"(pp0), "+v"(pp1), "+v"(va0), "+v"(va1), "+v"(va2), "+v"(va3));
            __builtin_amdgcn_sched_barrier(0);
            const float inv = 1.0f / lsum;
            bf16* op = OA + tokq * BW + hq * 64 + 4 * hh;
#pragma unroll
            for (int gq = 0; gq < 4; ++gq) {
                u32x2 w0, w1; w0.x = pk2hw(o0[4 * gq] * inv, o0[4 * gq + 1] * inv); w0.y = pk2hw(o0[4 * gq + 2] * inv, o0[4 * gq + 3] * inv);
                w1.x = pk2hw(o1[4 * gq] * inv, o1[4 * gq + 1] * inv); w1.y = pk2hw(o1[4 * gq + 2] * inv, o1[4 * gq + 3] * inv);
                *(u32x2*)(op + 8 * gq) = w0; *(u32x2*)(op + 32 + 8 * gq) = w1; }
        }
    }
    __syncthreads();
}

__device__ __forceinline__ void p4a_router(Frame& F, int l) {
    LAS float* wl = (LAS float*)F.lds;
    LAS int* bk = (LAS int*)(F.lds + 81920);
    const float* wrt = (const float*)(F.ws + WS_WRT) + (size_t)l * 20 * D;
    for (int i = F.tid; i < 20 * D / 4; i += NTHREADS) ((LAS f32x4*)wl)[i] = ((const f32x4*)wrt)[i];
    __syncthreads();
    const float* X = F.out; float* rinv2 = (float*)(F.ws + WS_RINV2); int* BUCKET = (int*)(F.ws + WS_BUCKET); float* WTOK = (float*)(F.ws + WS_WTOK);
    const int lane = F.lane, t2 = lane >> 4, kk = lane & 15, tok0 = F.wg * 128 + F.wave * 16 + 4 * t2;
    float lg[4][20], ss[4];
#pragma unroll
    for (int i = 0; i < 4; ++i) { ss[i] = 0.f;
#pragma unroll
        for (int o = 0; o < 20; ++o) lg[i][o] = 0.f; }
    const f32x4* xr = (const f32x4*)(X + (size_t)tok0 * D) + kk;
#pragma unroll 2
    for (int jj = 0; jj < 16; ++jj) {
        f32x4 x4[4];
#pragma unroll
        for (int i = 0; i < 4; ++i) x4[i] = xr[(size_t)i * (D / 4) + 16 * jj];
#pragma unroll
        for (int i = 0; i < 4; ++i) ss[i] += (x4[i].x * x4[i].x + x4[i].y * x4[i].y) + (x4[i].z * x4[i].z + x4[i].w * x4[i].w);
#pragma unroll
        for (int o = 0; o < 20; ++o) { const f32x4 w4 = ((const LAS f32x4*)(wl + o * D))[16 * jj + kk];
#pragma unroll
            for (int i = 0; i < 4; ++i) lg[i][o] += (x4[i].x * w4.x + x4[i].y * w4.y) + (x4[i].z * w4.z + x4[i].w * w4.w); }
    }
#pragma unroll
    for (int i = 0; i < 4; ++i) {
#pragma unroll
        for (int o = 0; o < 20; ++o) { float v = lg[i][o]; v += dpp_ror<8>(v); v += dpp_ror<4>(v); v += dpp_ror<2>(v); v += dpp_ror<1>(v); lg[i][o] = v; }
        { float v = ss[i]; v += dpp_ror<8>(v); v += dpp_ror<4>(v); v += dpp_ror<2>(v); v += dpp_ror<1>(v); ss[i] = v; } }
    {
        float lgv[20], ssv = ss[0];
#pragma unroll
        for (int o = 0; o < 20; ++o) lgv[o] = lg[0][o];
#pragma unroll
        for (int i = 1; i < 4; ++i) { ssv = (kk == i) ? ss[i] : ssv;
#pragma unroll
            for (int o = 0; o < 20; ++o) lgv[o] = (kk == i) ? lg[i][o] : lgv[o]; }
        const int tok = tok0 + (kk & 3); const float ri = 1.0f / sqrtf(ssv * (1.0f / D) + NORM_EPS);
        float gl[4]; int gi = 0; float gm;
#pragma unroll
        for (int q = 0; q < 4; ++q) gl[q] = lgv[q] * ri + F.in[I_BG][l * 4 + q];
        gm = gl[0];
#pragma unroll
        for (int q = 1; q < 4; ++q) if (gl[q] > gm) { gm = gl[q]; gi = q; }
        float gs = 0.f;
#pragma unroll
        for (int q = 0; q < 4; ++q) gs += expf(gl[q] - gm);
        const float gw = 1.0f / gs;
        float el[4];
#pragma unroll
        for (int e = 0; e < 4; ++e) { float v = 0.f;
#pragma unroll
            for (int g = 0; g < 4; ++g) v = (gi == g) ? (lgv[4 + g * 4 + e] * ri + F.in[I_BE][l * 16 + g * 4 + e]) : v;
            el[e] = v; }
        int i1 = 0; float v1 = el[0];
#pragma unroll
        for (int e = 1; e < 4; ++e) if (el[e] > v1) { v1 = el[e]; i1 = e; }
        int i2 = -1; float v2 = -3.4e38f;
#pragma unroll
        for (int e = 0; e < 4; ++e) if (e != i1 && el[e] > v2) { v2 = el[e]; i2 = e; }
        const float e2 = expf(v2 - v1), w1 = gw / (1.0f + e2), w2 = gw * e2 / (1.0f + e2);
        const int ea = i1 < i2 ? i1 : i2, eb = i1 < i2 ? i2 : i1; const float wa = i1 < i2 ? w1 : w2, wb = i1 < i2 ? w2 : w1;
        const int bucket = gi * 6 + pair_index(ea, eb);
        if (kk < 4) { rinv2[tok] = ri; BUCKET[tok] = bucket; WTOK[2 * tok] = wa; WTOK[2 * tok + 1] = wb; bk[F.wave * 16 + 4 * t2 + kk] = bucket; }
    }
    __syncthreads();
    if (F.tid < 128) { const int b = bk[F.tid]; int r = 0; for (int i = 0; i < F.tid; ++i) r += (bk[i] == b) ? 1 : 0; ((int*)(F.ws + WS_RANK))[F.wg * 128 + F.tid] = r; }
    if (F.tid >= 128 && F.tid < 128 + 32) { const int b = F.tid - 128; int c = 0; if (b < NBUCKET) for (int i = 0; i < 128; ++i) c += (bk[i] == b) ? 1 : 0; ((int*)(F.ws + WS_HIST))[F.wg * 32 + b] = c; }
    __syncthreads();
}

__device__ __forceinline__ void p4b_positions(Frame& F) {
    LAS int* tot = (LAS int*)F.lds; LAS int* pre = tot + 32; LAS int* base = tot + 64;
    const int* HIST = (const int*)(F.ws + WS_HIST);
    if (F.tid < NBUCKET) { int t = 0, p = 0; for (int w = 0; w < 256; ++w) { const int h = HIST[w * 32 + F.tid]; if (w < F.wg) p += h; t += h; } tot[F.tid] = t; pre[F.tid] = p; }
    __syncthreads();
    if (F.tid == 0) { int a = 0; for (int b = 0; b < NBUCKET; ++b) { base[b] = a; a += (tot[b] + 255) & ~255; } base[NBUCKET] = a; }
    __syncthreads();
    int* IDX = (int*)(F.ws + WS_IDX); float* WSORT = (float*)(F.ws + WS_WSORT); float* RSORT = (float*)(F.ws + WS_RSORT); const float* WTOK = (const float*)(F.ws + WS_WTOK);
    if (F.tid < 128) { const int tok = F.wg * 128 + F.tid; const int b = ((const int*)(F.ws + WS_BUCKET))[tok]; const int pos = base[b] + pre[b] + ((const int*)(F.ws + WS_RANK))[tok];
        IDX[pos] = tok; *(u32x2*)(WSORT + 2 * pos) = (u32x2){__float_as_uint(WTOK[2 * tok]), __float_as_uint(WTOK[2 * tok + 1])}; RSORT[pos] = ((const float*)(F.ws + WS_RINV2))[tok]; }
    if (F.wg == 0) {
        float z = 0.f; asm volatile("" : "+v"(z));
        for (int b = 0; b < NBUCKET; ++b) for (int p = base[b] + tot[b] + F.tid; p < base[b + 1]; p += NTHREADS) { IDX[p] = -1; WSORT[2 * p] = z; WSORT[2 * p + 1] = z; RSORT[p] = z; }
        if (F.tid <= NBUCKET) ((int*)(F.ws + WS_BBASE))[F.tid] = base[F.tid];
    }
    __syncthreads();
}

__device__ __forceinline__ int build_tile_table(Frame& F, LAS int* tb) {
    const int* BB = (const int*)(F.ws + WS_BBASE);
    if (F.tid < 160) { const int r0 = F.tid * 256; int bkt = -1; for (int b = 0; b < NBUCKET; ++b) if (r0 >= BB[b] && r0 < BB[b + 1]) bkt = b; tb[1 + F.tid] = bkt; }
    if (F.tid == 0) tb[0] = BB[NBUCKET] / 256;
    __syncthreads();
    return tb[0];
}

typedef f32x4 AccT[2][2][4][2];
struct EpiZ1 { bf16* Z1; const float* rinv;
    __device__ __forceinline__ bool operator()(const AccT& acc, const pg8::Unit& u, int wr, int wc, int fr, int fq) const {
        asm volatile("" : "+v"(fr), "+v"(fq));
#pragma unroll
        for (int ai = 0; ai < 2; ++ai)
#pragma unroll
            for (int m = 0; m < 4; ++m) { const int row = u.pm * 256 + ai * 128 + wr * 64 + m * 16 + fr; const float ri = rinv[row]; bf16* rowp = Z1 + (size_t)row * ZC + u.pn * 256 + wc * 32 + 8 * fq;
#pragma unroll
                for (int bj = 0; bj < 2; ++bj) *(u32x4*)(rowp + bj * 128) = pack8(acc[ai][bj][m][0] * ri, acc[ai][bj][m][1] * ri); }
        return false; } };
__device__ __forceinline__ void p1_inproj_pg8(Frame& F, int l) {
    DenseSched S{(const char*)(F.ws + WS_XB), (const char*)(F.ws + WS_WINT) + (size_t)l * IN_COLS * D * 2, M / 256, ZC / 256, F.G, F.wg, D / 64, D * 2, D * 2};
    EpiZ1 E{(bf16*)(F.ws + WS_Z1), (const float*)(F.ws + WS_RINV1)};
    pg8::gemm_phase<EpiZ1, DenseSched, true, 0>(F.lds, S, E, F.tid);
    if (P0_LAYERS < DEPTH && l == 0 && F.wg >= 128) p0_weights(F, P0_LAYERS, DEPTH, (F.wg - 128) * NWAVES + F.wave, 128 * NWAVES);
}
struct EpiGlu { bf16* OS; const float* bg;
    __device__ __forceinline__ bool operator()(const AccT& acc, const pg8::Unit& u, int wr, int wc, int fr, int fq) const {
        asm volatile("" : "+v"(fr), "+v"(fq));
        const int col = u.pn * 128 + wc * 32 + 8 * fq;
        f32x4 bv[2], bgt[2];
#pragma unroll
        for (int n = 0; n < 2; ++n) { bv[n] = *(const f32x4*)(bg + col + 4 * n); bgt[n] = *(const f32x4*)(bg + 512 + col + 4 * n); }
#pragma unroll
        for (int ai = 0; ai < 2; ++ai)
#pragma unroll
            for (int m = 0; m < 4; ++m) { const int row = u.pm * 256 + ai * 128 + wr * 64 + m * 16 + fr; f32x4 o[2];
#pragma unroll
                for (int n = 0; n < 2; ++n) { const f32x4 v = acc[ai][0][m][n] + bv[n], g = acc[ai][1][m][n] + bgt[n];
#pragma unroll
                    for (int j = 0; j < 4; ++j) o[n][j] = v[j] * sigmoidf_(g[j]); }
                *(u32x4*)(OS + (size_t)row * BW + col) = pack8(o[0], o[1]); }
        return false; } };
__device__ __forceinline__ void p3a_glu_pg8(Frame& F, int l) {
    DenseSched S{(const char*)(F.ws + WS_YS), (const char*)(F.ws + WS_WGLUT) + (size_t)l * 1024 * BW * 2, M / 256, 4, F.G, F.wg, BW / 64, BW * 2, BW * 2};
    EpiGlu E{(bf16*)(F.ws + WS_OS), F.in[I_BGLU] + l * 1024};
    pg8::gemm_phase<EpiGlu, DenseSched, true, 0>(F.lds, S, E, F.tid);
}
struct EpiOut { const float* xin; float* X; bf16* XB;
    __device__ __forceinline__ bool operator()(const AccT& acc, const pg8::Unit& u, int wr, int wc, int fr, int fq) const {
        asm volatile("" : "+v"(fr), "+v"(fq));
#pragma unroll
        for (int ai = 0; ai < 2; ++ai) {
#pragma unroll
            for (int mp = 0; mp < 2; ++mp) {
                f32x4 xv[2][2][2];
#pragma unroll
                for (int mm = 0; mm < 2; ++mm) { const size_t row = u.pm * 256 + ai * 128 + wr * 64 + (2 * mp + mm) * 16 + fr;
#pragma unroll
                    for (int bj = 0; bj < 2; ++bj) { const size_t o = row * D + u.pn * 256 + bj * 128 + wc * 32 + 8 * fq; xv[mm][bj][0] = *(const f32x4*)(xin + o); xv[mm][bj][1] = *(const f32x4*)(xin + o + 4); } }
#pragma unroll
                for (int mm = 0; mm < 2; ++mm) { const int m = 2 * mp + mm; const size_t row = u.pm * 256 + ai * 128 + wr * 64 + m * 16 + fr;
#pragma unroll
                    for (int bj = 0; bj < 2; ++bj) { const size_t o = row * D + u.pn * 256 + bj * 128 + wc * 32 + 8 * fq;
                        const f32x4 v0 = xv[mm][bj][0] + acc[ai][bj][m][0], v1 = xv[mm][bj][1] + acc[ai][bj][m][1];
                        *(f32x4*)(X + o) = v0; *(f32x4*)(X + o + 4) = v1; *(u32x4*)(XB + o) = pack8(v0, v1); } }
                asm volatile("" ::: "memory"); } }
        return false; } };
__device__ __forceinline__ void p3c_outproj_pg8(Frame& F, int l) {
    DenseSched S{(const char*)(F.ws + WS_MIXED), (const char*)(F.ws + WS_WOUTT) + (size_t)l * D * D * 2, M / 256, 4, F.G, F.wg, D / 64, D * 2, D * 2};
    EpiOut E{(l == 0) ? F.in[I_X] : F.out, F.out, (bf16*)(F.ws + WS_XB)};
    pg8::gemm_phase<EpiOut, DenseSched, true, 0>(F.lds, S, E, F.tid);
}
struct MixSched { const char* XB; const char* WG; const char* WB; const char* ws; int G, c;
    __device__ __forceinline__ bool next(int i, pg8::Unit& u) const {
        const int sub = i % 6, L = (i / 6) * G + c; if (L >= 512) return false;
        pg8::static_tile(L, M / 256, 4, u.pm, u.pn); u.aux = sub; const int k = sub >> 1;
        if (!(sub & 1)) { u.A = XB + (size_t)u.pm * 256 * 2048; u.lda2 = 2048; u.nt = 16; u.B = WG + ((size_t)k * D + u.pn * 256) * 2048; u.ldb2 = 2048; }
        else { const char* br = ws + (k == 0 ? WS_OA : (k == 1 ? WS_OL : WS_OS)); u.A = br + (size_t)u.pm * 256 * 1024; u.lda2 = 1024; u.nt = 8; u.B = WB + ((size_t)k * D + u.pn * 256) * 1024; u.ldb2 = 1024; }
        return true; }
    __device__ __forceinline__ unsigned row_off(const pg8::Unit&, int) const { return 0u; }
};
struct EpiMix { u32x2* SIG; u32x4* MIXS; bf16* MX; const float* rinv;
    __device__ __forceinline__ bool operator()(const AccT& acc, const pg8::Unit& u, int wr, int wc, int fr, int fq) const {
        asm volatile("" : "+v"(fr), "+v"(fq));
        const int tid = (wr * 4 + wc) * 64 + fq * 16 + fr, sub = u.aux, k = sub >> 1;
        if (!(sub & 1)) {
            float ri[2][4];
#pragma unroll
            for (int ai = 0; ai < 2; ++ai)
#pragma unroll
                for (int m = 0; m < 4; ++m) ri[ai][m] = rinv[u.pm * 256 + ai * 128 + wr * 64 + m * 16 + fr];
#pragma unroll
            for (int ai = 0; ai < 2; ++ai)
#pragma unroll
                for (int m = 0; m < 4; ++m)
#pragma unroll
                    for (int bj = 0; bj < 2; ++bj) { unsigned q0 = 0u, q1 = 0u;
#pragma unroll
                        for (int j = 0; j < 4; ++j) { q0 |= (unsigned)__builtin_rintf(255.0f * sigmoidf_(acc[ai][bj][m][0][j] * ri[ai][m])) << (8 * j); q1 |= (unsigned)__builtin_rintf(255.0f * sigmoidf_(acc[ai][bj][m][1][j] * ri[ai][m])) << (8 * j); }
                        SIG[((ai * 4 + m) * 2 + bj) * 512 + tid] = (u32x2){q0, q1}; }
        } else {
#pragma unroll
            for (int ai = 0; ai < 2; ++ai)
#pragma unroll
            for (int mp = 0; mp < 2; ++mp) {
                u32x2 sv[2][2]; u32x4 mv[2][2];
#pragma unroll
                for (int mm = 0; mm < 2; ++mm)
#pragma unroll
                    for (int bj = 0; bj < 2; ++bj) { const int slot = ((ai * 4 + 2 * mp + mm) * 2 + bj) * 512 + tid; sv[mm][bj] = SIG[slot]; if (k > 0) mv[mm][bj] = MIXS[slot]; }
#pragma unroll
                for (int mm = 0; mm < 2; ++mm) { const int m = 2 * mp + mm; const size_t row = u.pm * 256 + ai * 128 + wr * 64 + m * 16 + fr;
#pragma unroll
                    for (int bj = 0; bj < 2; ++bj) { const int slot = ((ai * 4 + m) * 2 + bj) * 512 + tid; f32x4 s0, s1;
#pragma unroll
                        for (int j = 0; j < 4; ++j) { s0[j] = (float)((sv[mm][bj].x >> (8 * j)) & 255u) * (1.0f / 255.0f); s1[j] = (float)((sv[mm][bj].y >> (8 * j)) & 255u) * (1.0f / 255.0f); }
                        f32x4 v0 = acc[ai][bj][m][0] * s0, v1 = acc[ai][bj][m][1] * s1;
                        if (k > 0) { f32x4 p0, p1; unpack8(mv[mm][bj], p0, p1); v0 += p0; v1 += p1; }
                        if (k < 2) MIXS[slot] = pack8(v0, v1);
                        else *(u32x4*)(MX + row * D + u.pn * 256 + bj * 128 + wc * 32 + 8 * fq) = pack8(v0, v1); } }
                asm volatile("" ::: "memory"); }
        }
        return false; } };
__device__ __forceinline__ void p3b_mix_pg8(Frame& F, int l) {
    MixSched S{(const char*)(F.ws + WS_XB), (const char*)(F.ws + WS_WINT) + ((size_t)l * IN_COLS + COL_GATES) * D * 2, (const char*)(F.ws + WS_WBRT) + (size_t)l * 3 * D * BW * 2, (const char*)F.ws, F.G, F.wg};
    EpiMix E{(u32x2*)(F.ws + WS_P3BSCR + (size_t)F.wg * 262144), (u32x4*)(F.ws + WS_P3BSCR + (size_t)F.wg * 262144 + 131072), (bf16*)(F.ws + WS_MIXED), (const float*)(F.ws + WS_RINV1)};
    pg8::gemm_phase<EpiMix, MixSched, true, 0>(F.lds, S, E, F.tid);
}
struct Moe1Sched { const char* XB; const char* W13; const int* IDX; const LAS int* tb; int ntile, G, c;
    __device__ __forceinline__ bool next(int i, pg8::Unit& u) const {
        const int L = i * G + c; if (L >= ntile * 4) return false;
        u.pm = L >> 2; u.pn = L & 3; const int bucket = tb[1 + u.pm], g = bucket / 6; int pa, pb; pair_of(bucket % 6, pa, pb);
        u.aux = u.pn >> 1; const int e = g * 4 + (u.aux ? pb : pa);
        u.A = XB; u.lda2 = 2048; u.nt = 16; u.B = W13 + ((size_t)e * 512 + (u.pn & 1) * 256) * 2048; u.ldb2 = 2048; return true; }
    __device__ __forceinline__ unsigned row_off(const pg8::Unit& u, int r) const { int tok = IDX[u.pm * 256 + r]; tok = tok < 0 ? 0 : tok; return (unsigned)tok * 2048u; }
};
struct EpiMoe1 { bf16* HS; const float* WSORT; const float* RSORT;
    __device__ __forceinline__ bool operator()(const AccT& acc, const pg8::Unit& u, int wr, int wc, int fr, int fq) const {
        asm volatile("" : "+v"(fr), "+v"(fq));
        const int slot = u.aux, hcol = slot * 256 + (u.pn & 1) * 128 + wc * 32 + 8 * fq;
#pragma unroll
        for (int ai = 0; ai < 2; ++ai)
#pragma unroll
            for (int m = 0; m < 4; ++m) { const int row = u.pm * 256 + ai * 128 + wr * 64 + m * 16 + fr; const float wsel = WSORT[2 * row + slot], ri = RSORT[row]; f32x4 o[2];
#pragma unroll
                for (int n = 0; n < 2; ++n)
#pragma unroll
                    for (int j = 0; j < 4; ++j) { const float v1 = acc[ai][0][m][n][j] * ri, v3 = acc[ai][1][m][n][j] * ri; o[n][j] = v1 * sigmoidf_(v1) * v3 * wsel; }
                *(u32x4*)(HS + (size_t)row * 512 + hcol) = pack8(o[0], o[1]); }
        return false; } };
__device__ __forceinline__ void p4c_moe1_pg8(Frame& F, int l) {
    LAS int* tb = (LAS int*)(F.lds + TB_OFF);
    const int ntile = build_tile_table(F, tb);
    Moe1Sched S{(const char*)(F.ws + WS_XB), (const char*)(F.ws + WS_W13T) + (size_t)l * 16 * 512 * D * 2, (const int*)(F.ws + WS_IDX), tb, ntile, F.G, F.wg};
    EpiMoe1 E{(bf16*)(F.ws + WS_HS), (const float*)(F.ws + WS_WSORT), (const float*)(F.ws + WS_RSORT)};
    pg8::gemm_phase<EpiMoe1, Moe1Sched, true, 2>(F.lds, S, E, F.tid);
}
struct Moe2Sched { const char* HS; const char* W2; const LAS int* tb; int ntile, G, c;
    __device__ __forceinline__ bool next(int i, pg8::Unit& u) const {
        const int L = i * G + c; if (L >= ntile * 4) return false;
        u.pm = L >> 2; u.pn = L & 3; u.aux = 0; const int bucket = tb[1 + u.pm];
        u.A = HS + (size_t)u.pm * 256 * 1024; u.lda2 = 1024; u.nt = 8; u.B = W2 + ((size_t)bucket * D + u.pn * 256) * 1024; u.ldb2 = 1024; return true; }
    __device__ __forceinline__ unsigned row_off(const pg8::Unit&, int) const { return 0u; }
};
struct EpiMoe2 { float* X; bf16* XB; const int* IDX;
    __device__ __forceinline__ bool operator()(const AccT& acc, const pg8::Unit& u, int wr, int wc, int fr, int fq) const {
        asm volatile("" : "+v"(fr), "+v"(fq));
        int tk[2][4];
#pragma unroll
        for (int ai = 0; ai < 2; ++ai)
#pragma unroll
            for (int m = 0; m < 4; ++m) tk[ai][m] = IDX[u.pm * 256 + ai * 128 + wr * 64 + m * 16 + fr];
#pragma unroll
        for (int ai = 0; ai < 2; ++ai) {
#pragma unroll
            for (int mp = 0; mp < 2; ++mp) {
                f32x4 xv[2][2][2];
#pragma unroll
                for (int mm = 0; mm < 2; ++mm) { const int tok = tk[ai][2 * mp + mm]; const size_t rb = (size_t)(tok < 0 ? 0 : tok) * D + u.pn * 256 + wc * 32 + 8 * fq;
#pragma unroll
                    for (int bj = 0; bj < 2; ++bj) { xv[mm][bj][0] = *(const f32x4*)(X + rb + bj * 128); xv[mm][bj][1] = *(const f32x4*)(X + rb + bj * 128 + 4); } }
#pragma unroll
                for (int mm = 0; mm < 2; ++mm) { const int m = 2 * mp + mm, tok = tk[ai][m];
                    if (tok >= 0) { const size_t rb = (size_t)tok * D + u.pn * 256 + wc * 32 + 8 * fq;
#pragma unroll
                        for (int bj = 0; bj < 2; ++bj) { const f32x4 v0 = xv[mm][bj][0] + acc[ai][bj][m][0], v1 = xv[mm][bj][1] + acc[ai][bj][m][1];
                            *(f32x4*)(X + rb + bj * 128) = v0; *(f32x4*)(X + rb + bj * 128 + 4) = v1; *(u32x4*)(XB + rb + bj * 128) = pack8(v0, v1); } } }
                asm volatile("" ::: "memory"); } }
        return false; } };
__device__ __forceinline__ void p4d_moe2_pg8(Frame& F, int l) {
    LAS int* tb = (LAS int*)(F.lds + TB_OFF);
    const int ntile = build_tile_table(F, tb);
    Moe2Sched S{(const char*)(F.ws + WS_HS), (const char*)(F.ws + WS_W2TB) + (size_t)l * NBUCKET * D * 512 * 2, tb, ntile, F.G, F.wg};
    EpiMoe2 E{F.out, (bf16*)(F.ws + WS_XB), (const int*)(F.ws + WS_IDX)};
    pg8::gemm_phase<EpiMoe2, Moe2Sched, true, 0>(F.lds, S, E, F.tid);
}

__device__ __forceinline__ void p_rowstats(Frame& F) {
    const float* X = F.out; float* rinv = (float*)(F.ws + WS_RINV1);
    for (int m0 = 4 * F.gw; m0 < M; m0 += 4 * F.NGW) {
        f32x4 v[4][4];
#pragma unroll
        for (int a = 0; a < 4; ++a) { const f32x4* xr = (const f32x4*)(X + (size_t)(m0 + a) * D) + F.lane;
#pragma unroll
            for (int j = 0; j < 4; ++j) v[a][j] = xr[64 * j]; }
        float t[4];
#pragma unroll
        for (int a = 0; a < 4; ++a) { float s = 0.f;
#pragma unroll
            for (int j = 0; j < 4; ++j) s += (v[a][j].x * v[a][j].x + v[a][j].y * v[a][j].y) + (v[a][j].z * v[a][j].z + v[a][j].w * v[a][j].w);
            t[a] = wave_sum(s, F.lane); }
        if (F.lane < 4) { const float s = F.lane == 0 ? t[0] : (F.lane == 1 ? t[1] : (F.lane == 2 ? t[2] : t[3])); rinv[m0 + F.lane] = 1.0f / sqrtf(s * (1.0f / D) + NORM_EPS); }
    }
}
__device__ __forceinline__ void p_final_norm(Frame& F) {
    float* X = F.out;
    const f32x4* gp = (const f32x4*)F.in[I_FNG] + F.lane; f32x4 gv[4];
#pragma unroll
    for (int j = 0; j < 4; ++j) gv[j] = gp[64 * j];
    for (int m0 = 4 * F.gw; m0 < M; m0 += 4 * F.NGW) {
        f32x4 v[4][4];
#pragma unroll
        for (int a = 0; a < 4; ++a) { const f32x4* xr = (const f32x4*)(X + (size_t)(m0 + a) * D) + F.lane;
#pragma unroll
            for (int j = 0; j < 4; ++j) v[a][j] = xr[64 * j]; }
#pragma unroll
        for (int a = 0; a < 4; ++a) { float s = 0.f;
#pragma unroll
            for (int j = 0; j < 4; ++j) s += (v[a][j].x * v[a][j].x + v[a][j].y * v[a][j].y) + (v[a][j].z * v[a][j].z + v[a][j].w * v[a][j].w);
            s = wave_sum(s, F.lane); const float ri = 1.0f / sqrtf(s * (1.0f / D) + NORM_EPS);
            f32x4* xw = (f32x4*)(X + (size_t)(m0 + a) * D) + F.lane;
#pragma unroll
            for (int j = 0; j < 4; ++j) xw[64 * j] = v[a][j] * ri * gv[j]; }
    }
}

__device__ __forceinline__ bool fresh(Frame& F) {
    int t = threadIdx.x; asm volatile("" : "+v"(t));
    F.tid = t; F.lane = t & 63; F.wave = __builtin_amdgcn_readfirstlane(t >> 6); F.gw = F.wg * NWAVES + F.wave;
    const __attribute__((address_space(4))) Args* ap = (const __attribute__((address_space(4))) Args*)__builtin_amdgcn_kernarg_segment_ptr();
    asm volatile("" : "+s"(ap));
    F.in = ap->in; F.out = ap->out; F.ws = ap->ws;
    return true;
}
__global__ void __launch_bounds__(NTHREADS, 2) fwd(Args args) {
    extern __shared__ __attribute__((aligned(16))) unsigned char lds[];
    Frame F;
    F.lds = (LAS unsigned char*)lds;
    volatile LAS unsigned* MISC = (volatile LAS unsigned*)(F.lds + MISC_OFF);
    if (threadIdx.x < 32) MISC[threadIdx.x] = 0u;
    __syncthreads();
    F.tid = threadIdx.x; F.lane = F.tid & 63; F.wave = __builtin_amdgcn_readfirstlane(F.tid >> 6);
    F.wg = blockIdx.x; F.gw = F.wg * NWAVES + F.wave;
    F.in = nullptr; F.out = args.out; F.ws = args.ws;
    unsigned* ctl = (unsigned*)(F.ws + WS_CTL);
    XcdBarrier bar; bar.bar = ctl + CW_BAR; bar.x = 0; bar.st = nullptr;
    if (!MK_PER_PHASE) bar = xcd_barrier_post(ctl + CW_BAR, MISC + 8, F.tid == 0);
    const int lo = args.ph_lo, hi = args.ph_hi;
#define IN(k) (lo <= (k) && (k) < hi && fresh(F))
#define SEAM(k) do { if (IN(k) && IN((k) + 1)) xcd_barrier(bar, F.tid == 0); } while (0)

#ifndef DUP_MASK
#define DUP_MASK 0
#endif
#define RUN(k, body) do { int reps_ = 1 + ((DUP_MASK >> (k)) & 1); if (DUP_MASK) asm volatile("" : "+s"(reps_)); for (int rep_ = 0; rep_ < reps_; ++rep_) { body; if (DUP_MASK) __syncthreads(); } } while (0)
    if (IN(0)) { RUN(0, p0_prologue(F)); } SEAM(0);
    for (int l = 0; l < DEPTH; ++l) {
        const int pb = 1 + 10 * l;
        if (IN(pb + 0)) { RUN(1, p1_inproj_pg8(F, l)); } SEAM(pb + 0);
        if (IN(pb + 1)) { RUN(2, lru_mfma(F, l)); RUN(3, s5_mfma(F, l)); RUN(4, attn_mfma(F, l)); } SEAM(pb + 1);
        if (IN(pb + 2)) { RUN(5, p3a_glu_pg8(F, l)); } SEAM(pb + 2);
        if (IN(pb + 3)) { RUN(6, p3b_mix_pg8(F, l)); } SEAM(pb + 3);
        if (IN(pb + 4)) { p3c_outproj_pg8(F, l); } SEAM(pb + 4);
        if (IN(pb + 5)) { RUN(8, p4a_router(F, l)); } SEAM(pb + 5);
        if (IN(pb + 6)) { RUN(9, p4b_positions(F)); } SEAM(pb + 6);
        if (IN(pb + 7)) { RUN(10, p4c_moe1_pg8(F, l)); } SEAM(pb + 7);
        if (IN(pb + 8)) { p4d_moe2_pg8(F, l); } SEAM(pb + 8);
        if (IN(pb + 9)) { if (l == DEPTH - 1) p_final_norm(F); else { RUN(12, p_rowstats(F)); } }
        if (l < DEPTH - 1) SEAM(pb + 9);
    }
#undef IN
#undef SEAM
}

extern "C" void kernel_launch(void* const* d_in, const int* in_sizes, int n_in, void* d_out, int out_size, void* d_ws, size_t ws_size, hipStream_t stream) {
    static int grid = 0;
    if (grid == 0) {
        if (n_in != 32 || out_size != M * D || ws_size < WS_END) { fprintf(stderr, "kernel_launch: unexpected shapes (n_in %d, out %d, ws %zu)\n", n_in, out_size, ws_size); grid = -1; return; }
        if (hipFuncSetAttribute((const void*)fwd, hipFuncAttributeMaxDynamicSharedMemorySize, LDS_BYTES) != hipSuccess) { fprintf(stderr, "kernel_launch: hipFuncSetAttribute failed\n"); grid = -1; return; }
        int per_cu = 0;
        if (hipOccupancyMaxActiveBlocksPerMultiprocessor(&per_cu, (const void*)fwd, NTHREADS, LDS_BYTES) != hipSuccess || per_cu < 1) fprintf(stderr, "kernel_launch: occupancy query reports %d\n", per_cu);
        (void)hipGetLastError();
        grid = 256;
    }
    if (grid < 0) return;
    (void)hipMemsetAsync((char*)d_ws + WS_CTL, 0, CTL_ZERO_BYTES, stream);
    Args a{};
    for (int i = 0; i < 32; ++i) a.in[i] = (const float*)d_in[i];
    a.out = (float*)d_out; a.ws = (unsigned char*)d_ws; a.pad = 0;
#if MK_PER_PHASE
    for (int p = 0; p < NPHASE; ++p) { a.ph_lo = p; a.ph_hi = p + 1; a.li = p; hipLaunchKernelGGL(fwd, dim3(grid), dim3(NTHREADS), LDS_BYTES, stream, a); }
#else
    a.ph_lo = 0; a.ph_hi = NPHASE; a.li = 0;
    hipLaunchKernelGGL(fwd, dim3(grid), dim3(NTHREADS), LDS_BYTES, stream, a);
#endif
}
```

```cpp
#include <hip/hip_runtime.h>
#include <cstdio>
#include <cstdint>

#ifndef MK_PER_PHASE
#define MK_PER_PHASE 0
#endif

constexpr int D = 1024, BATCH = 16, SEQ = 2048, M = BATCH * SEQ, DEPTH = 2;
constexpr int NQ = 8, HD = 64, WIN = 128;
constexpr int BW = 512;
constexpr int ZC = 2304;
constexpr int IN_COLS = 5376;
constexpr int COL_Q = 0, COL_K = 512, COL_V = 640, COL_XR = 768, COL_GR = 1280, COL_U = 1792, COL_GATES = 2304;
constexpr int NBUCKET = 24;
constexpr int MS_MAX = (128 + NBUCKET) * 256;
constexpr float NORM_EPS = 1e-6f;
constexpr int NWAVES = 8, NTHREADS = 512;
constexpr int NPHASE = 21;

constexpr size_t MiB = 1u << 20;
constexpr size_t WS_CTL = 0, CTL_ZERO_BYTES = 1 * MiB;
constexpr size_t WS_RINV1 = 1 * MiB;
constexpr size_t WS_RINV2 = WS_RINV1 + 128 * 1024;
constexpr size_t WS_BUCKET = WS_RINV2 + 128 * 1024;
constexpr size_t WS_RANK = WS_BUCKET + 128 * 1024;
constexpr size_t WS_WTOK = WS_RANK + 128 * 1024;
constexpr size_t WS_HIST = WS_WTOK + 256 * 1024;
constexpr size_t WS_BBASE = WS_HIST + 32 * 1024;
constexpr size_t WS_IDX = WS_BBASE + 1024;
constexpr size_t WS_WSORT = WS_IDX + 160 * 1024;
constexpr size_t WS_RSORT = WS_WSORT + 320 * 1024;
constexpr size_t WS_S5TBL = 3 * MiB;
constexpr size_t WS_WRT = 5 * MiB;
constexpr size_t WS_LRUF = 7 * MiB;
constexpr size_t WS_WINT = 8 * MiB;
constexpr size_t WS_WGLUT = 29 * MiB;
constexpr size_t WS_WBRT = 31 * MiB;
constexpr size_t WS_WOUTT = 37 * MiB;
constexpr size_t WS_W13T = 41 * MiB;
constexpr size_t WS_W2TB = 73 * MiB;
constexpr size_t WS_S5MAT = 121 * MiB;
constexpr size_t WS_S5LAM = 6 * MiB;
constexpr size_t WS_XB = 145 * MiB;
constexpr size_t WS_Z1 = 209 * MiB;
constexpr size_t WS_MIXED = 209 * MiB;
constexpr size_t WS_HS = 273 * MiB;
constexpr size_t WS_OA = 353 * MiB, WS_OL = 385 * MiB, WS_YS = 417 * MiB, WS_OS = 449 * MiB;
constexpr size_t WS_END = 481 * MiB;
static_assert(WS_WSORT + (size_t)MS_MAX * 8 <= WS_RSORT && WS_RSORT + (size_t)MS_MAX * 4 <= WS_S5TBL, "small region");
constexpr size_t WS_P3BSCR = 273 * MiB;
constexpr int TB_OFF = 163840 - 2048;
static_assert(WS_Z1 + (size_t)M * ZC * 2 <= WS_OA, "z1");
static_assert(WS_HS + (size_t)MS_MAX * 512 * 2 <= WS_OA, "hs");

constexpr int CW_BAR = 4096;
constexpr int LDS_BYTES = 163840;
constexpr int MISC_OFF = 163840 - 256;

#define LAS __attribute__((address_space(3)))
typedef unsigned short bf16;
typedef short bf16x8 __attribute__((ext_vector_type(8)));
typedef float f32x4 __attribute__((ext_vector_type(4)));
typedef unsigned u32x4 __attribute__((ext_vector_type(4)));
typedef unsigned u32x2 __attribute__((ext_vector_type(2)));

__device__ __forceinline__ float bf2f(bf16 b) { return __uint_as_float(((unsigned)b) << 16); }
__device__ __forceinline__ unsigned f2bf(float f) { unsigned u = __float_as_uint(f); return (u + 0x7fffu + ((u >> 16) & 1u)) >> 16; }
__device__ __forceinline__ unsigned pk2(float lo, float hi) { return f2bf(lo) | (f2bf(hi) << 16); }
typedef __bf16 hwbf16x2 __attribute__((ext_vector_type(2)));
__device__ __forceinline__ unsigned pk2hw(float lo, float hi) { hwbf16x2 v; v.x = (__bf16)lo; v.y = (__bf16)hi; return __builtin_bit_cast(unsigned, v); }
__device__ __forceinline__ float sigmoidf_(float x) { return __builtin_amdgcn_rcpf(1.0f + __builtin_amdgcn_exp2f(-1.4426950408889634f * x)); }
__device__ __forceinline__ float gelu_tanh(float x) { return x * sigmoidf_(1.5957691216057308f * (x + 0.044715f * x * x * x)); }
template <int N> __device__ __forceinline__ float dpp_ror(float v) { return __int_as_float(__builtin_amdgcn_update_dpp(0, __float_as_int(v), 0x120 + N, 0xf, 0xf, false)); }
__device__ __forceinline__ float rlane(float v, int l) { return __int_as_float(__builtin_amdgcn_readlane(__float_as_int(v), l)); }
__device__ __forceinline__ float wave_sum(float v, int  ) {
    v += dpp_ror<8>(v); v += dpp_ror<4>(v); v += dpp_ror<2>(v); v += dpp_ror<1>(v);
    return (rlane(v, 0) + rlane(v, 16)) + (rlane(v, 32) + rlane(v, 48));
}
__device__ __forceinline__ float lane_xor(float v, int lane, int o) { return __int_as_float(__builtin_amdgcn_ds_bpermute((lane ^ o) << 2, __float_as_int(v))); }
#define LDS_WAIT() asm volatile("s_waitcnt lgkmcnt(0)" ::: "memory")

#define XB_TMO      128
#define XB_XCNT(j)  (256  + 64 * (j))
#define XB_XSUB(j)  (1280 + 64 * (j))
#define XB_XGEN(j)  (2304 + 64 * (j))
#define XB_TOP      3328
#define XB_TOPGEN   3392
#define XCD_BAR_WORDS 3456
#define XB_SPIN_CAP (1u << 20)
__device__ __forceinline__ unsigned xb_ld(unsigned* p)              { return __hip_atomic_load(p, __ATOMIC_RELAXED, __HIP_MEMORY_SCOPE_AGENT); }
__device__ __forceinline__ unsigned xb_add(unsigned* p, unsigned v) { return __hip_atomic_fetch_add(p, v, __ATOMIC_RELAXED, __HIP_MEMORY_SCOPE_AGENT); }
__device__ __forceinline__ unsigned xb_xcc_id() { return (unsigned)__builtin_amdgcn_s_getreg((3 << 11) | 20) & 0xFu; }
#define XB_SPIN(cond, bar) do { unsigned _sp = 0; while (cond) { __builtin_amdgcn_s_sleep(1); \
    if ((++_sp & 255u) == 0u) { if (xb_ld(&(bar)[XB_TMO])) break; if (_sp > XB_SPIN_CAP) { atomicAdd(&(bar)[XB_TMO], 1u); break; } } } } while (0)
struct XcdBarrier { unsigned* bar; unsigned x; volatile LAS unsigned* st; };
__device__ __forceinline__ XcdBarrier xcd_barrier_post(unsigned* bar, volatile LAS unsigned* st, bool leader) {
    XcdBarrier b; b.bar = bar; b.x = xb_xcc_id(); b.st = st;
    if (leader) (void)xb_add(&bar[XB_XCNT(b.x)], 1u);
    return b;
}
__device__ __forceinline__ void xcd_barrier_complete(unsigned* bar, unsigned x, unsigned& nloc, unsigned& nx) {
    const unsigned G = gridDim.x * gridDim.y * gridDim.z;
    unsigned sum, cnt, mine, sp = 0u;
    for (;;) {
        sum = 0u; cnt = 0u; mine = 0u;
#pragma unroll
        for (unsigned j = 0; j < 16; ++j) { const unsigned c = xb_ld(&bar[XB_XCNT(j)]); sum += c; cnt += (c > 0u) ? 1u : 0u; mine = (j == x) ? c : mine; }
        if (sum == G) break;
        __builtin_amdgcn_s_sleep(1);
        if ((++sp & 255u) == 0u) { if (xb_ld(&bar[XB_TMO])) break; if (sp > XB_SPIN_CAP) { atomicAdd(&bar[XB_TMO], 1u); break; } }
    }
    nloc = mine > 0u ? mine : 1u; nx = cnt > 0u ? cnt : 1u;
}
__device__ __forceinline__ void xcd_barrier(const XcdBarrier& b, bool leader) {
    asm volatile("s_waitcnt vmcnt(0)" ::: "memory");
    __syncthreads();
    if (leader) {
        unsigned* bar = b.bar;
        __builtin_amdgcn_s_waitcnt(0);
        unsigned nloc = b.st[0], nx = b.st[1];
        if (nloc == 0u) { xcd_barrier_complete(bar, b.x, nloc, nx); b.st[0] = nloc; b.st[1] = nx; }
        const unsigned old = xb_add(&bar[XB_XSUB(b.x)], 1u);
        const unsigned gen = old / nloc;
        if (old + 1u == (gen + 1u) * nloc) {
            __builtin_amdgcn_fence(__ATOMIC_RELEASE, "agent");
            asm volatile("s_waitcnt vmcnt(0)" ::: "memory");
            const unsigned og = xb_add(&bar[XB_TOP], 1u);
            const unsigned tg = og / nx;
            if (og + 1u == (tg + 1u) * nx) xb_add(&bar[XB_TOPGEN], 1u);
            else XB_SPIN(xb_ld(&bar[XB_TOPGEN]) == tg, bar);
            __builtin_amdgcn_fence(__ATOMIC_ACQUIRE, "agent");
            xb_add(&bar[XB_XGEN(b.x)], 1u);
            asm volatile("s_waitcnt vmcnt(0)" ::: "memory");
        } else {
            XB_SPIN(xb_ld(&bar[XB_XGEN(b.x)]) == gen, bar);
            __builtin_amdgcn_fence(__ATOMIC_ACQUIRE, "agent");
            asm volatile("s_waitcnt vmcnt(0)" ::: "memory");
        }
    }
    __syncthreads();
}

struct Args { const float* in[32]; float* out; unsigned char* ws; int ph_lo, ph_hi, li, pad; };
struct Frame {
    LAS unsigned char* lds;
    int tid, lane, wave, wg, gw;
    static constexpr int G = 256, NGW = 256 * NWAVES;
    const float* const __attribute__((address_space(4)))* in;
    float* out; unsigned char* ws;
};
enum { I_X = 0, I_N1G, I_WIN, I_SINK, I_CONVW, I_CONVB, I_LWR, I_LBR, I_LWI, I_LBI, I_LAM, I_ARE, I_AIM, I_LSTEP, I_BRE, I_BIM, I_CRE, I_CIM, I_SD, I_WGLU, I_BGLU,
       I_WBR, I_WOUT, I_N2G, I_WG, I_BG, I_WE, I_BE, I_W1, I_W3, I_W2, I_FNG };

__device__ __forceinline__ void pair_of(int p, int& a, int& b) {
    a = (p < 3) ? 0 : (p < 5 ? 1 : 2); b = (p < 3) ? p + 1 : (p < 5 ? p - 1 : 3);
}
__device__ __forceinline__ int pair_index(int a, int b) {
    return (a == 0) ? (b - 1) : (a == 1 ? (b + 1) : 5);
}


namespace pg8 {
typedef unsigned short bf16_t;
constexpr int BM = 256, BK = 64, HALF = 128, HTB = HALF * BK * 2, STAGE_BYTES = 8 * HTB, NXCD = 8, WGM = 8;
__host__ __device__ __forceinline__ int lds_byte(int r, int c) { const int st = (r >> 4) * 2 + (c >> 5), rr = r & 15, cc = c & 31, ob = rr * 64 + cc * 2; return st * 1024 + (ob ^ (((ob >> 9) & 1) << 5)); }
__host__ __device__ __forceinline__ void stage_rc(int b, int& R, int& C) { const int st = b / 1024, sb = b % 1024, swz = sb ^ (((sb >> 9) & 1) << 5); R = (st >> 1) * 16 + swz / 64; C = (st & 1) * 32 + (swz % 64) / 2; }
__host__ __device__ __forceinline__ int perm32(int rho) { const int n = rho >> 4, i = rho & 15; return 8 * (i >> 2) + 4 * n + (i & 3); }

struct Unit { int pm, pn, aux; int nt; unsigned lda2, ldb2; const char* A; const char* B; };

__device__ __forceinline__ void static_tile(int L, int nM, int nN, int& pm, int& pn) {
    const int nwg = nM * nN; int wgid = L; { const int q = nwg / NXCD, r = nwg % NXCD, xcd = wgid % NXCD, off = wgid / NXCD; wgid = (xcd < r ? xcd * (q + 1) : r * (q + 1) + (xcd - r) * q) + off; }
    const int nig = WGM * nN, gid = wgid / nig, fm = gid * WGM, gsz = (nM - fm) < WGM ? (nM - fm) : WGM;
    pm = fm + ((wgid % nig) % gsz); pn = (wgid % nig) / gsz;
}

template <class Epi, class Sched, bool ALIGN_EPI, int MODE>
__device__ __forceinline__ void gemm_phase(LAS unsigned char* lds, const Sched& S, const Epi& E, int tid) {
    const int wid = __builtin_amdgcn_readfirstlane(tid >> 6), lane = tid & 63, wr = wid >> 2, wc = wid & 3, fr = lane & 15, fq = lane >> 4;
    unsigned RA[2], C2[2];
#pragma unroll
    for (int i = 0; i < 2; ++i) { int R, C; stage_rc(tid * 16 + i * 8192, R, C); RA[i] = (unsigned)R; C2[i] = (unsigned)C * 2u; }
    const unsigned ldsw = (unsigned)wid * 1024u;
    const int aoff = lds_byte(wr * 64 + fr, fq * 8), boff = lds_byte(wc * 32 + fr, fq * 8);
#define PG8_SA(b, h) (((b) * 2 + (h)) * HTB)
#define PG8_SB(b, h) ((4 + (b) * 2 + (h)) * HTB)
#define PG8_STAGE_A(bufoff, gbase, h, ld2, go) do { _Pragma("unroll") for (int _i = 0; _i < 2; ++_i) { \
        const unsigned _vo = (MODE == 2) ? ((go)[h][_i] + C2[_i]) : ((RA[_i] + 128u * (h)) * (ld2) + C2[_i]); \
        __builtin_amdgcn_global_load_lds((const unsigned*)((gbase) + _vo), (LAS unsigned*)(lds + (bufoff) + ldsw + _i * 8192), 16, 0, 0); } } while (0)
#define PG8_STAGE_B(bufoff, gbase, h, ld2) do { _Pragma("unroll") for (int _i = 0; _i < 2; ++_i) { \
        const unsigned _vo = (((RA[_i] & ~31u) + (unsigned)perm32((int)(RA[_i] & 31u))) + 128u * (h)) * (ld2) + C2[_i]; \
        __builtin_amdgcn_global_load_lds((const unsigned*)((gbase) + _vo), (LAS unsigned*)(lds + (bufoff) + ldsw + _i * 8192), 16, 0, 0); } } while (0)
#define PG8_LDA(dst, b, h) do { _Pragma("unroll") for (int m = 0; m < 4; ++m) _Pragma("unroll") for (int k = 0; k < 2; ++k) dst[m][k] = *(const LAS bf16x8*)(lds + PG8_SA(b, h) + aoff + m * 2048 + k * 1024); } while (0)
#define PG8_LDB(dst, b, h) do { _Pragma("unroll") for (int n = 0; n < 2; ++n) _Pragma("unroll") for (int k = 0; k < 2; ++k) dst[n][k] = *(const LAS bf16x8*)(lds + PG8_SB(b, h) + boff + n * 2048 + k * 1024); } while (0)
#define PG8_MMA(ai, bj, At, Bt) do { __builtin_amdgcn_s_setprio(1); _Pragma("unroll") for (int m = 0; m < 4; ++m) _Pragma("unroll") for (int n = 0; n < 2; ++n) _Pragma("unroll") for (int k = 0; k < 2; ++k) \
        acc[ai][bj][m][n] = __builtin_amdgcn_mfma_f32_16x16x32_bf16(Bt[n][k], At[m][k], acc[ai][bj][m][n], 0, 0, 0); __builtin_amdgcn_s_setprio(0); } while (0)
#define PG8_WAIT_V(n) asm volatile("s_waitcnt vmcnt(" #n ")" ::: "memory")
#define PG8_WAIT_L(n) asm volatile("s_waitcnt lgkmcnt(" #n ")" ::: "memory")
#define PG8_BAR __builtin_amdgcn_s_barrier()
#define PG8_SCHED __builtin_amdgcn_sched_barrier(0)
    Unit cur, nxt; int ui = 0;
    if (!S.next(0, cur)) return;
    f32x4 acc[2][2][4][2];
#pragma unroll
    for (int a = 0; a < 2; ++a)
#pragma unroll
        for (int b = 0; b < 2; ++b)
#pragma unroll
            for (int m = 0; m < 4; ++m)
#pragma unroll
                for (int n = 0; n < 2; ++n) acc[a][b][m][n] = (f32x4){0.f, 0.f, 0.f, 0.f};
    bf16x8 At[4][2], B0[2][2], B1[2][2];
    unsigned cgo[2][2] = {{0u, 0u}, {0u, 0u}}, ngo[2][2] = {{0u, 0u}, {0u, 0u}};
    if (MODE == 2) {
#pragma unroll
        for (int h = 0; h < 2; ++h)
#pragma unroll
            for (int i = 0; i < 2; ++i) cgo[h][i] = S.row_off(cur, h * 128 + (int)RA[i]);
    }
    const size_t kstep = (size_t)(BK * 2);
    const char* cA = cur.A; const char* cB = cur.B;
    PG8_STAGE_B(PG8_SB(0, 0), cB, 0, cur.ldb2); PG8_STAGE_B(PG8_SB(0, 1), cB, 1, cur.ldb2); PG8_STAGE_A(PG8_SA(0, 0), cA, 0, cur.lda2, cgo); PG8_STAGE_A(PG8_SA(0, 1), cA, 1, cur.lda2, cgo);
    if (wr == 1) PG8_BAR;
    PG8_WAIT_V(2); PG8_BAR;
    PG8_STAGE_B(PG8_SB(1, 0), cB + kstep, 0, cur.ldb2); PG8_STAGE_A(PG8_SA(1, 0), cA + kstep, 0, cur.lda2, cgo); PG8_STAGE_B(PG8_SB(1, 1), cB + kstep, 1, cur.ldb2);
    PG8_WAIT_V(6); PG8_BAR;
    for (;;) {
        const bool has_next = S.next(ui + 1, nxt);
        if (!has_next) nxt = cur;
        if (MODE == 2) {
#pragma unroll
            for (int h = 0; h < 2; ++h)
#pragma unroll
                for (int i = 0; i < 2; ++i) ngo[h][i] = has_next ? S.row_off(nxt, h * 128 + (int)RA[i]) : cgo[h][i];
        }
        const char* nA = nxt.A; const char* nB = nxt.B;
        const int nt = cur.nt;
        for (int t = 0; t < nt; t += 2) {
            const bool last = (t == nt - 2);
            const char* a1 = cA + (size_t)(t + 1) * kstep;
            const char* a2 = last ? nA : cA + (size_t)(t + 2) * kstep; const char* b2 = last ? nB : cB + (size_t)(t + 2) * kstep;
            const char* a3 = a2 + kstep; const char* b3 = b2 + kstep;
            const unsigned la2 = last ? nxt.lda2 : cur.lda2, lb2 = last ? nxt.ldb2 : cur.ldb2;
            unsigned go2[2][2];
#pragma unroll
            for (int h = 0; h < 2; ++h)
#pragma unroll
                for (int i = 0; i < 2; ++i) go2[h][i] = last ? ngo[h][i] : cgo[h][i];
            PG8_LDB(B0, 0, 0); PG8_LDB(B1, 0, 1); PG8_SCHED; PG8_LDA(At, 0, 0); PG8_STAGE_A(PG8_SA(1, 1), a1, 1, cur.lda2, cgo);
            PG8_WAIT_V(8); PG8_WAIT_L(0); PG8_BAR; PG8_MMA(0, 0, At, B0); PG8_MMA(0, 1, At, B1); PG8_BAR; PG8_SCHED;
            PG8_LDA(At, 0, 1); PG8_STAGE_B(PG8_SB(0, 0), b2, 0, lb2); PG8_STAGE_B(PG8_SB(0, 1), b2, 1, lb2); PG8_STAGE_A(PG8_SA(0, 0), a2, 0, la2, go2);
            PG8_WAIT_V(8); PG8_WAIT_L(0); PG8_BAR; PG8_MMA(1, 0, At, B0); PG8_MMA(1, 1, At, B1); PG8_BAR; PG8_SCHED;
            PG8_LDB(B0, 1, 0); PG8_LDB(B1, 1, 1); PG8_SCHED; PG8_LDA(At, 1, 0); PG8_STAGE_A(PG8_SA(0, 1), a2, 1, la2, go2);
            PG8_WAIT_V(8); PG8_WAIT_L(0); PG8_BAR; PG8_MMA(0, 0, At, B0); PG8_MMA(0, 1, At, B1); PG8_BAR; PG8_SCHED;
            PG8_LDA(At, 1, 1); PG8_STAGE_B(PG8_SB(1, 0), b3, 0, lb2); PG8_STAGE_B(PG8_SB(1, 1), b3, 1, lb2); PG8_STAGE_A(PG8_SA(1, 0), a3, 0, la2, go2);
            PG8_WAIT_V(8); PG8_WAIT_L(0); PG8_BAR; PG8_MMA(1, 0, At, B0); PG8_MMA(1, 1, At, B1); PG8_BAR; PG8_SCHED;
        }
        if constexpr (ALIGN_EPI) { if (wr == 0) PG8_BAR; }
        const bool keep = E(acc, cur, wr, wc, fr, fq);
        if (!has_next) break;
        if (!keep) {
#pragma unroll
            for (int a = 0; a < 2; ++a)
#pragma unroll
                for (int b = 0; b < 2; ++b)
#pragma unroll
                    for (int m = 0; m < 4; ++m)
#pragma unroll
                        for (int n = 0; n < 2; ++n) acc[a][b][m][n] = (f32x4){0.f, 0.f, 0.f, 0.f};
        }
        cur = nxt; cA = nA; cB = nB; ++ui;
        if (MODE == 2) {
#pragma unroll
            for (int h = 0; h < 2; ++h)
#pragma unroll
                for (int i = 0; i < 2; ++i) cgo[h][i] = ngo[h][i];
        }
        if constexpr (ALIGN_EPI) { if (wr == 1) PG8_BAR; }
    }
    PG8_WAIT_V(0);
    if constexpr (!ALIGN_EPI) { if (wr == 0) PG8_BAR; }
    PG8_BAR;
#undef PG8_SA
#undef PG8_SB
#undef PG8_STAGE_A
#undef PG8_STAGE_B
#undef PG8_LDA
#undef PG8_LDB
#undef PG8_MMA
#undef PG8_WAIT_V
#undef PG8_WAIT_L
#undef PG8_BAR
#undef PG8_SCHED
}
}

__device__ __forceinline__ unsigned cvt_pk_bf16(float lo, float hi) { unsigned r; asm volatile("v_cvt_pk_bf16_f32 %0, %1, %2" : "=v"(r) : "v"(lo), "v"(hi)); return r; }
__device__ __forceinline__ u32x4 pack8(const f32x4& v0, const f32x4& v1) { u32x4 w; w.x = cvt_pk_bf16(v0[0], v0[1]); w.y = cvt_pk_bf16(v0[2], v0[3]); w.z = cvt_pk_bf16(v1[0], v1[1]); w.w = cvt_pk_bf16(v1[2], v1[3]); return w; }
__device__ __forceinline__ void unpack8(const u32x4& w, f32x4& v0, f32x4& v1) {
    v0[0] = __uint_as_float(w.x << 16); v0[1] = __uint_as_float(w.x & 0xffff0000u); v0[2] = __uint_as_float(w.y << 16); v0[3] = __uint_as_float(w.y & 0xffff0000u);
    v1[0] = __uint_as_float(w.z << 16); v1[1] = __uint_as_float(w.z & 0xffff0000u); v1[2] = __uint_as_float(w.w << 16); v1[3] = __uint_as_float(w.w & 0xffff0000u); }

struct DenseSched {
    const char* A; const char* B; int nM, nN, G, c, nt; unsigned lda2, ldb2;
    __device__ __forceinline__ bool next(int i, pg8::Unit& u) const {
        const int L = i * G + c; if (L >= nM * nN) return false;
        pg8::static_tile(L, nM, nN, u.pm, u.pn); u.aux = 0; u.nt = nt; u.lda2 = lda2; u.ldb2 = ldb2;
        u.A = A + (size_t)u.pm * 256 * lda2; u.B = B + (size_t)u.pn * 256 * ldb2; return true;
    }
    __device__ __forceinline__ unsigned row_off(const pg8::Unit&, int) const { return 0u; }
};

template <int MAP>
__device__ __forceinline__ int rowmap(int n) { if (MAP == 0) return n; return (n >> 7) * 256 + (n & 127) + (MAP == 2 ? 128 : 0); }
template <int MAP>
__device__ __forceinline__ void transpose_item(const float* W, int N, int ncol0, const float* gain, bf16* dst, int dld, int dcol0, LAS float* scr, int kb, int nb, int lane) {
    const int k0 = 64 * kb, n0 = 32 * nb;
    float tv_[32];
#pragma unroll
    for (int i = 0; i < 32; ++i) tv_[i] = W[(size_t)(k0 + 2 * i + (lane >> 5)) * N + ncol0 + n0 + (lane & 31)];
    if (gain) {
#pragma unroll
        for (int i = 0; i < 32; ++i) tv_[i] *= gain[k0 + 2 * i + (lane >> 5)];
    }
#pragma unroll
    for (int i = 0; i < 32; ++i) scr[(2 * i + (lane >> 5)) * 33 + (lane & 31)] = tv_[i];
    LDS_WAIT();
    const int c = lane & 7;
#pragma unroll
    for (int j = 0; j < 4; ++j) { const int n = (lane >> 3) + 8 * j; const LAS float* s = scr + (8 * c) * 33 + n;
        u32x4 o; o.x = pk2(s[0 * 33], s[1 * 33]); o.y = pk2(s[2 * 33], s[3 * 33]); o.z = pk2(s[4 * 33], s[5 * 33]); o.w = pk2(s[6 * 33], s[7 * 33]);
        *(u32x4*)(dst + (size_t)rowmap<MAP>(n0 + n) * dld + dcol0 + k0 + 8 * c) = o; }
    LDS_WAIT();
}

__device__ __forceinline__ void s5_setup_item(Frame& F, int l, int g);
#ifndef P0_LAYERS
#define P0_LAYERS 1
#endif
__device__ __forceinline__ void p0_weights(Frame& F, int l0, int l1, int worker, int nworkers) {
    LAS float* scr = (LAS float*)(F.lds + F.wave * 16384);
    unsigned char* ws = F.ws;
    constexpr int IT_WIN = 16 * 168, IT_GLU = 8 * 16 * 2, IT_BR = 3 * 8 * 32, IT_OUT = 16 * 32, IT_W13 = 16 * 2 * 16 * 8, IT_W2 = 48 * 4 * 32;
    constexpr int IT_LAYER = IT_WIN + IT_GLU + IT_BR + IT_OUT + IT_W13 + IT_W2;
    for (int it = l0 * IT_LAYER + worker; it < l1 * IT_LAYER; it += nworkers) {
        const int l = it / IT_LAYER; int r = it % IT_LAYER;
        if (r < IT_WIN) { transpose_item<0>(F.in[I_WIN] + (size_t)l * D * IN_COLS, IN_COLS, 0, F.in[I_N1G] + l * D, (bf16*)(ws + WS_WINT) + (size_t)l * IN_COLS * D, D, 0, scr, r / 168, r % 168, F.lane); continue; }
        r -= IT_WIN;
        if (r < IT_GLU) { const int half = r / (8 * 16); const int q = r % (8 * 16);
            const float* W = F.in[I_WGLU] + (size_t)l * BW * 1024; bf16* dst = (bf16*)(ws + WS_WGLUT) + (size_t)l * 1024 * BW;
            if (half == 0) transpose_item<1>(W, 1024, 0, nullptr, dst, BW, 0, scr, q / 16, q % 16, F.lane);
            else           transpose_item<2>(W, 1024, 512, nullptr, dst, BW, 0, scr, q / 16, q % 16, F.lane);
            continue; }
        r -= IT_GLU;
        if (r < IT_BR) { const int k = r / 256, q = r % 256; transpose_item<0>(F.in[I_WBR] + ((size_t)l * 3 + k) * BW * D, D, 0, nullptr, (bf16*)(ws + WS_WBRT) + ((size_t)l * 3 + k) * D * BW, BW, 0, scr, q / 32, q % 32, F.lane); continue; }
        r -= IT_BR;
        if (r < IT_OUT) { transpose_item<0>(F.in[I_WOUT] + (size_t)l * D * D, D, 0, nullptr, (bf16*)(ws + WS_WOUTT) + (size_t)l * D * D, D, 0, scr, r / 32, r % 32, F.lane); continue; }
        r -= IT_OUT;
        if (r < IT_W13) { const int ge = r / 256, q = r % 256, which = q / 128, qq = q % 128;
            const float* W = F.in[which ? I_W3 : I_W1] + ((size_t)l * 16 + ge) * D * 256; bf16* dst = (bf16*)(ws + WS_W13T) + ((size_t)l * 16 + ge) * 512 * D;
            if (which == 0) transpose_item<1>(W, 256, 0, F.in[I_N2G] + l * D, dst, D, 0, scr, qq / 8, qq % 8, F.lane);
            else            transpose_item<2>(W, 256, 0, F.in[I_N2G] + l * D, dst, D, 0, scr, qq / 8, qq % 8, F.lane);
            continue; }
        r -= IT_W13;
        { const int bs = r / 128, q = r % 128, bucket = bs >> 1, slot = bs & 1, g = bucket / 6; int pa, pb; pair_of(bucket % 6, pa, pb);
          const int e = g * 4 + (slot ? pb : pa);
          transpose_item<0>(F.in[I_W2] + ((size_t)l * 16 + e) * 256 * D, D, 0, nullptr, (bf16*)(ws + WS_W2TB) + ((size_t)l * NBUCKET + bucket) * D * 512, 512, slot * 256, scr, q / 32, q % 32, F.lane); }
    }
}
__device__ __forceinline__ void p0_prologue(Frame& F) {
    LAS float* scr = (LAS float*)(F.lds + F.wave * 16384);
    unsigned char* ws = F.ws;
    if (F.wg < DEPTH * 32) { s5_setup_item(F, F.wg >> 5, F.wg & 31); return; }
    const int gwx = (F.wg - DEPTH * 32) * NWAVES + F.wave; constexpr int NGX = (256 - DEPTH * 32) * NWAVES;
    p0_weights(F, 0, P0_LAYERS, gwx, NGX);
    {
        const float* x = F.in[I_X]; bf16* XB = (bf16*)(ws + WS_XB); float* rinv = (float*)(ws + WS_RINV1);
        for (int m0 = 4 * gwx; m0 < M; m0 += 4 * NGX) {
            f32x4 v[4][4]; float s4[4];
#pragma unroll
            for (int a = 0; a < 4; ++a) { const f32x4* xr = (const f32x4*)(x + (size_t)(m0 + a) * D) + F.lane;
#pragma unroll
                for (int j = 0; j < 4; ++j) v[a][j] = xr[64 * j]; }
#pragma unroll
            for (int a = 0; a < 4; ++a) { float s = 0.f;
#pragma unroll
                for (int j = 0; j < 4; ++j) s += (v[a][j].x * v[a][j].x + v[a][j].y * v[a][j].y) + (v[a][j].z * v[a][j].z + v[a][j].w * v[a][j].w);
                s4[a] = wave_sum(s, F.lane);
                u32x2* o = (u32x2*)(XB + (size_t)(m0 + a) * D) + F.lane;
#pragma unroll
                for (int j = 0; j < 4; ++j) { u32x2 w; w.x = pk2(v[a][j].x, v[a][j].y); w.y = pk2(v[a][j].z, v[a][j].w); o[64 * j] = w; } }
            if (F.lane < 4) { const float s = F.lane == 0 ? s4[0] : (F.lane == 1 ? s4[1] : (F.lane == 2 ? s4[2] : s4[3])); rinv[m0 + F.lane] = 1.0f / sqrtf(s * (1.0f / D) + NORM_EPS); }
        }
    }
    {
        bf16* lf = (bf16*)(ws + WS_LRUF);
        for (int i = gwx * 64 + F.lane; i < DEPTH * 2 * 8 * 2 * 2 * 4 * 64; i += NGX * 64) {
            const int ln = i & 63, ks = (i >> 6) & 3, gate = (i >> 8) & 1, nh = (i >> 9) & 1, hb = (i >> 10) & 7, ld = i >> 13;
            const float* W = F.in[gate ? I_LWI : I_LWR] + ((size_t)ld * 8 + hb) * 4096 + nh * 32 + (ln & 31);
            const int k0 = 16 * ks + 8 * (ln >> 5);
            u32x4 o; o.x = pk2(W[(size_t)(k0 + 0) * 64], W[(size_t)(k0 + 1) * 64]); o.y = pk2(W[(size_t)(k0 + 2) * 64], W[(size_t)(k0 + 3) * 64]);
            o.z = pk2(W[(size_t)(k0 + 4) * 64], W[(size_t)(k0 + 5) * 64]); o.w = pk2(W[(size_t)(k0 + 6) * 64], W[(size_t)(k0 + 7) * 64]);
            *(u32x4*)(lf + (size_t)i * 8) = o;
        }
    }
    {
        float* wrt = (float*)(ws + WS_WRT);
        for (int i = gwx * 64 + F.lane; i < DEPTH * 20 * D; i += NGX * 64) {
            const int k = i % D, j = (i / D) % 20, l = i / (20 * D);
            const float g2 = F.in[I_N2G][l * D + k];
            wrt[i] = g2 * (j < 4 ? F.in[I_WG][((size_t)l * D + k) * 4 + j] : F.in[I_WE][((size_t)l * D + k) * 16 + (j - 4)]);
        }
    }
}

typedef float f32x16 __attribute__((ext_vector_type(16)));
#define MFMA32(a, b, c) __builtin_amdgcn_mfma_f32_32x32x16_bf16((a), (b), (c), 0, 0, 0)
constexpr int S5_ETAB = 0, S5_UIMG = 8192, S5_HIMG = 8192 + 67584, S5_CSTR = 528;

__device__ __forceinline__ void s5_setup_item(Frame& F, int l, int g) {
    LAS float* PW = (LAS float*)F.lds;
    LAS float* BB = PW + 4352;
    LAS float* CC = BB + 4096;
    LAS float* KT = CC + 2048;
    const int tid = F.tid;
    __syncthreads();
    for (int idx = tid; idx < 2 * 64 * 17; idx += NTHREADS) {
        const int d = idx / 1088, rem = idx % 1088, n = rem / 17, j = rem % 17, ld = l * 2 + d;
        const float are = F.in[I_ARE][(size_t)ld * 2048 + g * 64 + n], aim = F.in[I_AIM][(size_t)ld * 2048 + g * 64 + n];
        const float step = expf(F.in[I_LSTEP][ld * 32 + g]);
        const double ang1 = (double)aim * (double)step, lm1 = (double)are * (double)step;
        const double a = fmod(ang1 * j, 6.283185307179586); float sn, cs; sincosf((float)a, &sn, &cs); const float mg = expf((float)(lm1 * j));
        PW[((d * 64 + n) * 17 + j) * 2] = mg * cs; PW[((d * 64 + n) * 17 + j) * 2 + 1] = mg * sn;
    }
    if (tid < 128) {
        const int d = tid >> 6, n = tid & 63, ld = l * 2 + d;
        const float are = F.in[I_ARE][(size_t)ld * 2048 + g * 64 + n], aim = F.in[I_AIM][(size_t)ld * 2048 + g * 64 + n];
        const float step = expf(F.in[I_LSTEP][ld * 32 + g]);
        const double ang1 = (double)aim * (double)step, lm1 = (double)are * (double)step;
        float abr, abi;
        { const double a = fmod(ang1 * 1, 6.283185307179586); float sn, cs; sincosf((float)a, &sn, &cs); const float mg = expf((float)(lm1 * 1)); abr = mg * cs; abi = mg * sn; }
        { float* lam = (float*)(F.ws + WS_S5LAM) + ((((size_t)l * 32 + g) * 2 + d) * 64 + n) * 4;
          const double a16 = fmod(ang1 * 16.0, 6.283185307179586), a256 = fmod(ang1 * 256.0, 6.283185307179586); float sn, cs;
          sincosf((float)a16, &sn, &cs); const float m16 = expf((float)(lm1 * 16.0)); lam[0] = m16 * cs; lam[1] = m16 * sn;
          sincosf((float)a256, &sn, &cs); const float m256 = expf((float)(lm1 * 256.0)); lam[2] = m256 * cs; lam[3] = m256 * sn; }
        const float den = are * are + aim * aim, nr = abr - 1.0f;
        const float sr = (nr * are + abi * aim) / den, si = (abi * are - nr * aim) / den;
        const float* bre = F.in[I_BRE] + ((size_t)ld * 2048 + g * 64 + n) * 16; const float* bim = F.in[I_BIM] + ((size_t)ld * 2048 + g * 64 + n) * 16;
        for (int c = 0; c < 16; ++c) { BB[((d * 64 + n) * 16 + c) * 2] = sr * bre[c] - si * bim[c]; BB[((d * 64 + n) * 16 + c) * 2 + 1] = sr * bim[c] + si * bre[c]; }
    }
    for (int i = tid; i < 1024; i += NTHREADS) { CC[i * 2] = F.in[I_CRE][((size_t)l * 32 + g) * 1024 + i]; CC[i * 2 + 1] = F.in[I_CIM][((size_t)l * 32 + g) * 1024 + i]; }
    __syncthreads();
    {
        const int cp = tid & 15, dl = (tid >> 4) & 15, d = tid >> 8; float acc[16];
#pragma unroll
        for (int c = 0; c < 16; ++c) acc[c] = 0.f;
#pragma unroll 2
        for (int n = 0; n < 64; ++n) { const float cr = CC[(cp * 64 + n) * 2], ci = CC[(cp * 64 + n) * 2 + 1], pr = PW[((d * 64 + n) * 17 + dl) * 2], pi = PW[((d * 64 + n) * 17 + dl) * 2 + 1];
            const float gr = cr * pr - ci * pi, gi = cr * pi + ci * pr;
#pragma unroll
            for (int c = 0; c < 16; ++c) { const float br = BB[((d * 64 + n) * 16 + c) * 2], bi = BB[((d * 64 + n) * 16 + c) * 2 + 1]; acc[c] += gr * br - gi * bi; } }
#pragma unroll
        for (int c = 0; c < 16; ++c) KT[((d * 16 + dl) * 16 + cp) * 16 + c] = acc[c];
    }
    __syncthreads();
    bf16* WsF = (bf16*)(F.ws + WS_S5MAT) + ((size_t)l * 32 + g) * 196608; bf16* W3F = WsF + 65536;
    for (int q = tid; q < 8192; q += NTHREADS) {
        const int row = q >> 5, kc = (q & 31) * 8, s_ = kc >> 4, c0 = kc & 15;
        const int nn = row & 31, ri = (row >> 5) & 1, sh = (row >> 6) & 1, d = row >> 7, n = sh * 32 + nn, e = d ? s_ : 15 - s_;
        const float pr = PW[((d * 64 + n) * 17 + e) * 2], pi = PW[((d * 64 + n) * 17 + e) * 2 + 1]; float v[8];
#pragma unroll
        for (int j = 0; j < 8; ++j) { const float br = BB[((d * 64 + n) * 16 + c0 + j) * 2], bi = BB[((d * 64 + n) * 16 + c0 + j) * 2 + 1]; v[j] = ri ? (pr * bi + pi * br) : (pr * br - pi * bi); }
        u32x4 o; o.x = pk2(v[0], v[1]); o.y = pk2(v[2], v[3]); o.z = pk2(v[4], v[5]); o.w = pk2(v[6], v[7]);
        const int tile = row >> 5, ks = kc >> 4, ln = (row & 31) + 32 * ((kc >> 3) & 1);
        *(u32x4*)(WsF + ((size_t)(tile * 16 + ks) * 64 + ln) * 8) = o;
    }
    const float* dsk = F.in[I_SD] + l * BW + g * 16;
    for (int q = tid; q < 16384; q += NTHREADS) {
        const int row = q >> 6, kc = (q & 63) * 8, tau = row >> 4, cp = row & 15; float v[8];
        if (kc < 256) { const int s_ = kc >> 4, c0 = kc & 15;
#pragma unroll
            for (int j = 0; j < 8; ++j) { float m = 0.f; if (s_ <= tau) m += KT[((0 * 16 + (tau - s_)) * 16 + cp) * 16 + c0 + j]; if (s_ >= tau) m += KT[((1 * 16 + (s_ - tau)) * 16 + cp) * 16 + c0 + j];
                if (s_ == tau && c0 + j == cp) m += dsk[cp]; v[j] = m; }
        } else {
#pragma unroll
            for (int j = 0; j < 8; ++j) { const int kh = kc - 256 + j, d = kh >> 7, n = (kh & 127) >> 1, ri = kh & 1, p = d ? 16 - tau : tau + 1;
                const float cr = CC[(cp * 64 + n) * 2], ci = CC[(cp * 64 + n) * 2 + 1], pr = PW[((d * 64 + n) * 17 + p) * 2], pi = PW[((d * 64 + n) * 17 + p) * 2 + 1];
                v[j] = ri ? -(cr * pi + ci * pr) : (cr * pr - ci * pi); }
        }
        u32x4 o; o.x = pk2(v[0], v[1]); o.y = pk2(v[2], v[3]); o.z = pk2(v[4], v[5]); o.w = pk2(v[6], v[7]);
        const int tile = row >> 5, ks = kc >> 4, ln = (row & 31) + 32 * ((kc >> 3) & 1);
        *(u32x4*)(W3F + ((size_t)(tile * 32 + ks) * 64 + ln) * 8) = o;
    }
}


__device__ __forceinline__ void s5_scan_a(f32x16& re, f32x16& im, float Lr, float Li, LAS float* e) {
#pragma unroll
    for (int i = 1; i < 16; ++i) { const float pr = re[i - 1], pi = im[i - 1]; re[i] += Lr * pr - Li * pi; im[i] += Lr * pi + Li * pr; }
    e[0] = re[15]; e[1] = im[15];
}
__device__ __forceinline__ void s5_scan_b(f32x16& re, f32x16& im, float Lr, float Li, float L16r, float L16i, const LAS float* et, int sg, LAS unsigned char* hp, int hstep) {
    float cr = 0.f, ci = 0.f;
#pragma unroll
    for (int sp = 0; sp < 8; ++sp) { const bool use = sp < sg; const float er = et[sp * 64], ei = et[sp * 64 + 1];
        const float nr_ = L16r * cr - L16i * ci + er, ni_ = L16r * ci + L16i * cr + ei; cr = use ? nr_ : cr; ci = use ? ni_ : ci; }
    float pr = Lr, pi = Li;
#pragma unroll
    for (int i = 0; i < 16; ++i) { re[i] += pr * cr - pi * ci; im[i] += pr * ci + pi * cr; const float t = pr * Lr - pi * Li; pi = pr * Li + pi * Lr; pr = t; }
#pragma unroll
    for (int i = 0; i < 16; ++i) *(LAS unsigned*)(hp + i * hstep) = pk2(re[i], im[i]);
}

__device__ __forceinline__ void s5_mfma(Frame& F, int l) {
    const bf16* Z1 = (const bf16*)(F.ws + WS_Z1); bf16* YS = (bf16*)(F.ws + WS_YS);
    LAS unsigned char* UIMG = F.lds + S5_UIMG; LAS unsigned char* HIMG = F.lds + S5_HIMG; LAS float* ETAB = (LAS float*)(F.lds + S5_ETAB);
    const int tid = F.tid, lane = F.lane, w = F.wave, r = lane & 31, h = lane >> 5;
    const int item0 = F.wg >= 128 ? (F.wg - 128) * 4 : 0, item1 = F.wg >= 128 ? item0 + 4 : 0;
    u32x4 uv[8];
#define S5_LOAD_U(IT) do { const int b_ = (IT) >> 5, g_ = (IT) & 31; _Pragma("unroll") for (int q = 0; q < 8; ++q) { const int p = tid + q * NTHREADS, token = p >> 1, half = p & 1; \
        uv[q] = *(const u32x4*)(Z1 + ((size_t)b_ * SEQ + token) * ZC + COL_U + g_ * 16 + half * 8); } } while (0)
    if (item0 < item1) S5_LOAD_U(item0);
    for (int item = item0; item < item1; ++item) {
        const int b = item >> 5, g = item & 31;
        const bf16* WsF = (const bf16*)(F.ws + WS_S5MAT) + ((size_t)l * 32 + g) * 196608; const bf16* W3F = WsF + 65536;
        __syncthreads();
        {
#pragma unroll
          for (int q = 0; q < 8; ++q) { const int p = tid + q * NTHREADS, token = p >> 1, half = p & 1; *(LAS u32x4*)(UIMG + (token >> 4) * S5_CSTR + (token & 15) * 32 + half * 16) = uv[q]; } }
        { unsigned z = 0u; asm volatile("" : "+v"(z));
          if (tid < 16) *(LAS u32x4*)(HIMG + 1 * S5_CSTR + tid * 16) = (u32x4){z, z, z, z};
          else if (tid < 32) *(LAS u32x4*)(HIMG + 128 * S5_CSTR + 256 + (tid - 16) * 16) = (u32x4){z, z, z, z}; }
        __syncthreads();
        if (item + 1 < item1) S5_LOAD_U(item + 1);
        const int d = w >> 2, sh = (w >> 1) & 1, mh = w & 1;
        f32x16 sre[2], sim[2];
#pragma unroll
        for (int i = 0; i < 16; ++i) { sre[0][i] = 0.f; sre[1][i] = 0.f; sim[0][i] = 0.f; sim[1][i] = 0.f; }
        {
            const int qf = 16 * ((r >> 2) & 1) + 4 * (r >> 3) + (r & 3);
            const int qr = d ? 127 - (64 * mh + qf) : 64 * mh + qf;
            const bf16* bre = WsF + ((size_t)(((d * 2 + sh) * 2 + 0) * 16) * 64 + lane) * 8; const bf16* bim = bre + (size_t)16 * 64 * 8;
            const LAS unsigned char* a0 = UIMG + qr * S5_CSTR + 16 * h; const LAS unsigned char* a1 = UIMG + (d ? qr - 32 : qr + 32) * S5_CSTR + 16 * h;
            unsigned zq = 0u; asm volatile("" : "+v"(zq));
            u32x4 gre[4], gim[4], l0, l1, ore, oim, ox0, ox1;
#pragma unroll
            for (int q = 0; q < 4; ++q) { gre[q] = *(const u32x4*)(bre + q * 512); gim[q] = *(const u32x4*)(bim + q * 512); }
            l0 = *(const LAS u32x4*)(a0); l1 = *(const LAS u32x4*)(a1);
            ore = oim = ox0 = ox1 = (u32x4){0u, 0u, 0u, 0u};
#pragma unroll
            for (int ks = 0; ks < 16; ++ks) {
                asm volatile("s_nop 15\n\ts_nop 15" : "+v"(zq), "+v"(ore), "+v"(oim), "+v"(ox0), "+v"(ox1));
                ore = gre[ks & 3] ^ zq; oim = gim[ks & 3] ^ zq; ox0 = l0 ^ zq; ox1 = l1 ^ zq;
                asm volatile("" : "+v"(ore), "+v"(oim), "+v"(ox0), "+v"(ox1));
                if (ks + 4 < 16) { gre[ks & 3] = *(const u32x4*)(bre + (ks + 4) * 512); gim[ks & 3] = *(const u32x4*)(bim + (ks + 4) * 512); }
                if (ks + 1 < 16) { l0 = *(const LAS u32x4*)(a0 + (ks + 1) * 32); l1 = *(const LAS u32x4*)(a1 + (ks + 1) * 32); }
                sre[0] = MFMA32(__builtin_bit_cast(bf16x8, ox0), __builtin_bit_cast(bf16x8, ore), sre[0]); sim[0] = MFMA32(__builtin_bit_cast(bf16x8, ox0), __builtin_bit_cast(bf16x8, oim), sim[0]);
                sre[1] = MFMA32(__builtin_bit_cast(bf16x8, ox1), __builtin_bit_cast(bf16x8, ore), sre[1]); sim[1] = MFMA32(__builtin_bit_cast(bf16x8, ox1), __builtin_bit_cast(bf16x8, oim), sim[1]);
            }
            asm volatile("" : "+v"(ore), "+v"(oim), "+v"(ox0), "+v"(ox1));
        }
        __builtin_amdgcn_sched_barrier(0);
        asm volatile("s_nop 15\n\ts_nop 15\n\ts_nop 15\n\ts_nop 15\n\ts_nop 15" : "+v"(sre[0]), "+v"(sre[1]), "+v"(sim[0]), "+v"(sim[1]));
        __builtin_amdgcn_sched_barrier(0);

        const int n = sh * 32 + r;
        const f32x4 lam = *(const f32x4*)((const float*)(F.ws + WS_S5LAM) + ((((size_t)l * 32 + g) * 2 + d) * 64 + n) * 4);
        LAS float* et = ETAB + ((d * 2 + sh) * 8) * 64 + r * 2;
        const int sg0 = 4 * mh + h, sg1 = sg0 + 2;
        s5_scan_a(sre[0], sim[0], lam[0], lam[1], et + sg0 * 64); s5_scan_a(sre[1], sim[1], lam[0], lam[1], et + sg1 * 64);
        __syncthreads();
        {
            const int cs0 = 16 * sg0, cs1 = 16 * sg1, hstep = d ? -S5_CSTR : S5_CSTR;
            LAS unsigned char* hcol = HIMG + d * 256 + 4 * n;
            s5_scan_b(sre[0], sim[0], lam[0], lam[1], lam[2], lam[3], et, sg0, hcol + (d ? 127 - cs0 : cs0 + 2) * S5_CSTR, hstep);
            s5_scan_b(sre[1], sim[1], lam[0], lam[1], lam[2], lam[3], et, sg1, hcol + (d ? 127 - cs1 : cs1 + 2) * S5_CSTR, hstep);
        }
        __syncthreads();
        f32x16 acc[4];
#pragma unroll
        for (int nt = 0; nt < 4; ++nt)
#pragma unroll
            for (int i = 0; i < 16; ++i) acc[nt][i] = 0.f;
        {
            const bf16* ap = W3F + ((size_t)(w * 32) * 64 + lane) * 8;
            unsigned bxa[4], bha[4];
#pragma unroll
            for (int nt = 0; nt < 4; ++nt) { bxa[nt] = (unsigned)(S5_UIMG + (nt * 32 + r) * S5_CSTR + 16 * h); bha[nt] = (unsigned)(S5_HIMG + (nt * 32 + r + 1) * S5_CSTR + 16 * h); }
            unsigned zq = 0u; asm volatile("" : "+v"(zq));
            u32x4 ga[4], lx[4], oa, ox[4];
#pragma unroll
            for (int q = 0; q < 4; ++q) ga[q] = *(const u32x4*)(ap + q * 512);
#pragma unroll
            for (int nt = 0; nt < 4; ++nt) { lx[nt] = *(const LAS u32x4*)(F.lds + bxa[nt]); ox[nt] = (u32x4){0u, 0u, 0u, 0u}; }
            oa = (u32x4){0u, 0u, 0u, 0u};
#pragma unroll
            for (int ks = 0; ks < 32; ++ks) {
                asm volatile("s_nop 15\n\ts_nop 15" : "+v"(zq), "+v"(oa), "+v"(ox[0]), "+v"(ox[1]), "+v"(ox[2]), "+v"(ox[3]));
                oa = ga[ks & 3] ^ zq;
#pragma unroll
                for (int nt = 0; nt < 4; ++nt) ox[nt] = lx[nt] ^ zq;
                asm volatile("" : "+v"(oa), "+v"(ox[0]), "+v"(ox[1]), "+v"(ox[2]), "+v"(ox[3]));
                if (ks + 4 < 32) ga[ks & 3] = *(const u32x4*)(ap + (ks + 4) * 512);
                if (ks + 1 < 32) {
#pragma unroll
                    for (int nt = 0; nt < 4; ++nt) lx[nt] = *(const LAS u32x4*)(F.lds + ((ks + 1) < 16 ? bxa[nt] + (ks + 1) * 32 : bha[nt] + (ks + 1 - 16) * 32));
                }
#pragma unroll
                for (int nt = 0; nt < 4; ++nt) acc[nt] = MFMA32(__builtin_bit_cast(bf16x8, oa), __builtin_bit_cast(bf16x8, ox[nt]), acc[nt]);
            }
            asm volatile("" : "+v"(oa), "+v"(ox[0]), "+v"(ox[1]), "+v"(ox[2]), "+v"(ox[3]));
            asm volatile("" :: "v"(bxa[0]), "v"(bxa[1]), "v"(bxa[2]), "v"(bxa[3]), "v"(bha[0]), "v"(bha[1]), "v"(bha[2]), "v"(bha[3]));
        }
        __builtin_amdgcn_sched_barrier(0);
        asm volatile("s_nop 15\n\ts_nop 15\n\ts_nop 15\n\ts_nop 15\n\ts_nop 15" : "+v"(acc[0]), "+v"(acc[1]), "+v"(acc[2]), "+v"(acc[3]));
        __builtin_amdgcn_sched_barrier(0);
#pragma unroll
        for (int nt = 0; nt < 4; ++nt)
#pragma unroll
            for (int gq = 0; gq < 4; ++gq) { const int tau = 2 * w + (gq >> 1), cp = 8 * (gq & 1) + 4 * h, token = (32 * nt + r) * 16 + tau;
                u32x2 o; o.x = pk2hw(gelu_tanh(acc[nt][4 * gq]), gelu_tanh(acc[nt][4 * gq + 1])); o.y = pk2hw(gelu_tanh(acc[nt][4 * gq + 2]), gelu_tanh(acc[nt][4 * gq + 3]));
                *(u32x2*)(YS + ((size_t)b * SEQ + token) * BW + g * 16 + cp) = o; }
    }
#undef S5_LOAD_U
    __syncthreads();
}


#define MFMA_FENCE3(a, b, c) asm volatile("s_nop 15\n\ts_nop 15\n\ts_nop 15\n\ts_nop 15\n\ts_nop 15" : "+v"(a), "+v"(b), "+v"(c))
__device__ __forceinline__ void lru_half_scan(f32x16& aR, f32x16& aI, const f32x16& aX, float br, float bi, float lamc, LAS float* sgw) {
    float Pp = 1.f, Hh = 0.f;
#pragma unroll
    for (int i = 0; i < 16; ++i) {
        const float rg = sigmoidf_(aR[i] + br), ig = sigmoidf_(aI[i] + bi), x2 = 2.0f * lamc * rg;
        const float a = __builtin_amdgcn_exp2f(0.72134752044f * x2);
        const float om = __builtin_fmaf(-a, a, 1.0f);
        const float u = __builtin_amdgcn_sqrtf(fmaxf(om, 0.f)) * ig * aX[i];
        Hh = a * Hh + u; Pp = a * Pp; aR[i] = Hh; aI[i] = Pp;
        if ((i & 3) == 3) asm volatile("" : "+v"(Hh), "+v"(Pp));
    }
    sgw[0] = Pp; sgw[1] = Hh;
}
constexpr int LRU_TILE = 16384, LRU_TILE_BYTES = 33 * 1024;
__device__ __forceinline__ void lru_mfma(Frame& F, int l) {
    const bf16* Z1 = (const bf16*)(F.ws + WS_Z1); bf16* OL = (bf16*)(F.ws + WS_OL);
    LAS float* CW = (LAS float*)F.lds;
    LAS float* SEG = CW + 320;
    const int tid = F.tid, lane = F.lane, w = F.wave, r = lane & 31, hh = lane >> 5;
    for (int item = F.wg; item < (F.wg < 128 ? BATCH * 8 : 0); item += 128) {
        const int b = item >> 3, hb = item & 7, ch0 = hb * 64 + r;
        __syncthreads();
        if (tid < 256) CW[tid] = F.in[I_CONVW][((size_t)l * 4 + (tid >> 6)) * BW + hb * 64 + (tid & 63)];
        else if (tid < 320) CW[tid] = F.in[I_CONVB][l * BW + hb * 64 + (tid - 256)];
        const int qf = 16 * ((r >> 2) & 1) + 4 * (r >> 3) + (r & 3);
        const bf16* xrb = Z1 + (size_t)b * SEQ * ZC + COL_XR + hb * 64 + (lane & 7) * 8;
#pragma unroll 1
        for (int dir = 0; dir < 2; ++dir) {
            bf16x8 wr[2][4], wi[2][4];
#pragma unroll
            for (int nh = 0; nh < 2; ++nh) { const bf16* lf = (const bf16*)(F.ws + WS_LRUF) + ((((((size_t)l * 2 + dir) * 8 + hb) * 2 + nh) * 2) * 4 * 64 + lane) * 8;
#pragma unroll
              for (int ks = 0; ks < 4; ++ks) { wr[nh][ks] = *(const bf16x8*)(lf + (size_t)ks * 512); wi[nh][ks] = *(const bf16x8*)(lf + (size_t)(4 + ks) * 512); } }
            float br[2], bi[2], lamc[2], carry[2] = {0.f, 0.f};
#pragma unroll
            for (int nh = 0; nh < 2; ++nh) { const int ch = ch0 + 32 * nh; br[nh] = F.in[I_LBR][((size_t)l * 2 + dir) * BW + ch]; bi[nh] = F.in[I_LBI][((size_t)l * 2 + dir) * BW + ch];
                lamc[nh] = -8.0f * log1pf(expf(-F.in[I_LAM][((size_t)l * 2 + dir) * BW + ch])); }
#define LRU_STAGE(SC) do { const int tlo_ = dir ? SEQ - 256 * ((SC) + 1) : 256 * (SC); \
                for (int j_ = w; j_ < 33; j_ += NWAVES) { int t_ = tlo_ - 2 + 8 * j_ + (lane >> 3); t_ = t_ < 0 ? 0 : (t_ >= SEQ ? SEQ - 1 : t_); \
                    __builtin_amdgcn_global_load_lds((const unsigned*)(xrb + (size_t)t_ * ZC), (LAS unsigned*)(F.lds + LRU_TILE + ((SC) & 1) * LRU_TILE_BYTES + j_ * 1024), 16, 0, 0); } } while (0)
            LRU_STAGE(0);
#pragma unroll 1
            for (int sc = 0; sc < 8; ++sc) {
                asm volatile("s_waitcnt vmcnt(0)" ::: "memory"); __syncthreads();
                if (sc + 1 < 8) LRU_STAGE(sc + 1);
                const int srow = sc * 256 + w * 32 + qf, trow = dir ? (SEQ - 1 - srow) : srow, tlo = dir ? SEQ - 256 * (sc + 1) : 256 * sc;
                const LAS unsigned char* tl = F.lds + LRU_TILE + (sc & 1) * LRU_TILE_BYTES + (trow - tlo) * 128 + 16 * hh;
                bf16x8 av[4];
#pragma unroll
                for (int ks = 0; ks < 4; ++ks) {
                    const int c0 = 16 * ks + 8 * hh;
                    float xv[8];
#pragma unroll
                    for (int j = 0; j < 8; ++j) xv[j] = CW[256 + c0 + j];
#pragma unroll
                    for (int tap = 0; tap < 4; ++tap) { const int tt = trow + tap - 2; const float msk = (tt >= 0 && tt < SEQ) ? 1.0f : 0.0f;
                        const bf16x8 v = *(const LAS bf16x8*)(tl + tap * 128 + ks * 32);
#pragma unroll
                        for (int j = 0; j < 8; ++j) xv[j] += (CW[tap * 64 + c0 + j] * msk) * bf2f((bf16)v[j]); }
                    u32x4 pa; pa.x = pk2hw(xv[0], xv[1]); pa.y = pk2hw(xv[2], xv[3]); pa.z = pk2hw(xv[4], xv[5]); pa.w = pk2hw(xv[6], xv[7]);
                    av[ks] = __builtin_bit_cast(bf16x8, pa);
                }
                const int st0 = sc * 256 + w * 32 + 16 * hh; const size_t tok0 = (size_t)b * SEQ + (dir ? (SEQ - 1 - st0) : st0); const long tstep = dir ? -1 : 1;
#pragma unroll
                for (int nh = 0; nh < 2; ++nh) {
                    const int ch = ch0 + 32 * nh;
                    f32x16 aR, aI, aX;
#pragma unroll
                    for (int i = 0; i < 16; ++i) { aR[i] = 0.f; aI[i] = 0.f; aX[i] = 0.f; }
                    bf16x8 idf[4];
#pragma unroll
                    for (int ks = 0; ks < 4; ++ks) { u32x4 pd_;
#pragma unroll
                        for (int jj = 0; jj < 4; ++jj) { const int k0 = 16 * ks + 8 * hh + 2 * jj; pd_[jj] = (k0 == nh * 32 + r ? 0x3f80u : 0u) | (k0 + 1 == nh * 32 + r ? 0x3f800000u : 0u); }
                        idf[ks] = __builtin_bit_cast(bf16x8, pd_); }
                    __builtin_amdgcn_sched_barrier(0);
#pragma unroll
                    for (int ks = 0; ks < 4; ++ks) { aR = MFMA32(av[ks], wr[nh][ks], aR); aI = MFMA32(av[ks], wi[nh][ks], aI); aX = MFMA32(av[ks], idf[ks], aX); }
                    __builtin_amdgcn_sched_barrier(0);
                    MFMA_FENCE3(aR, aI, aX);
                    __builtin_amdgcn_sched_barrier(0);
                    bf16 hfv[16], grv[16];
                    if (dir) {
#pragma unroll
                        for (int i = 0; i < 16; ++i) { const size_t tok = tok0 + tstep * i; hfv[i] = OL[tok * BW + ch]; grv[i] = Z1[tok * ZC + COL_GR + ch]; }
                    }
                    LAS float* sg = SEG + nh * 1024;
                    lru_half_scan(aR, aI, aX, br[nh], bi[nh], lamc[nh], sg + ((2 * w + hh) * 32 + r) * 2);
                    __syncthreads();
                    float cin = 0.f, X = carry[nh];
#pragma unroll
                    for (int sp = 0; sp < 16; ++sp) { cin = (sp == 2 * w + hh) ? X : cin; X = sg[(sp * 32 + r) * 2] * X + sg[(sp * 32 + r) * 2 + 1]; }
                    carry[nh] = X;
                    if (dir == 0) {
#pragma unroll
                        for (int i = 0; i < 16; i += 2) { const unsigned p = pk2hw(aR[i] + aI[i] * cin, aR[i + 1] + aI[i + 1] * cin);
                            OL[(tok0 + tstep * i) * BW + ch] = (bf16)(p & 0xffffu); OL[(tok0 + tstep * (i + 1)) * BW + ch] = (bf16)(p >> 16); }
                    } else {
#pragma unroll
                        for (int i = 0; i < 16; i += 2) { const unsigned p = pk2hw(gelu_tanh(bf2f(grv[i])) * (bf2f(hfv[i]) + aR[i] + aI[i] * cin), gelu_tanh(bf2f(grv[i + 1])) * (bf2f(hfv[i + 1]) + aR[i + 1] + aI[i + 1] * cin));
                            OL[(tok0 + tstep * i) * BW + ch] = (bf16)(p & 0xffffu); OL[(tok0 + tstep * (i + 1)) * BW + ch] = (bf16)(p >> 16); }
                    }
                }
            }
            asm volatile("s_waitcnt vmcnt(0)" ::: "memory"); __syncthreads();
        }
    }
    __syncthreads();
}

#ifndef ATT_LO
#define ATT_LO 1
#endif
constexpr int AT_KSTR = 144, AT_VSTR = 776, AT_K = 0, AT_V = 384 * AT_KSTR;
__device__ __forceinline__ void attn_mfma(Frame& F, int l) {
    const bf16* Z1 = (const bf16*)(F.ws + WS_Z1); bf16* OA = (bf16*)(F.ws + WS_OA);
    LAS unsigned char* KL = F.lds + AT_K; LAS unsigned char* VT = F.lds + AT_V;
    const int tid = F.tid, lane = F.lane, w = F.wave, r = lane & 31, hh = lane >> 5;
    const float LOG2E = 1.4426950408889634f;
    for (int k = 0; k < (F.wg < 128 ? ATT_LO : 4 - ATT_LO); ++k) {
        const int item = F.wg < 128 ? F.wg * ATT_LO + k : 128 * ATT_LO + (F.wg - 128) * (4 - ATT_LO) + k;
        const int b = item >> 5, nb = (item >> 1) & 15, kvh = item & 1;
        __syncthreads();
        { u32x4 kq[6], vq[6];
#pragma unroll
          for (int q = 0; q < 6; ++q) { const int p = tid + q * NTHREADS, kj = p >> 3, dc = p & 7, sp = nb * 128 - 128 + kj; const bool ok = (sp >= 0 && sp < SEQ);
              const bf16* base = Z1 + ((size_t)b * SEQ + (ok ? sp : 0)) * ZC + kvh * 64 + dc * 8; kq[q] = *(const u32x4*)(base + COL_K); vq[q] = *(const u32x4*)(base + COL_V);
              if (!ok) { kq[q] = (u32x4){0u, 0u, 0u, 0u}; vq[q] = (u32x4){0u, 0u, 0u, 0u}; } }
#pragma unroll
          for (int q = 0; q < 6; ++q) { const int p = tid + q * NTHREADS, kj = p >> 3, dc = p & 7; const u32x4 vv = vq[q];
              *(LAS u32x4*)(KL + kj * AT_KSTR + dc * 16) = kq[q];
              LAS bf16* vt = (LAS bf16*)(VT + (dc * 8) * AT_VSTR + kj * 2);
              vt[0 * (AT_VSTR / 2)] = (bf16)(vv.x & 0xffffu); vt[1 * (AT_VSTR / 2)] = (bf16)(vv.x >> 16); vt[2 * (AT_VSTR / 2)] = (bf16)(vv.y & 0xffffu); vt[3 * (AT_VSTR / 2)] = (bf16)(vv.y >> 16);
              vt[4 * (AT_VSTR / 2)] = (bf16)(vv.z & 0xffffu); vt[5 * (AT_VSTR / 2)] = (bf16)(vv.z >> 16); vt[6 * (AT_VSTR / 2)] = (bf16)(vv.w & 0xffffu); vt[7 * (AT_VSTR / 2)] = (bf16)(vv.w >> 16); } }
        __syncthreads();
#pragma unroll 1
        for (int task = w; task < 16; task += NWAVES) {
            const int g = task >> 2, qt = task & 3, hq = kvh * 4 + g;
            const size_t tokq = (size_t)b * SEQ + nb * 128 + 32 * qt + r;
            bf16x8 qf[4];
#pragma unroll
            for (int ks = 0; ks < 4; ++ks) qf[ks] = *(const bf16x8*)(Z1 + tokq * ZC + COL_Q + hq * 64 + 16 * ks + 8 * hh);
            const float slope2 = exp2f(-(float)(hq + 1)) * LOG2E, sink2 = F.in[I_SINK][l * NQ + hq] * LOG2E;
            float m = sink2, lsum = 1.0f;
            f32x16 o0, o1;
#pragma unroll
            for (int i = 0; i < 16; ++i) { o0[i] = 0.f; o1[i] = 0.f; }
            u32x4 ka[4] = {(u32x4){0u, 0u, 0u, 0u}, (u32x4){0u, 0u, 0u, 0u}, (u32x4){0u, 0u, 0u, 0u}, (u32x4){0u, 0u, 0u, 0u}};
            u32x4 pp0 = (u32x4){0u, 0u, 0u, 0u}, pp1 = pp0, va0 = pp0, va1 = pp0, va2 = pp0, va3 = pp0;
#pragma unroll 1
            for (int kt = qt; kt < qt + 9; ++kt) {
                f32x16 sc;
#pragma unroll
                for (int i = 0; i < 16; ++i) sc[i] = 0.f;
                { const LAS unsigned char* kp = KL + (32 * kt + r) * AT_KSTR + 16 * hh;
#pragma unroll
                  for (int ks = 0; ks < 4; ++ks) ka[ks] = *(const LAS u32x4*)(kp + ks * 32);
#pragma unroll
                  for (int ks = 0; ks < 4; ++ks) sc = MFMA32(__builtin_bit_cast(bf16x8, ka[ks]), qf[ks], sc); }
                __builtin_amdgcn_sched_barrier(0);
                asm volatile("s_nop 15\n\ts_nop 15\n\ts_nop 15\n\ts_nop 15\n\ts_nop 15" : "+v"(sc), "+v"(o0), "+v"(o1), "+v"(pp0), "+v"(pp1), "+v"(va0), "+v"(va1), "+v"(va2), "+v"(va3), "+v"(ka[0]), "+v"(ka[1]), "+v"(ka[2]), "+v"(ka[3]));
                __builtin_amdgcn_sched_barrier(0);
                const float fd0 = (float)(128 + 32 * qt + r - 32 * kt - 4 * hh);
                const bool inwin = (kt > qt) && (kt < qt + 8), inseq = (nb * 128 - 128 + 32 * kt >= 0) && (nb * 128 - 128 + 32 * kt + 31 < SEQ);
                float tmax = -1e30f;
                if (inwin && inseq) {
#pragma unroll
                    for (int i = 0; i < 16; ++i) { const float dd = fd0 - (float)((i & 3) + 8 * (i >> 2)); const float v = sc[i] * (0.125f * LOG2E) - slope2 * __builtin_fabsf(dd); sc[i] = v; tmax = fmaxf(tmax, v); }
                } else {
#pragma unroll
                    for (int i = 0; i < 16; ++i) { const int kj = 32 * kt + (i & 3) + 8 * (i >> 2) + 4 * hh, sp = nb * 128 - 128 + kj; const float dd = fd0 - (float)((i & 3) + 8 * (i >> 2)), ad = __builtin_fabsf(dd);
                        const bool valid = (ad <= (float)WIN) && (sp >= 0) && (sp < SEQ);
                        const float v = valid ? (sc[i] * (0.125f * LOG2E) - slope2 * ad) : -1e30f; sc[i] = v; tmax = fmaxf(tmax, v); }
                }
                { const auto sw = __builtin_amdgcn_permlane32_swap(__float_as_uint(tmax), __float_as_uint(tmax), false, false); tmax = fmaxf(__uint_as_float(sw[0]), __uint_as_float(sw[1])); }
                const float mnew = fmaxf(m, tmax), alpha = __builtin_amdgcn_exp2f(m - mnew); m = mnew;
                float psum = 0.f;
#pragma unroll
                for (int i = 0; i < 16; ++i) { const float p = __builtin_amdgcn_exp2f(sc[i] - mnew); sc[i] = p; psum += p; }
                { const auto sw = __builtin_amdgcn_permlane32_swap(__float_as_uint(psum), __float_as_uint(psum), false, false); psum = __uint_as_float(sw[0]) + __uint_as_float(sw[1]); }
                lsum = lsum * alpha + psum;
#pragma unroll
                for (int i = 0; i < 16; ++i) { o0[i] *= alpha; o1[i] *= alpha; }
                pp0.x = pk2hw(sc[0], sc[1]); pp0.y = pk2hw(sc[2], sc[3]); pp0.z = pk2hw(sc[4], sc[5]); pp0.w = pk2hw(sc[6], sc[7]);
                pp1.x = pk2hw(sc[8], sc[9]); pp1.y = pk2hw(sc[10], sc[11]); pp1.z = pk2hw(sc[12], sc[13]); pp1.w = pk2hw(sc[14], sc[15]);
                {   const LAS unsigned char* vp = VT + r * AT_VSTR + (32 * kt + 4 * hh) * 2;
#define AT_LDV(dst, off) do { const u32x2 lo_ = *(const LAS u32x2*)(vp + (off)), hi_ = *(const LAS u32x2*)(vp + (off) + 16); dst.x = lo_.x; dst.y = lo_.y; dst.z = hi_.x; dst.w = hi_.y; } while (0)
                    AT_LDV(va0, 0); AT_LDV(va1, 32 * AT_VSTR); AT_LDV(va2, 32); AT_LDV(va3, 32 * AT_VSTR + 32);
#undef AT_LDV
                    o0 = MFMA32(__builtin_bit_cast(bf16x8, va0), __builtin_bit_cast(bf16x8, pp0), o0); o1 = MFMA32(__builtin_bit_cast(bf16x8, va1), __builtin_bit_cast(bf16x8, pp0), o1);
                    o0 = MFMA32(__builtin_bit_cast(bf16x8, va2), __builtin_bit_cast(bf16x8, pp1), o0); o1 = MFMA32(__builtin_bit_cast(bf16x8, va3), __builtin_bit_cast(bf16x8, pp1), o1); }
            }
            __builtin_amdgcn_sched_barrier(0);
            asm volatile("s_nop 15\n\ts_nop 15\n\ts_nop 15\n\ts_nop 15\n\ts_nop 15" : "+v"(o0), "+v"(o1), "+v"(pp0), "+v"(pp1), "+v"(va0), "+v"(va1), "+v"(va2), "+v"(va3));
            __builtin_amdgcn_sched_barrier(0);
            const float inv = 1.0f / lsum;
            bf16* op = OA + tokq * BW + hq * 64 + 4 * hh;
#pragma unroll
            for (int gq = 0; gq < 4; ++gq) {
                u32x2 w0, w1; w0.x = pk2hw(o0[4 * gq] * inv, o0[4 * gq + 1] * inv); w0.y = pk2hw(o0[4 * gq + 2] * inv, o0[4 * gq + 3] * inv);
                w1.x = pk2hw(o1[4 * gq] * inv, o1[4 * gq + 1] * inv); w1.y = pk2hw(o1[4 * gq + 2] * inv, o1[4 * gq + 3] * inv);
                *(u32x2*)(op + 8 * gq) = w0; *(u32x2*)(op + 32 + 8 * gq) = w1; }
        }
    }
    __syncthreads();
}

__device__ __forceinline__ void p4a_router(Frame& F, int l) {
    LAS float* wl = (LAS float*)F.lds;
    LAS int* bk = (LAS int*)(F.lds + 81920);
    const float* wrt = (const float*)(F.ws + WS_WRT) + (size_t)l * 20 * D;
    for (int i = F.tid; i < 20 * D / 4; i += NTHREADS) ((LAS f32x4*)wl)[i] = ((const f32x4*)wrt)[i];
    __syncthreads();
    const float* X = F.out; float* rinv2 = (float*)(F.ws + WS_RINV2); int* BUCKET = (int*)(F.ws + WS_BUCKET); float* WTOK = (float*)(F.ws + WS_WTOK);
    const int lane = F.lane, t2 = lane >> 4, kk = lane & 15, tok0 = F.wg * 128 + F.wave * 16 + 4 * t2;
    float lg[4][20], ss[4];
#pragma unroll
    for (int i = 0; i < 4; ++i) { ss[i] = 0.f;
#pragma unroll
        for (int o = 0; o < 20; ++o) lg[i][o] = 0.f; }
    const f32x4* xr = (const f32x4*)(X + (size_t)tok0 * D) + kk;
#pragma unroll 2
    for (int jj = 0; jj < 16; ++jj) {
        f32x4 x4[4];
#pragma unroll
        for (int i = 0; i < 4; ++i) x4[i] = xr[(size_t)i * (D / 4) + 16 * jj];
#pragma unroll
        for (int i = 0; i < 4; ++i) ss[i] += (x4[i].x * x4[i].x + x4[i].y * x4[i].y) + (x4[i].z * x4[i].z + x4[i].w * x4[i].w);
#pragma unroll
        for (int o = 0; o < 20; ++o) { const f32x4 w4 = ((const LAS f32x4*)(wl + o * D))[16 * jj + kk];
#pragma unroll
            for (int i = 0; i < 4; ++i) lg[i][o] += (x4[i].x * w4.x + x4[i].y * w4.y) + (x4[i].z * w4.z + x4[i].w * w4.w); }
    }
#pragma unroll
    for (int i = 0; i < 4; ++i) {
#pragma unroll
        for (int o = 0; o < 20; ++o) { float v = lg[i][o]; v += dpp_ror<8>(v); v += dpp_ror<4>(v); v += dpp_ror<2>(v); v += dpp_ror<1>(v); lg[i][o] = v; }
        { float v = ss[i]; v += dpp_ror<8>(v); v += dpp_ror<4>(v); v += dpp_ror<2>(v); v += dpp_ror<1>(v); ss[i] = v; } }
    {
        float lgv[20], ssv = ss[0];
#pragma unroll
        for (int o = 0; o < 20; ++o) lgv[o] = lg[0][o];
#pragma unroll
        for (int i = 1; i < 4; ++i) { ssv = (kk == i) ? ss[i] : ssv;
#pragma unroll
            for (int o = 0; o < 20; ++o) lgv[o] = (kk == i) ? lg[i][o] : lgv[o]; }
        const int tok = tok0 + (kk & 3); const float ri = 1.0f / sqrtf(ssv * (1.0f / D) + NORM_EPS);
        float gl[4]; int gi = 0; float gm;
#pragma unroll
        for (int q = 0; q < 4; ++q) gl[q] = lgv[q] * ri + F.in[I_BG][l * 4 + q];
        gm = gl[0];
#pragma unroll
        for (int q = 1; q < 4; ++q) if (gl[q] > gm) { gm = gl[q]; gi = q; }
        float gs = 0.f;
#pragma unroll
        for (int q = 0; q < 4; ++q) gs += expf(gl[q] - gm);
        const float gw = 1.0f / gs;
        float el[4];
#pragma unroll
        for (int e = 0; e < 4; ++e) { float v = 0.f;
#pragma unroll
            for (int g = 0; g < 4; ++g) v = (gi == g) ? (lgv[4 + g * 4 + e] * ri + F.in[I_BE][l * 16 + g * 4 + e]) : v;
            el[e] = v; }
        int i1 = 0; float v1 = el[0];
#pragma unroll
        for (int e = 1; e < 4; ++e) if (el[e] > v1) { v1 = el[e]; i1 = e; }
        int i2 = -1; float v2 = -3.4e38f;
#pragma unroll
        for (int e = 0; e < 4; ++e) if (e != i1 && el[e] > v2) { v2 = el[e]; i2 = e; }
        const float e2 = expf(v2 - v1), w1 = gw / (1.0f + e2), w2 = gw * e2 / (1.0f + e2);
        const int ea = i1 < i2 ? i1 : i2, eb = i1 < i2 ? i2 : i1; const float wa = i1 < i2 ? w1 : w2, wb = i1 < i2 ? w2 : w1;
        const int bucket = gi * 6 + pair_index(ea, eb);
        if (kk < 4) { rinv2[tok] = ri; BUCKET[tok] = bucket; WTOK[2 * tok] = wa; WTOK[2 * tok + 1] = wb; bk[F.wave * 16 + 4 * t2 + kk] = bucket; }
    }
    __syncthreads();
    if (F.tid < 128) { const int b = bk[F.tid]; int r = 0; for (int i = 0; i < F.tid; ++i) r += (bk[i] == b) ? 1 : 0; ((int*)(F.ws + WS_RANK))[F.wg * 128 + F.tid] = r; }
    if (F.tid >= 128 && F.tid < 128 + 32) { const int b = F.tid - 128; int c = 0; if (b < NBUCKET) for (int i = 0; i < 128; ++i) c += (bk[i] == b) ? 1 : 0; ((int*)(F.ws + WS_HIST))[F.wg * 32 + b] = c; }
    __syncthreads();
}

__device__ __forceinline__ void p4b_positions(Frame& F) {
    LAS int* tot = (LAS int*)F.lds; LAS int* pre = tot + 32; LAS int* base = tot + 64;
    const int* HIST = (const int*)(F.ws + WS_HIST);
    if (F.tid < NBUCKET) { int t = 0, p = 0; for (int w = 0; w < 256; ++w) { const int h = HIST[w * 32 + F.tid]; if (w < F.wg) p += h; t += h; } tot[F.tid] = t; pre[F.tid] = p; }
    __syncthreads();
    if (F.tid == 0) { int a = 0; for (int b = 0; b < NBUCKET; ++b) { base[b] = a; a += (tot[b] + 255) & ~255; } base[NBUCKET] = a; }
    __syncthreads();
    int* IDX = (int*)(F.ws + WS_IDX); float* WSORT = (float*)(F.ws + WS_WSORT); float* RSORT = (float*)(F.ws + WS_RSORT); const float* WTOK = (const float*)(F.ws + WS_WTOK);
    if (F.tid < 128) { const int tok = F.wg * 128 + F.tid; const int b = ((const int*)(F.ws + WS_BUCKET))[tok]; const int pos = base[b] + pre[b] + ((const int*)(F.ws + WS_RANK))[tok];
        IDX[pos] = tok; *(u32x2*)(WSORT + 2 * pos) = (u32x2){__float_as_uint(WTOK[2 * tok]), __float_as_uint(WTOK[2 * tok + 1])}; RSORT[pos] = ((const float*)(F.ws + WS_RINV2))[tok]; }
    if (F.wg == 0) {
        float z = 0.f; asm volatile("" : "+v"(z));
        for (int b = 0; b < NBUCKET; ++b) for (int p = base[b] + tot[b] + F.tid; p < base[b + 1]; p += NTHREADS) { IDX[p] = -1; WSORT[2 * p] = z; WSORT[2 * p + 1] = z; RSORT[p] = z; }
        if (F.tid <= NBUCKET) ((int*)(F.ws + WS_BBASE))[F.tid] = base[F.tid];
    }
    __syncthreads();
}

__device__ __forceinline__ int build_tile_table(Frame& F, LAS int* tb) {
    const int* BB = (const int*)(F.ws + WS_BBASE);
    if (F.tid < 160) { const int r0 = F.tid * 256; int bkt = -1; for (int b = 0; b < NBUCKET; ++b) if (r0 >= BB[b] && r0 < BB[b + 1]) bkt = b; tb[1 + F.tid] = bkt; }
    if (F.tid == 0) tb[0] = BB[NBUCKET] / 256;
    __syncthreads();
    return tb[0];
}

typedef f32x4 AccT[2][2][4][2];
struct EpiZ1 { bf16* Z1; const float* rinv;
    __device__ __forceinline__ bool operator()(const AccT& acc, const pg8::Unit& u, int wr, int wc, int fr, int fq) const {
        asm volatile("" : "+v"(fr), "+v"(fq));
#pragma unroll
        for (int ai = 0; ai < 2; ++ai)
#pragma unroll
            for (int m = 0; m < 4; ++m) { const int row = u.pm * 256 + ai * 128 + wr * 64 + m * 16 + fr; const float ri = rinv[row]; bf16* rowp = Z1 + (size_t)row * ZC + u.pn * 256 + wc * 32 + 8 * fq;
#pragma unroll
                for (int bj = 0; bj < 2; ++bj) *(u32x4*)(rowp + bj * 128) = pack8(acc[ai][bj][m][0] * ri, acc[ai][bj][m][1] * ri); }
        return false; } };
__device__ __forceinline__ void p1_inproj_pg8(Frame& F, int l) {
    DenseSched S{(const char*)(F.ws + WS_XB), (const char*)(F.ws + WS_WINT) + (size_t)l * IN_COLS * D * 2, M / 256, ZC / 256, F.G, F.wg, D / 64, D * 2, D * 2};
    EpiZ1 E{(bf16*)(F.ws + WS_Z1), (const float*)(F.ws + WS_RINV1)};
    pg8::gemm_phase<EpiZ1, DenseSched, true, 0>(F.lds, S, E, F.tid);
    if (P0_LAYERS < DEPTH && l == 0 && F.wg >= 128) p0_weights(F, P0_LAYERS, DEPTH, (F.wg - 128) * NWAVES + F.wave, 128 * NWAVES);
}
struct EpiGlu { bf16* OS; const float* bg;
    __device__ __forceinline__ bool operator()(const AccT& acc, const pg8::Unit& u, int wr, int wc, int fr, int fq) const {
        asm volatile("" : "+v"(fr), "+v"(fq));
        const int col = u.pn * 128 + wc * 32 + 8 * fq;
        f32x4 bv[2], bgt[2];
#pragma unroll
        for (int n = 0; n < 2; ++n) { bv[n] = *(const f32x4*)(bg + col + 4 * n); bgt[n] = *(const f32x4*)(bg + 512 + col + 4 * n); }
#pragma unroll
        for (int ai = 0; ai < 2; ++ai)
#pragma unroll
            for (int m = 0; m < 4; ++m) { const int row = u.pm * 256 + ai * 128 + wr * 64 + m * 16 + fr; f32x4 o[2];
#pragma unroll
                for (int n = 0; n < 2; ++n) { const f32x4 v = acc[ai][0][m][n] + bv[n], g = acc[ai][1][m][n] + bgt[n];
#pragma unroll
                    for (int j = 0; j < 4; ++j) o[n][j] = v[j] * sigmoidf_(g[j]); }
                *(u32x4*)(OS + (size_t)row * BW + col) = pack8(o[0], o[1]); }
        return false; } };
__device__ __forceinline__ void p3a_glu_pg8(Frame& F, int l) {
    DenseSched S{(const char*)(F.ws + WS_YS), (const char*)(F.ws + WS_WGLUT) + (size_t)l * 1024 * BW * 2, M / 256, 4, F.G, F.wg, BW / 64, BW * 2, BW * 2};
    EpiGlu E{(bf16*)(F.ws + WS_OS), F.in[I_BGLU] + l * 1024};
    pg8::gemm_phase<EpiGlu, DenseSched, true, 0>(F.lds, S, E, F.tid);
}
struct EpiOut { const float* xin; float* X; bf16* XB;
    __device__ __forceinline__ bool operator()(const AccT& acc, const pg8::Unit& u, int wr, int wc, int fr, int fq) const {
        asm volatile("" : "+v"(fr), "+v"(fq));
#pragma unroll
        for (int ai = 0; ai < 2; ++ai) {
#pragma unroll
            for (int mp = 0; mp < 2; ++mp) {
                f32x4 xv[2][2][2];
#pragma unroll
                for (int mm = 0; mm < 2; ++mm) { const size_t row = u.pm * 256 + ai * 128 + wr * 64 + (2 * mp + mm) * 16 + fr;
#pragma unroll
                    for (int bj = 0; bj < 2; ++bj) { const size_t o = row * D + u.pn * 256 + bj * 128 + wc * 32 + 8 * fq; xv[mm][bj][0] = *(const f32x4*)(xin + o); xv[mm][bj][1] = *(const f32x4*)(xin + o + 4); } }
#pragma unroll
                for (int mm = 0; mm < 2; ++mm) { const int m = 2 * mp + mm; const size_t row = u.pm * 256 + ai * 128 + wr * 64 + m * 16 + fr;
#pragma unroll
                    for (int bj = 0; bj < 2; ++bj) { const size_t o = row * D + u.pn * 256 + bj * 128 + wc * 32 + 8 * fq;
                        const f32x4 v0 = xv[mm][bj][0] + acc[ai][bj][m][0], v1 = xv[mm][bj][1] + acc[ai][bj][m][1];
                        *(f32x4*)(X + o) = v0; *(f32x4*)(X + o + 4) = v1; *(u32x4*)(XB + o) = pack8(v0, v1); } }
                asm volatile("" ::: "memory"); } }
        return false; } };
__device__ __forceinline__ void p3c_outproj_pg8(Frame& F, int l) {
    DenseSched S{(const char*)(F.ws + WS_MIXED), (const char*)(F.ws + WS_WOUTT) + (size_t)l * D * D * 2, M / 256, 4, F.G, F.wg, D / 64, D * 2, D * 2};
    EpiOut E{(l == 0) ? F.in[I_X] : F.out, F.out, (bf16*)(F.ws + WS_XB)};
    pg8::gemm_phase<EpiOut, DenseSched, true, 0>(F.lds, S, E, F.tid);
}
struct MixSched { const char* XB; const char* WG; const char* WB; const char* ws; int G, c;
    __device__ __forceinline__ bool next(int i, pg8::Unit& u) const {
        const int sub = i % 6, L = (i / 6) * G + c; if (L >= 512) return false;
        pg8::static_tile(L, M / 256, 4, u.pm, u.pn); u.aux = sub; const int k = sub >> 1;
        if (!(sub & 1)) { u.A = XB + (size_t)u.pm * 256 * 2048; u.lda2 = 2048; u.nt = 16; u.B = WG + ((size_t)k * D + u.pn * 256) * 2048; u.ldb2 = 2048; }
        else { const char* br = ws + (k == 0 ? WS_OA : (k == 1 ? WS_OL : WS_OS)); u.A = br + (size_t)u.pm * 256 * 1024; u.lda2 = 1024; u.nt = 8; u.B = WB + ((size_t)k * D + u.pn * 256) * 1024; u.ldb2 = 1024; }
        return true; }
    __device__ __forceinline__ unsigned row_off(const pg8::Unit&, int) const { return 0u; }
};
struct EpiMix { u32x2* SIG; u32x4* MIXS; bf16* MX; const float* rinv;
    __device__ __forceinline__ bool operator()(const AccT& acc, const pg8::Unit& u, int wr, int wc, int fr, int fq) const {
        asm volatile("" : "+v"(fr), "+v"(fq));
        const int tid = (wr * 4 + wc) * 64 + fq * 16 + fr, sub = u.aux, k = sub >> 1;
        if (!(sub & 1)) {
            float ri[2][4];
#pragma unroll
            for (int ai = 0; ai < 2; ++ai)
#pragma unroll
                for (int m = 0; m < 4; ++m) ri[ai][m] = rinv[u.pm * 256 + ai * 128 + wr * 64 + m * 16 + fr];
#pragma unroll
            for (int ai = 0; ai < 2; ++ai)
#pragma unroll
                for (int m = 0; m < 4; ++m)
#pragma unroll
                    for (int bj = 0; bj < 2; ++bj) { unsigned q0 = 0u, q1 = 0u;
#pragma unroll
                        for (int j = 0; j < 4; ++j) { q0 |= (unsigned)__builtin_rintf(255.0f * sigmoidf_(acc[ai][bj][m][0][j] * ri[ai][m])) << (8 * j); q1 |= (unsigned)__builtin_rintf(255.0f * sigmoidf_(acc[ai][bj][m][1][j] * ri[ai][m])) << (8 * j); }
                        SIG[((ai * 4 + m) * 2 + bj) * 512 + tid] = (u32x2){q0, q1}; }
        } else {
#pragma unroll
            for (int ai = 0; ai < 2; ++ai)
#pragma unroll
            for (int mp = 0; mp < 2; ++mp) {
                u32x2 sv[2][2]; u32x4 mv[2][2];
#pragma unroll
                for (int mm = 0; mm < 2; ++mm)
#pragma unroll
                    for (int bj = 0; bj < 2; ++bj) { const int slot = ((ai * 4 + 2 * mp + mm) * 2 + bj) * 512 + tid; sv[mm][bj] = SIG[slot]; if (k > 0) mv[mm][bj] = MIXS[slot]; }
#pragma unroll
                for (int mm = 0; mm < 2; ++mm) { const int m = 2 * mp + mm; const size_t row = u.pm * 256 + ai * 128 + wr * 64 + m * 16 + fr;
#pragma unroll
                    for (int bj = 0; bj < 2; ++bj) { const int slot = ((ai * 4 + m) * 2 + bj) * 512 + tid; f32x4 s0, s1;
#pragma unroll
                        for (int j = 0; j < 4; ++j) { s0[j] = (float)((sv[mm][bj].x >> (8 * j)) & 255u) * (1.0f / 255.0f); s1[j] = (float)((sv[mm][bj].y >> (8 * j)) & 255u) * (1.0f / 255.0f); }
                        f32x4 v0 = acc[ai][bj][m][0] * s0, v1 = acc[ai][bj][m][1] * s1;
                        if (k > 0) { f32x4 p0, p1; unpack8(mv[mm][bj], p0, p1); v0 += p0; v1 += p1; }
                        if (k < 2) MIXS[slot] = pack8(v0, v1);
                        else *(u32x4*)(MX + row * D + u.pn * 256 + bj * 128 + wc * 32 + 8 * fq) = pack8(v0, v1); } }
                asm volatile("" ::: "memory"); }
        }
        return false; } };
__device__ __forceinline__ void p3b_mix_pg8(Frame& F, int l) {
    MixSched S{(const char*)(F.ws + WS_XB), (const char*)(F.ws + WS_WINT) + ((size_t)l * IN_COLS + COL_GATES) * D * 2, (const char*)(F.ws + WS_WBRT) + (size_t)l * 3 * D * BW * 2, (const char*)F.ws, F.G, F.wg};
    EpiMix E{(u32x2*)(F.ws + WS_P3BSCR + (size_t)F.wg * 262144), (u32x4*)(F.ws + WS_P3BSCR + (size_t)F.wg * 262144 + 131072), (bf16*)(F.ws + WS_MIXED), (const float*)(F.ws + WS_RINV1)};
    pg8::gemm_phase<EpiMix, MixSched, true, 0>(F.lds, S, E, F.tid);
}
struct Moe1Sched { const char* XB; const char* W13; const int* IDX; const LAS int* tb; int ntile, G, c;
    __device__ __forceinline__ bool next(int i, pg8::Unit& u) const {
        const int L = i * G + c; if (L >= ntile * 4) return false;
        u.pm = L >> 2; u.pn = L & 3; const int bucket = tb[1 + u.pm], g = bucket / 6; int pa, pb; pair_of(bucket % 6, pa, pb);
        u.aux = u.pn >> 1; const int e = g * 4 + (u.aux ? pb : pa);
        u.A = XB; u.lda2 = 2048; u.nt = 16; u.B = W13 + ((size_t)e * 512 + (u.pn & 1) * 256) * 2048; u.ldb2 = 2048; return true; }
    __device__ __forceinline__ unsigned row_off(const pg8::Unit& u, int r) const { int tok = IDX[u.pm * 256 + r]; tok = tok < 0 ? 0 : tok; return (unsigned)tok * 2048u; }
};
struct EpiMoe1 { bf16* HS; const float* WSORT; const float* RSORT;
    __device__ __forceinline__ bool operator()(const AccT& acc, const pg8::Unit& u, int wr, int wc, int fr, int fq) const {
        asm volatile("" : "+v"(fr), "+v"(fq));
        const int slot = u.aux, hcol = slot * 256 + (u.pn & 1) * 128 + wc * 32 + 8 * fq;
#pragma unroll
        for (int ai = 0; ai < 2; ++ai)
#pragma unroll
            for (int m = 0; m < 4; ++m) { const int row = u.pm * 256 + ai * 128 + wr * 64 + m * 16 + fr; const float wsel = WSORT[2 * row + slot], ri = RSORT[row]; f32x4 o[2];
#pragma unroll
                for (int n = 0; n < 2; ++n)
#pragma unroll
                    for (int j = 0; j < 4; ++j) { const float v1 = acc[ai][0][m][n][j] * ri, v3 = acc[ai][1][m][n][j] * ri; o[n][j] = v1 * sigmoidf_(v1) * v3 * wsel; }
                *(u32x4*)(HS + (size_t)row * 512 + hcol) = pack8(o[0], o[1]); }
        return false; } };
__device__ __forceinline__ void p4c_moe1_pg8(Frame& F, int l) {
    LAS int* tb = (LAS int*)(F.lds + TB_OFF);
    const int ntile = build_tile_table(F, tb);
    Moe1Sched S{(const char*)(F.ws + WS_XB), (const char*)(F.ws + WS_W13T) + (size_t)l * 16 * 512 * D * 2, (const int*)(F.ws + WS_IDX), tb, ntile, F.G, F.wg};
    EpiMoe1 E{(bf16*)(F.ws + WS_HS), (const float*)(F.ws + WS_WSORT), (const float*)(F.ws + WS_RSORT)};
    pg8::gemm_phase<EpiMoe1, Moe1Sched, true, 2>(F.lds, S, E, F.tid);
}
struct Moe2Sched { const char* HS; const char* W2; const LAS int* tb; int ntile, G, c;
    __device__ __forceinline__ bool next(int i, pg8::Unit& u) const {
        const int L = i * G + c; if (L >= ntile * 4) return false;
        u.pm = L >> 2; u.pn = L & 3; u.aux = 0; const int bucket = tb[1 + u.pm];
        u.A = HS + (size_t)u.pm * 256 * 1024; u.lda2 = 1024; u.nt = 8; u.B = W2 + ((size_t)bucket * D + u.pn * 256) * 1024; u.ldb2 = 1024; return true; }
    __device__ __forceinline__ unsigned row_off(const pg8::Unit&, int) const { return 0u; }
};
struct EpiMoe2 { float* X; bf16* XB; const int* IDX;
    __device__ __forceinline__ bool operator()(const AccT& acc, const pg8::Unit& u, int wr, int wc, int fr, int fq) const {
        asm volatile("" : "+v"(fr), "+v"(fq));
        int tk[2][4];
#pragma unroll
        for (int ai = 0; ai < 2; ++ai)
#pragma unroll
            for (int m = 0; m < 4; ++m) tk[ai][m] = IDX[u.pm * 256 + ai * 128 + wr * 64 + m * 16 + fr];
#pragma unroll
        for (int ai = 0; ai < 2; ++ai) {
#pragma unroll
            for (int mp = 0; mp < 2; ++mp) {
                f32x4 xv[2][2][2];
#pragma unroll
                for (int mm = 0; mm < 2; ++mm) { const int tok = tk[ai][2 * mp + mm]; const size_t rb = (size_t)(tok < 0 ? 0 : tok) * D + u.pn * 256 + wc * 32 + 8 * fq;
#pragma unroll
                    for (int bj = 0; bj < 2; ++bj) { xv[mm][bj][0] = *(const f32x4*)(X + rb + bj * 128); xv[mm][bj][1] = *(const f32x4*)(X + rb + bj * 128 + 4); } }
#pragma unroll
                for (int mm = 0; mm < 2; ++mm) { const int m = 2 * mp + mm, tok = tk[ai][m];
                    if (tok >= 0) { const size_t rb = (size_t)tok * D + u.pn * 256 + wc * 32 + 8 * fq;
#pragma unroll
                        for (int bj = 0; bj < 2; ++bj) { const f32x4 v0 = xv[mm][bj][0] + acc[ai][bj][m][0], v1 = xv[mm][bj][1] + acc[ai][bj][m][1];
                            *(f32x4*)(X + rb + bj * 128) = v0; *(f32x4*)(X + rb + bj * 128 + 4) = v1; *(u32x4*)(XB + rb + bj * 128) = pack8(v0, v1); } } }
                asm volatile("" ::: "memory"); } }
        return false; } };
__device__ __forceinline__ void p4d_moe2_pg8(Frame& F, int l) {
    LAS int* tb = (LAS int*)(F.lds + TB_OFF);
    const int ntile = build_tile_table(F, tb);
    Moe2Sched S{(const char*)(F.ws + WS_HS), (const char*)(F.ws + WS_W2TB) + (size_t)l * NBUCKET * D * 512 * 2, tb, ntile, F.G, F.wg};
    EpiMoe2 E{F.out, (bf16*)(F.ws + WS_XB), (const int*)(F.ws + WS_IDX)};
    pg8::gemm_phase<EpiMoe2, Moe2Sched, true, 0>(F.lds, S, E, F.tid);
}

__device__ __forceinline__ void p_rowstats(Frame& F) {
    const float* X = F.out; float* rinv = (float*)(F.ws + WS_RINV1);
    for (int m0 = 4 * F.gw; m0 < M; m0 += 4 * F.NGW) {
        f32x4 v[4][4];
#pragma unroll
        for (int a = 0; a < 4; ++a) { const f32x4* xr = (const f32x4*)(X + (size_t)(m0 + a) * D) + F.lane;
#pragma unroll
            for (int j = 0; j < 4; ++j) v[a][j] = xr[64 * j]; }
        float t[4];
#pragma unroll
        for (int a = 0; a < 4; ++a) { float s = 0.f;
#pragma unroll
            for (int j = 0; j < 4; ++j) s += (v[a][j].x * v[a][j].x + v[a][j].y * v[a][j].y) + (v[a][j].z * v[a][j].z + v[a][j].w * v[a][j].w);
            t[a] = wave_sum(s, F.lane); }
        if (F.lane < 4) { const float s = F.lane == 0 ? t[0] : (F.lane == 1 ? t[1] : (F.lane == 2 ? t[2] : t[3])); rinv[m0 + F.lane] = 1.0f / sqrtf(s * (1.0f / D) + NORM_EPS); }
    }
}
__device__ __forceinline__ void p_final_norm(Frame& F) {
    float* X = F.out;
    const f32x4* gp = (const f32x4*)F.in[I_FNG] + F.lane; f32x4 gv[4];
#pragma unroll
    for (int j = 0; j < 4; ++j) gv[j] = gp[64 * j];
    for (int m0 = 4 * F.gw; m0 < M; m0 += 4 * F.NGW) {
        f32x4 v[4][4];
#pragma unroll
        for (int a = 0; a < 4; ++a) { const f32x4* xr = (const f32x4*)(X + (size_t)(m0 + a) * D) + F.lane;
#pragma unroll
            for (int j = 0; j < 4; ++j) v[a][j] = xr[64 * j]; }
#pragma unroll
        for (int a = 0; a < 4; ++a) { float s = 0.f;
#pragma unroll
            for (int j = 0; j < 4; ++j) s += (v[a][j].x * v[a][j].x + v[a][j].y * v[a][j].y) + (v[a][j].z * v[a][j].z + v[a][j].w * v[a][j].w);
            s = wave_sum(s, F.lane); const float ri = 1.0f / sqrtf(s * (1.0f / D) + NORM_EPS);
            f32x4* xw = (f32x4*)(X + (size_t)(m0 + a) * D) + F.lane;
#pragma unroll
            for (int j = 0; j < 4; ++j) xw[64 * j] = v[a][j] * ri * gv[j]; }
    }
}

__device__ __forceinline__ bool fresh(Frame& F) {
    int t = threadIdx.x; asm volatile("" : "+v"(t));
    F.tid = t; F.lane = t & 63; F.wave = __builtin_amdgcn_readfirstlane(t >> 6); F.gw = F.wg * NWAVES + F.wave;
    const __attribute__((address_space(4))) Args* ap = (const __attribute__((address_space(4))) Args*)__builtin_amdgcn_kernarg_segment_ptr();
    asm volatile("" : "+s"(ap));
    F.in = ap->in; F.out = ap->out; F.ws = ap->ws;
    return true;
}
__global__ void __launch_bounds__(NTHREADS, 2) fwd(Args args) {
    extern __shared__ __attribute__((aligned(16))) unsigned char lds[];
    Frame F;
    F.lds = (LAS unsigned char*)lds;
    volatile LAS unsigned* MISC = (volatile LAS unsigned*)(F.lds + MISC_OFF);
    if (threadIdx.x < 32) MISC[threadIdx.x] = 0u;
    __syncthreads();
    F.tid = threadIdx.x; F.lane = F.tid & 63; F.wave = __builtin_amdgcn_readfirstlane(F.tid >> 6);
    F.wg = blockIdx.x; F.gw = F.wg * NWAVES + F.wave;
    F.in = nullptr; F.out = args.out; F.ws = args.ws;
    unsigned* ctl = (unsigned*)(F.ws + WS_CTL);
    XcdBarrier bar; bar.bar = ctl + CW_BAR; bar.x = 0; bar.st = nullptr;
    if (!MK_PER_PHASE) bar = xcd_barrier_post(ctl + CW_BAR, MISC + 8, F.tid == 0);
    const int lo = args.ph_lo, hi = args.ph_hi;
#define IN(k) (lo <= (k) && (k) < hi && fresh(F))
#define SEAM(k) do { if (IN(k) && IN((k) + 1)) xcd_barrier(bar, F.tid == 0); } while (0)

#ifndef DUP_MASK
#define DUP_MASK 0
#endif
#define RUN(k, body) do { int reps_ = 1 + ((DUP_MASK >> (k)) & 1); if (DUP_MASK) asm volatile("" : "+s"(reps_)); for (int rep_ = 0; rep_ < reps_; ++rep_) { body; if (DUP_MASK) __syncthreads(); } } while (0)
    if (IN(0)) { RUN(0, p0_prologue(F)); } SEAM(0);
    for (int l = 0; l < DEPTH; ++l) {
        const int pb = 1 + 10 * l;
        if (IN(pb + 0)) { RUN(1, p1_inproj_pg8(F, l)); } SEAM(pb + 0);
        if (IN(pb + 1)) { RUN(2, lru_mfma(F, l)); RUN(3, s5_mfma(F, l)); RUN(4, attn_mfma(F, l)); } SEAM(pb + 1);
        if (IN(pb + 2)) { RUN(5, p3a_glu_pg8(F, l)); } SEAM(pb + 2);
        if (IN(pb + 3)) { RUN(6, p3b_mix_pg8(F, l)); } SEAM(pb + 3);
        if (IN(pb + 4)) { p3c_outproj_pg8(F, l); } SEAM(pb + 4);
        if (IN(pb + 5)) { RUN(8, p4a_router(F, l)); } SEAM(pb + 5);
        if (IN(pb + 6)) { RUN(9, p4b_positions(F)); } SEAM(pb + 6);
        if (IN(pb + 7)) { RUN(10, p4c_moe1_pg8(F, l)); } SEAM(pb + 7);
        if (IN(pb + 8)) { p4d_moe2_pg8(F, l); } SEAM(pb + 8);
        if (IN(pb + 9)) { if (l == DEPTH - 1) p_final_norm(F); else { RUN(12, p_rowstats(F)); } }
        if (l < DEPTH - 1) SEAM(pb + 9);
    }
#undef IN
#undef SEAM
}

extern "C" void kernel_launch(void* const* d_in, const int* in_sizes, int n_in, void* d_out, int out_size, void* d_ws, size_t ws_size, hipStream_t stream) {
    static int grid = 0;
    if (grid == 0) {
        if (n_in != 32 || out_size != M * D || ws_size < WS_END) { fprintf(stderr, "kernel_launch: unexpected shapes (n_in %d, out %d, ws %zu)\n", n_in, out_size, ws_size); grid = -1; return; }
        if (hipFuncSetAttribute((const void*)fwd, hipFuncAttributeMaxDynamicSharedMemorySize, LDS_BYTES) != hipSuccess) { fprintf(stderr, "kernel_launch: hipFuncSetAttribute failed\n"); grid = -1; return; }
        int per_cu = 0;
        if (hipOccupancyMaxActiveBlocksPerMultiprocessor(&per_cu, (const void*)fwd, NTHREADS, LDS_BYTES) != hipSuccess || per_cu < 1) fprintf(stderr, "kernel_launch: occupancy query reports %d\n", per_cu);
        (void)hipGetLastError();
        grid = 256;
    }
    if (grid < 0) return;
    (void)hipMemsetAsync((char*)d_ws + WS_CTL, 0, CTL_ZERO_BYTES, stream);
    Args a{};
    for (int i = 0; i < 32; ++i) a.in[i] = (const float*)d_in[i];
    a.out = (float*)d_out; a.ws = (unsigned char*)d_ws; a.pad = 0;
#if MK_PER_PHASE
    for (int p = 0; p < NPHASE; ++p) { a.ph_lo = p; a.ph_hi = p + 1; a.li = p; hipLaunchKernelGGL(fwd, dim3(grid), dim3(NTHREADS), LDS_BYTES, stream, a); }
#else
    a.ph_lo = 0; a.ph_hi = NPHASE; a.li = 0;
    hipLaunchKernelGGL(fwd, dim3(grid), dim3(NTHREADS), LDS_BYTES, stream, a);
#endif
}
```

```cpp
#include <hip/hip_runtime.h>
#include <cstdio>
#include <cstdint>

#ifndef MK_PER_PHASE
#define MK_PER_PHASE 0
#endif

constexpr int D = 1024, BATCH = 16, SEQ = 2048, M = BATCH * SEQ, DEPTH = 2;
constexpr int NQ = 8, HD = 64, WIN = 128;
constexpr int BW = 512;
constexpr int ZC = 2304;
constexpr int IN_COLS = 5376;
constexpr int COL_Q = 0, COL_K = 512, COL_V = 640, COL_XR = 768, COL_GR = 1280, COL_U = 1792, COL_GATES = 2304;
constexpr int NBUCKET = 24;
constexpr int MS_MAX = (128 + NBUCKET) * 256;
constexpr float NORM_EPS = 1e-6f;
constexpr int NWAVES = 8, NTHREADS = 512;
constexpr int NPHASE = 21;

constexpr size_t MiB = 1u << 20;
constexpr size_t WS_CTL = 0, CTL_ZERO_BYTES = 1 * MiB;
constexpr size_t WS_RINV1 = 1 * MiB;
constexpr size_t WS_RINV2 = WS_RINV1 + 128 * 1024;
constexpr size_t WS_BUCKET = WS_RINV2 + 128 * 1024;
constexpr size_t WS_RANK = WS_BUCKET + 128 * 1024;
constexpr size_t WS_WTOK = WS_RANK + 128 * 1024;
constexpr size_t WS_HIST = WS_WTOK + 256 * 1024;
constexpr size_t WS_BBASE = WS_HIST + 32 * 1024;
constexpr size_t WS_IDX = WS_BBASE + 1024;
constexpr size_t WS_WSORT = WS_IDX + 160 * 1024;
constexpr size_t WS_RSORT = WS_WSORT + 320 * 1024;
constexpr size_t WS_S5TBL = 3 * MiB;
constexpr size_t WS_WRT = 5 * MiB;
constexpr size_t WS_LRUF = 7 * MiB;
constexpr size_t WS_WINT = 8 * MiB;
constexpr size_t WS_WGLUT = 29 * MiB;
constexpr size_t WS_WBRT = 31 * MiB;
constexpr size_t WS_WOUTT = 37 * MiB;
constexpr size_t WS_W13T = 41 * MiB;
constexpr size_t WS_W2TB = 73 * MiB;
constexpr size_t WS_S5MAT = 121 * MiB;
constexpr size_t WS_S5LAM = 6 * MiB;
constexpr size_t WS_XB = 145 * MiB;
constexpr size_t WS_Z1 = 209 * MiB;
constexpr size_t WS_MIXED = 209 * MiB;
constexpr size_t WS_HS = 273 * MiB;
constexpr size_t WS_OA = 353 * MiB, WS_OL = 385 * MiB, WS_YS = 417 * MiB, WS_OS = 449 * MiB;
constexpr size_t WS_END = 481 * MiB;
static_assert(WS_WSORT + (size_t)MS_MAX * 8 <= WS_RSORT && WS_RSORT + (size_t)MS_MAX * 4 <= WS_S5TBL, "small region");
constexpr size_t WS_P3BSCR = 273 * MiB;
constexpr int TB_OFF = 163840 - 2048;
static_assert(WS_Z1 + (size_t)M * ZC * 2 <= WS_OA, "z1");
static_assert(WS_HS + (size_t)MS_MAX * 512 * 2 <= WS_OA, "hs");

constexpr int CW_BAR = 4096;
constexpr int LDS_BYTES = 163840;
constexpr int MISC_OFF = 163840 - 256;

#define LAS __attribute__((address_space(3)))
typedef unsigned short bf16;
typedef short bf16x8 __attribute__((ext_vector_type(8)));
typedef float f32x4 __attribute__((ext_vector_type(4)));
typedef unsigned u32x4 __attribute__((ext_vector_type(4)));
typedef unsigned u32x2 __attribute__((ext_vector_type(2)));

__device__ __forceinline__ float bf2f(bf16 b) { return __uint_as_float(((unsigned)b) << 16); }
__device__ __forceinline__ unsigned f2bf(float f) { unsigned u = __float_as_uint(f); return (u + 0x7fffu + ((u >> 16) & 1u)) >> 16; }
__device__ __forceinline__ unsigned pk2(float lo, float hi) { return f2bf(lo) | (f2bf(hi) << 16); }
typedef __bf16 hwbf16x2 __attribute__((ext_vector_type(2)));
__device__ __forceinline__ unsigned pk2hw(float lo, float hi) { hwbf16x2 v; v.x = (__bf16)lo; v.y = (__bf16)hi; return __builtin_bit_cast(unsigned, v); }
__device__ __forceinline__ float sigmoidf_(float x) { return __builtin_amdgcn_rcpf(1.0f + __builtin_amdgcn_exp2f(-1.4426950408889634f * x)); }
__device__ __forceinline__ float gelu_tanh(float x) { return x * sigmoidf_(1.5957691216057308f * (x + 0.044715f * x * x * x)); }
template <int N> __device__ __forceinline__ float dpp_ror(float v) { return __int_as_float(__builtin_amdgcn_update_dpp(0, __float_as_int(v), 0x120 + N, 0xf, 0xf, false)); }
__device__ __forceinline__ float rlane(float v, int l) { return __int_as_float(__builtin_amdgcn_readlane(__float_as_int(v), l)); }
__device__ __forceinline__ float wave_sum(float v, int  ) {
    v += dpp_ror<8>(v); v += dpp_ror<4>(v); v += dpp_ror<2>(v); v += dpp_ror<1>(v);
    return (rlane(v, 0) + rlane(v, 16)) + (rlane(v, 32) + rlane(v, 48));
}
__device__ __forceinline__ float lane_xor(float v, int lane, int o) { return __int_as_float(__builtin_amdgcn_ds_bpermute((lane ^ o) << 2, __float_as_int(v))); }
#define LDS_WAIT() asm volatile("s_waitcnt lgkmcnt(0)" ::: "memory")

#define XB_TMO      128
#define XB_XCNT(j)  (256  + 64 * (j))
#define XB_XSUB(j)  (1280 + 64 * (j))
#define XB_XGEN(j)  (2304 + 64 * (j))
#define XB_TOP      3328
#define XB_TOPGEN   3392
#define XCD_BAR_WORDS 3456
#define XB_SPIN_CAP (1u << 20)
__device__ __forceinline__ unsigned xb_ld(unsigned* p)              { return __hip_atomic_load(p, __ATOMIC_RELAXED, __HIP_MEMORY_SCOPE_AGENT); }
__device__ __forceinline__ unsigned xb_add(unsigned* p, unsigned v) { return __hip_atomic_fetch_add(p, v, __ATOMIC_RELAXED, __HIP_MEMORY_SCOPE_AGENT); }
__device__ __forceinline__ unsigned xb_xcc_id() { return (unsigned)__builtin_amdgcn_s_getreg((3 << 11) | 20) & 0xFu; }
#define XB_SPIN(cond, bar) do { unsigned _sp = 0; while (cond) { __builtin_amdgcn_s_sleep(1); \
    if ((++_sp & 255u) == 0u) { if (xb_ld(&(bar)[XB_TMO])) break; if (_sp > XB_SPIN_CAP) { atomicAdd(&(bar)[XB_TMO], 1u); break; } } } } while (0)
struct XcdBarrier { unsigned* bar; unsigned x; volatile LAS unsigned* st; };
__device__ __forceinline__ XcdBarrier xcd_barrier_post(unsigned* bar, volatile LAS unsigned* st, bool leader) {
    XcdBarrier b; b.bar = bar; b.x = xb_xcc_id(); b.st = st;
    if (leader) (void)xb_add(&bar[XB_XCNT(b.x)], 1u);
    return b;
}
__device__ __forceinline__ void xcd_barrier_complete(unsigned* bar, unsigned x, unsigned& nloc, unsigned& nx) {
    const unsigned G = gridDim.x * gridDim.y * gridDim.z;
    unsigned sum, cnt, mine, sp = 0u;
    for (;;) {
        sum = 0u; cnt = 0u; mine = 0u;
#pragma unroll
        for (unsigned j = 0; j < 16; ++j) { const unsigned c = xb_ld(&bar[XB_XCNT(j)]); sum += c; cnt += (c > 0u) ? 1u : 0u; mine = (j == x) ? c : mine; }
        if (sum == G) break;
        __builtin_amdgcn_s_sleep(1);
        if ((++sp & 255u) == 0u) { if (xb_ld(&bar[XB_TMO])) break; if (sp > XB_SPIN_CAP) { atomicAdd(&bar[XB_TMO], 1u); break; } }
    }
    nloc = mine > 0u ? mine : 1u; nx = cnt > 0u ? cnt : 1u;
}
__device__ __forceinline__ void xcd_barrier(const XcdBarrier& b, bool leader) {
    asm volatile("s_waitcnt vmcnt(0)" ::: "memory");
    __syncthreads();
    if (leader) {
        unsigned* bar = b.bar;
        __builtin_amdgcn_s_waitcnt(0);
        unsigned nloc = b.st[0], nx = b.st[1];
        if (nloc == 0u) { xcd_barrier_complete(bar, b.x, nloc, nx); b.st[0] = nloc; b.st[1] = nx; }
        const unsigned old = xb_add(&bar[XB_XSUB(b.x)], 1u);
        const unsigned gen = old / nloc;
        if (old + 1u == (gen + 1u) * nloc) {
            __builtin_amdgcn_fence(__ATOMIC_RELEASE, "agent");
            asm volatile("s_waitcnt vmcnt(0)" ::: "memory");
            const unsigned og = xb_add(&bar[XB_TOP], 1u);
            const unsigned tg = og / nx;
            if (og + 1u == (tg + 1u) * nx) xb_add(&bar[XB_TOPGEN], 1u);
            else XB_SPIN(xb_ld(&bar[XB_TOPGEN]) == tg, bar);
            __builtin_amdgcn_fence(__ATOMIC_ACQUIRE, "agent");
            xb_add(&bar[XB_XGEN(b.x)], 1u);
            asm volatile("s_waitcnt vmcnt(0)" ::: "memory");
        } else {
            XB_SPIN(xb_ld(&bar[XB_XGEN(b.x)]) == gen, bar);
            __builtin_amdgcn_fence(__ATOMIC_ACQUIRE, "agent");
            asm volatile("s_waitcnt vmcnt(0)" ::: "memory");
        }
    }
    __syncthreads();
}

struct Args { const float* in[32]; float* out; unsigned char* ws; int ph_lo, ph_hi, li, pad; };
struct Frame {
    LAS unsigned char* lds;
    int tid, lane, wave, wg, gw;
    static constexpr int G = 256, NGW = 256 * NWAVES;
    const float* const __attribute__((address_space(4)))* in;
    float* out; unsigned char* ws;
};
enum { I_X = 0, I_N1G, I_WIN, I_SINK, I_CONVW, I_CONVB, I_LWR, I_LBR, I_LWI, I_LBI, I_LAM, I_ARE, I_AIM, I_LSTEP, I_BRE, I_BIM, I_CRE, I_CIM, I_SD, I_WGLU, I_BGLU,
       I_WBR, I_WOUT, I_N2G, I_WG, I_BG, I_WE, I_BE, I_W1, I_W3, I_W2, I_FNG };

__device__ __forceinline__ void pair_of(int p, int& a, int& b) {
    a = (p < 3) ? 0 : (p < 5 ? 1 : 2); b = (p < 3) ? p + 1 : (p < 5 ? p - 1 : 3);
}
__device__ __forceinline__ int pair_index(int a, int b) {
    return (a == 0) ? (b - 1) : (a == 1 ? (b + 1) : 5);
}


namespace pg8 {
typedef unsigned short bf16_t;
constexpr int BM = 256, BK = 64, HALF = 128, HTB = HALF * BK * 2, STAGE_BYTES = 8 * HTB, NXCD = 8, WGM = 8;
__host__ __device__ __forceinline__ int lds_byte(int r, int c) { const int st = (r >> 4) * 2 + (c >> 5), rr = r & 15, cc = c & 31, ob = rr * 64 + cc * 2; return st * 1024 + (ob ^ (((ob >> 9) & 1) << 5)); }
__host__ __device__ __forceinline__ void stage_rc(int b, int& R, int& C) { const int st = b / 1024, sb = b % 1024, swz = sb ^ (((sb >> 9) & 1) << 5); R = (st >> 1) * 16 + swz / 64; C = (st & 1) * 32 + (swz % 64) / 2; }
__host__ __device__ __forceinline__ int perm32(int rho) { const int n = rho >> 4, i = rho & 15; return 8 * (i >> 2) + 4 * n + (i & 3); }

struct Unit { int pm, pn, aux; int nt; unsigned lda2, ldb2; const char* A; const char* B; };

__device__ __forceinline__ void static_tile(int L, int nM, int nN, int& pm, int& pn) {
    const int nwg = nM * nN; int wgid = L; { const int q = nwg / NXCD, r = nwg % NXCD, xcd = wgid % NXCD, off = wgid / NXCD; wgid = (xcd < r ? xcd * (q + 1) : r * (q + 1) + (xcd - r) * q) + off; }
    const int nig = WGM * nN, gid = wgid / nig, fm = gid * WGM, gsz = (nM - fm) < WGM ? (nM - fm) : WGM;
    pm = fm + ((wgid % nig) % gsz); pn = (wgid % nig) / gsz;
}

template <class Epi, class Sched, bool ALIGN_EPI, int MODE>
__device__ __forceinline__ void gemm_phase(LAS unsigned char* lds, const Sched& S, const Epi& E, int tid) {
    const int wid = __builtin_amdgcn_readfirstlane(tid >> 6), lane = tid & 63, wr = wid >> 2, wc = wid & 3, fr = lane & 15, fq = lane >> 4;
    unsigned RA[2], C2[2];
#pragma unroll
    for (int i = 0; i < 2; ++i) { int R, C; stage_rc(tid * 16 + i * 8192, R, C); RA[i] = (unsigned)R; C2[i] = (unsigned)C * 2u; }
    const unsigned ldsw = (unsigned)wid * 1024u;
    const int aoff = lds_byte(wr * 64 + fr, fq * 8), boff = lds_byte(wc * 32 + fr, fq * 8);
#define PG8_SA(b, h) (((b) * 2 + (h)) * HTB)
#define PG8_SB(b, h) ((4 + (b) * 2 + (h)) * HTB)
#define PG8_STAGE_A(bufoff, gbase, h, ld2, go) do { _Pragma("unroll") for (int _i = 0; _i < 2; ++_i) { \
        const unsigned _vo = (MODE == 2) ? ((go)[h][_i] + C2[_i]) : ((RA[_i] + 128u * (h)) * (ld2) + C2[_i]); \
        __builtin_amdgcn_global_load_lds((const unsigned*)((gbase) + _vo), (LAS unsigned*)(lds + (bufoff) + ldsw + _i * 8192), 16, 0, 0); } } while (0)
#define PG8_STAGE_B(bufoff, gbase, h, ld2) do { _Pragma("unroll") for (int _i = 0; _i < 2; ++_i) { \
        const unsigned _vo = (((RA[_i] & ~31u) + (unsigned)perm32((int)(RA[_i] & 31u))) + 128u * (h)) * (ld2) + C2[_i]; \
        __builtin_amdgcn_global_load_lds((const unsigned*)((gbase) + _vo), (LAS unsigned*)(lds + (bufoff) + ldsw + _i * 8192), 16, 0, 0); } } while (0)
#define PG8_LDA(dst, b, h) do { _Pragma("unroll") for (int m = 0; m < 4; ++m) _Pragma("unroll") for (int k = 0; k < 2; ++k) dst[m][k] = *(const LAS bf16x8*)(lds + PG8_SA(b, h) + aoff + m * 2048 + k * 1024); } while (0)
#define PG8_LDB(dst, b, h) do { _Pragma("unroll") for (int n = 0; n < 2; ++n) _Pragma("unroll") for (int k = 0; k < 2; ++k) dst[n][k] = *(const LAS bf16x8*)(lds + PG8_SB(b, h) + boff + n * 2048 + k * 1024); } while (0)
#define PG8_MMA(ai, bj, At, Bt) do { __builtin_amdgcn_s_setprio(1); _Pragma("unroll") for (int m = 0; m < 4; ++m) _Pragma("unroll") for (int n = 0; n < 2; ++n) _Pragma("unroll") for (int k = 0; k < 2; ++k) \
        acc[ai][bj][m][n] = __builtin_amdgcn_mfma_f32_16x16x32_bf16(Bt[n][k], At[m][k], acc[ai][bj][m][n], 0, 0, 0); __builtin_amdgcn_s_setprio(0); } while (0)
#define PG8_WAIT_V(n) asm volatile("s_waitcnt vmcnt(" #n ")" ::: "memory")
#define PG8_WAIT_L(n) asm volatile("s_waitcnt lgkmcnt(" #n ")" ::: "memory")
#define PG8_BAR __builtin_amdgcn_s_barrier()
#define PG8_SCHED __builtin_amdgcn_sched_barrier(0)
    Unit cur, nxt; int ui = 0;
    if (!S.next(0, cur)) return;
    f32x4 acc[2][2][4][2];
#pragma unroll
    for (int a = 0; a < 2; ++a)
#pragma unroll
        for (int b = 0; b < 2; ++b)
#pragma unroll
            for (int m = 0; m < 4; ++m)
#pragma unroll
                for (int n = 0; n < 2; ++n) acc[a][b][m][n] = (f32x4){0.f, 0.f, 0.f, 0.f};
    bf16x8 At[4][2], B0[2][2], B1[2][2];
    unsigned cgo[2][2] = {{0u, 0u}, {0u, 0u}}, ngo[2][2] = {{0u, 0u}, {0u, 0u}};
    if (MODE == 2) {
#pragma unroll
        for (int h = 0; h < 2; ++h)
#pragma unroll
            for (int i = 0; i < 2; ++i) cgo[h][i] = S.row_off(cur, h * 128 + (int)RA[i]);
    }
    const size_t kstep = (size_t)(BK * 2);
    const char* cA = cur.A; const char* cB = cur.B;
    PG8_STAGE_B(PG8_SB(0, 0), cB, 0, cur.ldb2); PG8_STAGE_B(PG8_SB(0, 1), cB, 1, cur.ldb2); PG8_STAGE_A(PG8_SA(0, 0), cA, 0, cur.lda2, cgo); PG8_STAGE_A(PG8_SA(0, 1), cA, 1, cur.lda2, cgo);
    if (wr == 1) PG8_BAR;
    PG8_WAIT_V(2); PG8_BAR;
    PG8_STAGE_B(PG8_SB(1, 0), cB + kstep, 0, cur.ldb2); PG8_STAGE_A(PG8_SA(1, 0), cA + kstep, 0, cur.lda2, cgo); PG8_STAGE_B(PG8_SB(1, 1), cB + kstep, 1, cur.ldb2);
    PG8_WAIT_V(6); PG8_BAR;
    for (;;) {
        const bool has_next = S.next(ui + 1, nxt);
        if (!has_next) nxt = cur;
        if (MODE == 2) {
#pragma unroll
            for (int h = 0; h < 2; ++h)
#pragma unroll
                for (int i = 0; i < 2; ++i) ngo[h][i] = has_next ? S.row_off(nxt, h * 128 + (int)RA[i]) : cgo[h][i];
        }
        const char* nA = nxt.A; const char* nB = nxt.B;
        const int nt = cur.nt;
        for (int t = 0; t < nt; t += 2) {
            const bool last = (t == nt - 2);
            const char* a1 = cA + (size_t)(t + 1) * kstep;
            const char* a2 = last ? nA : cA + (size_t)(t + 2) * kstep; const char* b2 = last ? nB : cB + (size_t)(t + 2) * kstep;
            const char* a3 = a2 + kstep; const char* b3 = b2 + kstep;
            const unsigned la2 = last ? nxt.lda2 : cur.lda2, lb2 = last ? nxt.ldb2 : cur.ldb2;
            unsigned go2[2][2];
#pragma unroll
            for (int h = 0; h < 2; ++h)
#pragma unroll
                for (int i = 0; i < 2; ++i) go2[h][i] = last ? ngo[h][i] : cgo[h][i];
            PG8_LDB(B0, 0, 0); PG8_LDB(B1, 0, 1); PG8_SCHED; PG8_LDA(At, 0, 0); PG8_STAGE_A(PG8_SA(1, 1), a1, 1, cur.lda2, cgo);
            PG8_WAIT_V(8); PG8_WAIT_L(0); PG8_BAR; PG8_MMA(0, 0, At, B0); PG8_MMA(0, 1, At, B1); PG8_BAR; PG8_SCHED;
            PG8_LDA(At, 0, 1); PG8_STAGE_B(PG8_SB(0, 0), b2, 0, lb2); PG8_STAGE_B(PG8_SB(0, 1), b2, 1, lb2); PG8_STAGE_A(PG8_SA(0, 0), a2, 0, la2, go2);
            PG8_WAIT_V(8); PG8_WAIT_L(0); PG8_BAR; PG8_MMA(1, 0, At, B0); PG8_MMA(1, 1, At, B1); PG8_BAR; PG8_SCHED;
            PG8_LDB(B0, 1, 0); PG8_LDB(B1, 1, 1); PG8_SCHED; PG8_LDA(At, 1, 0); PG8_STAGE_A(PG8_SA(0, 1), a2, 1, la2, go2);
            PG8_WAIT_V(8); PG8_WAIT_L(0); PG8_BAR; PG8_MMA(0, 0, At, B0); PG8_MMA(0, 1, At, B1); PG8_BAR; PG8_SCHED;
            PG8_LDA(At, 1, 1); PG8_STAGE_B(PG8_SB(1, 0), b3, 0, lb2); PG8_STAGE_B(PG8_SB(1, 1), b3, 1, lb2); PG8_STAGE_A(PG8_SA(1, 0), a3, 0, la2, go2);
            PG8_WAIT_V(8); PG8_WAIT_L(0); PG8_BAR; PG8_MMA(1, 0, At, B0); PG8_MMA(1, 1, At, B1); PG8_BAR; PG8_SCHED;
        }
        if constexpr (ALIGN_EPI) { if (wr == 0) PG8_BAR; }
        const bool keep = E(acc, cur, wr, wc, fr, fq);
        if (!has_next) break;
        if (!keep) {
#pragma unroll
            for (int a = 0; a < 2; ++a)
#pragma unroll
                for (int b = 0; b < 2; ++b)
#pragma unroll
                    for (int m = 0; m < 4; ++m)
#pragma unroll
                        for (int n = 0; n < 2; ++n) acc[a][b][m][n] = (f32x4){0.f, 0.f, 0.f, 0.f};
        }
        cur = nxt; cA = nA; cB = nB; ++ui;
        if (MODE == 2) {
#pragma unroll
            for (int h = 0; h < 2; ++h)
#pragma unroll
                for (int i = 0; i < 2; ++i) cgo[h][i] = ngo[h][i];
        }
        if constexpr (ALIGN_EPI) { if (wr == 1) PG8_BAR; }
    }
    PG8_WAIT_V(0);
    if constexpr (!ALIGN_EPI) { if (wr == 0) PG8_BAR; }
    PG8_BAR;
#undef PG8_SA
#undef PG8_SB
#undef PG8_STAGE_A
#undef PG8_STAGE_B
#undef PG8_LDA
#undef PG8_LDB
#undef PG8_MMA
#undef PG8_WAIT_V
#undef PG8_WAIT_L
#undef PG8_BAR
#undef PG8_SCHED
}
}

__device__ __forceinline__ unsigned cvt_pk_bf16(float lo, float hi) { unsigned r; asm volatile("v_cvt_pk_bf16_f32 %0, %1, %2" : "=v"(r) : "v"(lo), "v"(hi)); return r; }
__device__ __forceinline__ u32x4 pack8(const f32x4& v0, const f32x4& v1) { u32x4 w; w.x = cvt_pk_bf16(v0[0], v0[1]); w.y = cvt_pk_bf16(v0[2], v0[3]); w.z = cvt_pk_bf16(v1[0], v1[1]); w.w = cvt_pk_bf16(v1[2], v1[3]); return w; }
__device__ __forceinline__ void unpack8(const u32x4& w, f32x4& v0, f32x4& v1) {
    v0[0] = __uint_as_float(w.x << 16); v0[1] = __uint_as_float(w.x & 0xffff0000u); v0[2] = __uint_as_float(w.y << 16); v0[3] = __uint_as_float(w.y & 0xffff0000u);
    v1[0] = __uint_as_float(w.z << 16); v1[1] = __uint_as_float(w.z & 0xffff0000u); v1[2] = __uint_as_float(w.w << 16); v1[3] = __uint_as_float(w.w & 0xffff0000u); }

struct DenseSched {
    const char* A; const char* B; int nM, nN, G, c, nt; unsigned lda2, ldb2;
    __device__ __forceinline__ bool next(int i, pg8::Unit& u) const {
        const int L = i * G + c; if (L >= nM * nN) return false;
        pg8::static_tile(L, nM, nN, u.pm, u.pn); u.aux = 0; u.nt = nt; u.lda2 = lda2; u.ldb2 = ldb2;
        u.A = A + (size_t)u.pm * 256 * lda2; u.B = B + (size_t)u.pn * 256 * ldb2; return true;
    }
    __device__ __forceinline__ unsigned row_off(const pg8::Unit&, int) const { return 0u; }
};

template <int MAP>
__device__ __forceinline__ int rowmap(int n) { if (MAP == 0) return n; return (n >> 7) * 256 + (n & 127) + (MAP == 2 ? 128 : 0); }
template <int MAP>
__device__ __forceinline__ void transpose_item(const float* W, int N, int ncol0, const float* gain, bf16* dst, int dld, int dcol0, LAS float* scr, int kb, int nb, int lane) {
    const int k0 = 64 * kb, n0 = 32 * nb;
    float tv_[32];
#pragma unroll
    for (int i = 0; i < 32; ++i) tv_[i] = W[(size_t)(k0 + 2 * i + (lane >> 5)) * N + ncol0 + n0 + (lane & 31)];
    if (gain) {
#pragma unroll
        for (int i = 0; i < 32; ++i) tv_[i] *= gain[k0 + 2 * i + (lane >> 5)];
    }
#pragma unroll
    for (int i = 0; i < 32; ++i) scr[(2 * i + (lane >> 5)) * 33 + (lane & 31)] = tv_[i];
    LDS_WAIT();
    const int c = lane & 7;
#pragma unroll
    for (int j = 0; j < 4; ++j) { const int n = (lane >> 3) + 8 * j; const LAS float* s = scr + (8 * c) * 33 + n;
        u32x4 o; o.x = pk2(s[0 * 33], s[1 * 33]); o.y = pk2(s[2 * 33], s[3 * 33]); o.z = pk2(s[4 * 33], s[5 * 33]); o.w = pk2(s[6 * 33], s[7 * 33]);
        *(u32x4*)(dst + (size_t)rowmap<MAP>(n0 + n) * dld + dcol0 + k0 + 8 * c) = o; }
    LDS_WAIT();
}

__device__ __forceinline__ void s5_setup_item(Frame& F, int l, int g);
#ifndef P0_LAYERS
#define P0_LAYERS 1
#endif
__device__ __forceinline__ void p0_weights(Frame& F, int l0, int l1, int worker, int nworkers) {
    LAS float* scr = (LAS float*)(F.lds + F.wave * 16384);
    unsigned char* ws = F.ws;
    constexpr int IT_WIN = 16 * 168, IT_GLU = 8 * 16 * 2, IT_BR = 3 * 8 * 32, IT_OUT = 16 * 32, IT_W13 = 16 * 2 * 16 * 8, IT_W2 = 48 * 4 * 32;
    constexpr int IT_LAYER = IT_WIN + IT_GLU + IT_BR + IT_OUT + IT_W13 + IT_W2;
    for (int it = l0 * IT_LAYER + worker; it < l1 * IT_LAYER; it += nworkers) {
        const int l = it / IT_LAYER; int r = it % IT_LAYER;
        if (r < IT_WIN) { transpose_item<0>(F.in[I_WIN] + (size_t)l * D * IN_COLS, IN_COLS, 0, F.in[I_N1G] + l * D, (bf16*)(ws + WS_WINT) + (size_t)l * IN_COLS * D, D, 0, scr, r / 168, r % 168, F.lane); continue; }
        r -= IT_WIN;
        if (r < IT_GLU) { const int half = r / (8 * 16); const int q = r % (8 * 16);
            const float* W = F.in[I_WGLU] + (size_t)l * BW * 1024; bf16* dst = (bf16*)(ws + WS_WGLUT) + (size_t)l * 1024 * BW;
            if (half == 0) transpose_item<1>(W, 1024, 0, nullptr, dst, BW, 0, scr, q / 16, q % 16, F.lane);
            else           transpose_item<2>(W, 1024, 512, nullptr, dst, BW, 0, scr, q / 16, q % 16, F.lane);
            continue; }
        r -= IT_GLU;
        if (r < IT_BR) { const int k = r / 256, q = r % 256; transpose_item<0>(F.in[I_WBR] + ((size_t)l * 3 + k) * BW * D, D, 0, nullptr, (bf16*)(ws + WS_WBRT) + ((size_t)l * 3 + k) * D * BW, BW, 0, scr, q / 32, q % 32, F.lane); continue; }
        r -= IT_BR;
        if (r < IT_OUT) { transpose_item<0>(F.in[I_WOUT] + (size_t)l * D * D, D, 0, nullptr, (bf16*)(ws + WS_WOUTT) + (size_t)l * D * D, D, 0, scr, r / 32, r % 32, F.lane); continue; }
        r -= IT_OUT;
        if (r < IT_W13) { const int ge = r / 256, q = r % 256, which = q / 128, qq = q % 128;
            const float* W = F.in[which ? I_W3 : I_W1] + ((size_t)l * 16 + ge) * D * 256; bf16* dst = (bf16*)(ws + WS_W13T) + ((size_t)l * 16 + ge) * 512 * D;
            if (which == 0) transpose_item<1>(W, 256, 0, F.in[I_N2G] + l * D, dst, D, 0, scr, qq / 8, qq % 8, F.lane);
            else            transpose_item<2>(W, 256, 0, F.in[I_N2G] + l * D, dst, D, 0, scr, qq / 8, qq % 8, F.lane);
            continue; }
        r -= IT_W13;
        { const int bs = r / 128, q = r % 128, bucket = bs >> 1, slot = bs & 1, g = bucket / 6; int pa, pb; pair_of(bucket % 6, pa, pb);
          const int e = g * 4 + (slot ? pb : pa);
          transpose_item<0>(F.in[I_W2] + ((size_t)l * 16 + e) * 256 * D, D, 0, nullptr, (bf16*)(ws + WS_W2TB) + ((size_t)l * NBUCKET + bucket) * D * 512, 512, slot * 256, scr, q / 32, q % 32, F.lane); }
    }
}
__device__ __forceinline__ void p0_prologue(Frame& F) {
    LAS float* scr = (LAS float*)(F.lds + F.wave * 16384);
    unsigned char* ws = F.ws;
    if (F.wg < DEPTH * 32) { s5_setup_item(F, F.wg >> 5, F.wg & 31); return; }
    const int gwx = (F.wg - DEPTH * 32) * NWAVES + F.wave; constexpr int NGX = (256 - DEPTH * 32) * NWAVES;
    p0_weights(F, 0, P0_LAYERS, gwx, NGX);
    {
        const float* x = F.in[I_X]; bf16* XB = (bf16*)(ws + WS_XB); float* rinv = (float*)(ws + WS_RINV1);
        for (int m0 = 4 * gwx; m0 < M; m0 += 4 * NGX) {
            f32x4 v[4][4]; float s4[4];
#pragma unroll
            for (int a = 0; a < 4; ++a) { const f32x4* xr = (const f32x4*)(x + (size_t)(m0 + a) * D) + F.lane;
#pragma unroll
                for (int j = 0; j < 4; ++j) v[a][j] = xr[64 * j]; }
#pragma unroll
            for (int a = 0; a < 4; ++a) { float s = 0.f;
#pragma unroll
                for (int j = 0; j < 4; ++j) s += (v[a][j].x * v[a][j].x + v[a][j].y * v[a][j].y) + (v[a][j].z * v[a][j].z + v[a][j].w * v[a][j].w);
                s4[a] = wave_sum(s, F.lane);
                u32x2* o = (u32x2*)(XB + (size_t)(m0 + a) * D) + F.lane;
#pragma unroll
                for (int j = 0; j < 4; ++j) { u32x2 w; w.x = pk2(v[a][j].x, v[a][j].y); w.y = pk2(v[a][j].z, v[a][j].w); o[64 * j] = w; } }
            if (F.lane < 4) { const float s = F.lane == 0 ? s4[0] : (F.lane == 1 ? s4[1] : (F.lane == 2 ? s4[2] : s4[3])); rinv[m0 + F.lane] = 1.0f / sqrtf(s * (1.0f / D) + NORM_EPS); }
        }
    }
    {
        bf16* lf = (bf16*)(ws + WS_LRUF);
        for (int i = gwx * 64 + F.lane; i < DEPTH * 2 * 8 * 2 * 2 * 4 * 64; i += NGX * 64) {
            const int ln = i & 63, ks = (i >> 6) & 3, gate = (i >> 8) & 1, nh = (i >> 9) & 1, hb = (i >> 10) & 7, ld = i >> 13;
            const float* W = F.in[gate ? I_LWI : I_LWR] + ((size_t)ld * 8 + hb) * 4096 + nh * 32 + (ln & 31);
            const int k0 = 16 * ks + 8 * (ln >> 5);
            u32x4 o; o.x = pk2(W[(size_t)(k0 + 0) * 64], W[(size_t)(k0 + 1) * 64]); o.y = pk2(W[(size_t)(k0 + 2) * 64], W[(size_t)(k0 + 3) * 64]);
            o.z = pk2(W[(size_t)(k0 + 4) * 64], W[(size_t)(k0 + 5) * 64]); o.w = pk2(W[(size_t)(k0 + 6) * 64], W[(size_t)(k0 + 7) * 64]);
            *(u32x4*)(lf + (size_t)i * 8) = o;
        }
    }
    {
        float* wrt = (float*)(ws + WS_WRT);
        for (int i = gwx * 64 + F.lane; i < DEPTH * 20 * D; i += NGX * 64) {
            const int k = i % D, j = (i / D) % 20, l = i / (20 * D);
            const float g2 = F.in[I_N2G][l * D + k];
            wrt[i] = g2 * (j < 4 ? F.in[I_WG][((size_t)l * D + k) * 4 + j] : F.in[I_WE][((size_t)l * D + k) * 16 + (j - 4)]);
        }
    }
}

typedef float f32x16 __attribute__((ext_vector_type(16)));
#define MFMA32(a, b, c) __builtin_amdgcn_mfma_f32_32x32x16_bf16((a), (b), (c), 0, 0, 0)
constexpr int S5_ETAB = 0, S5_UIMG = 8192, S5_HIMG = 8192 + 67584, S5_CSTR = 528;

__device__ __forceinline__ void s5_setup_item(Frame& F, int l, int g) {
    LAS float* PW = (LAS float*)F.lds;
    LAS float* BB = PW + 4352;
    LAS float* CC = BB + 4096;
    LAS float* KT = CC + 2048;
    const int tid = F.tid;
    __syncthreads();
    for (int idx = tid; idx < 2 * 64 * 17; idx += NTHREADS) {
        const int d = idx / 1088, rem = idx % 1088, n = rem / 17, j = rem % 17, ld = l * 2 + d;
        const float are = F.in[I_ARE][(size_t)ld * 2048 + g * 64 + n], aim = F.in[I_AIM][(size_t)ld * 2048 + g * 64 + n];
        const float step = expf(F.in[I_LSTEP][ld * 32 + g]);
        const double ang1 = (double)aim * (double)step, lm1 = (double)are * (double)step;
        const double a = fmod(ang1 * j, 6.283185307179586); float sn, cs; sincosf((float)a, &sn, &cs); const float mg = expf((float)(lm1 * j));
        PW[((d * 64 + n) * 17 + j) * 2] = mg * cs; PW[((d * 64 + n) * 17 + j) * 2 + 1] = mg * sn;
    }
    if (tid < 128) {
        const int d = tid >> 6, n = tid & 63, ld = l * 2 + d;
        const float are = F.in[I_ARE][(size_t)ld * 2048 + g * 64 + n], aim = F.in[I_AIM][(size_t)ld * 2048 + g * 64 + n];
        const float step = expf(F.in[I_LSTEP][ld * 32 + g]);
        const double ang1 = (double)aim * (double)step, lm1 = (double)are * (double)step;
        float abr, abi;
        { const double a = fmod(ang1 * 1, 6.283185307179586); float sn, cs; sincosf((float)a, &sn, &cs); const float mg = expf((float)(lm1 * 1)); abr = mg * cs; abi = mg * sn; }
        { float* lam = (float*)(F.ws + WS_S5LAM) + ((((size_t)l * 32 + g) * 2 + d) * 64 + n) * 4;
          const double a16 = fmod(ang1 * 16.0, 6.283185307179586), a256 = fmod(ang1 * 256.0, 6.283185307179586); float sn, cs;
          sincosf((float)a16, &sn, &cs); const float m16 = expf((float)(lm1 * 16.0)); lam[0] = m16 * cs; lam[1] = m16 * sn;
          sincosf((float)a256, &sn, &cs); const float m256 = expf((float)(lm1 * 256.0)); lam[2] = m256 * cs; lam[3] = m256 * sn; }
        const float den = are * are + aim * aim, nr = abr - 1.0f;
        const float sr = (nr * are + abi * aim) / den, si = (abi * are - nr * aim) / den;
        const float* bre = F.in[I_BRE] + ((size_t)ld * 2048 + g * 64 + n) * 16; const float* bim = F.in[I_BIM] + ((size_t)ld * 2048 + g * 64 + n) * 16;
        for (int c = 0; c < 16; ++c) { BB[((d * 64 + n) * 16 + c) * 2] = sr * bre[c] - si * bim[c]; BB[((d * 64 + n) * 16 + c) * 2 + 1] = sr * bim[c] + si * bre[c]; }
    }
    for (int i = tid; i < 1024; i += NTHREADS) { CC[i * 2] = F.in[I_CRE][((size_t)l * 32 + g) * 1024 + i]; CC[i * 2 + 1] = F.in[I_CIM][((size_t)l * 32 + g) * 1024 + i]; }
    __syncthreads();
    {
        const int cp = tid & 15, dl = (tid >> 4) & 15, d = tid >> 8; float acc[16];
#pragma unroll
        for (int c = 0; c < 16; ++c) acc[c] = 0.f;
#pragma unroll 2
        for (int n = 0; n < 64; ++n) { const float cr = CC[(cp * 64 + n) * 2], ci = CC[(cp * 64 + n) * 2 + 1], pr = PW[((d * 64 + n) * 17 + dl) * 2], pi = PW[((d * 64 + n) * 17 + dl) * 2 + 1];
            const float gr = cr * pr - ci * pi, gi = cr * pi + ci * pr;
#pragma unroll
            for (int c = 0; c < 16; ++c) { const float br = BB[((d * 64 + n) * 16 + c) * 2], bi = BB[((d * 64 + n) * 16 + c) * 2 + 1]; acc[c] += gr * br - gi * bi; } }
#pragma unroll
        for (int c = 0; c < 16; ++c) KT[((d * 16 + dl) * 16 + cp) * 16 + c] = acc[c];
    }
    __syncthreads();
    bf16* WsF = (bf16*)(F.ws + WS_S5MAT) + ((size_t)l * 32 + g) * 196608; bf16* W3F = WsF + 65536;
    for (int q = tid; q < 8192; q += NTHREADS) {
        const int row = q >> 5, kc = (q & 31) * 8, s_ = kc >> 4, c0 = kc & 15;
        const int nn = row & 31, ri = (row >> 5) & 1, sh = (row >> 6) & 1, d = row >> 7, n = sh * 32 + nn, e = d ? s_ : 15 - s_;
        const float pr = PW[((d * 64 + n) * 17 + e) * 2], pi = PW[((d * 64 + n) * 17 + e) * 2 + 1]; float v[8];
#pragma unroll
        for (int j = 0; j < 8; ++j) { const float br = BB[((d * 64 + n) * 16 + c0 + j) * 2], bi = BB[((d * 64 + n) * 16 + c0 + j) * 2 + 1]; v[j] = ri ? (pr * bi + pi * br) : (pr * br - pi * bi); }
        u32x4 o; o.x = pk2(v[0], v[1]); o.y = pk2(v[2], v[3]); o.z = pk2(v[4], v[5]); o.w = pk2(v[6], v[7]);
        const int tile = row >> 5, ks = kc >> 4, ln = (row & 31) + 32 * ((kc >> 3) & 1);
        *(u32x4*)(WsF + ((size_t)(tile * 16 + ks) * 64 + ln) * 8) = o;
    }
    const float* dsk = F.in[I_SD] + l * BW + g * 16;
    for (int q = tid; q < 16384; q += NTHREADS) {
        const int row = q >> 6, kc = (q & 63) * 8, tau = row >> 4, cp = row & 15; float v[8];
        if (kc < 256) { const int s_ = kc >> 4, c0 = kc & 15;
#pragma unroll
            for (int j = 0; j < 8; ++j) { float m = 0.f; if (s_ <= tau) m += KT[((0 * 16 + (tau - s_)) * 16 + cp) * 16 + c0 + j]; if (s_ >= tau) m += KT[((1 * 16 + (s_ - tau)) * 16 + cp) * 16 + c0 + j];
                if (s_ == tau && c0 + j == cp) m += dsk[cp]; v[j] = m; }
        } else {
#pragma unroll
            for (int j = 0; j < 8; ++j) { const int kh = kc - 256 + j, d = kh >> 7, n = (kh & 127) >> 1, ri = kh & 1, p = d ? 16 - tau : tau + 1;
                const float cr = CC[(cp * 64 + n) * 2], ci = CC[(cp * 64 + n) * 2 + 1], pr = PW[((d * 64 + n) * 17 + p) * 2], pi = PW[((d * 64 + n) * 17 + p) * 2 + 1];
                v[j] = ri ? -(cr * pi + ci * pr) : (cr * pr - ci * pi); }
        }
        u32x4 o; o.x = pk2(v[0], v[1]); o.y = pk2(v[2], v[3]); o.z = pk2(v[4], v[5]); o.w = pk2(v[6], v[7]);
        const int tile = row >> 5, ks = kc >> 4, ln = (row & 31) + 32 * ((kc >> 3) & 1);
        *(u32x4*)(W3F + ((size_t)(tile * 32 + ks) * 64 + ln) * 8) = o;
    }
}


__device__ __forceinline__ void s5_scan_a(f32x16& re, f32x16& im, float Lr, float Li, LAS float* e) {
#pragma unroll
    for (int i = 1; i < 16; ++i) { const float pr = re[i - 1], pi = im[i - 1]; re[i] += Lr * pr - Li * pi; im[i] += Lr * pi + Li * pr; }
    e[0] = re[15]; e[1] = im[15];
}
__device__ __forceinline__ void s5_scan_b(f32x16& re, f32x16& im, float Lr, float Li, float L16r, float L16i, const LAS float* et, int sg, LAS unsigned char* hp, int hstep) {
    float cr = 0.f, ci = 0.f;
#pragma unroll
    for (int sp = 0; sp < 8; ++sp) { const bool use = sp < sg; const float er = et[sp * 64], ei = et[sp * 64 + 1];
        const float nr_ = L16r * cr - L16i * ci + er, ni_ = L16r * ci + L16i * cr + ei; cr = use ? nr_ : cr; ci = use ? ni_ : ci; }
    float pr = Lr, pi = Li;
#pragma unroll
    for (int i = 0; i < 16; ++i) { re[i] += pr * cr - pi * ci; im[i] += pr * ci + pi * cr; const float t = pr * Lr - pi * Li; pi = pr * Li + pi * Lr; pr = t; }
#pragma unroll
    for (int i = 0; i < 16; ++i) *(LAS unsigned*)(hp + i * hstep) = pk2(re[i], im[i]);
}

__device__ __forceinline__ void s5_mfma(Frame& F, int l) {
    const bf16* Z1 = (const bf16*)(F.ws + WS_Z1); bf16* YS = (bf16*)(F.ws + WS_YS);
    LAS unsigned char* UIMG = F.lds + S5_UIMG; LAS unsigned char* HIMG = F.lds + S5_HIMG; LAS float* ETAB = (LAS float*)(F.lds + S5_ETAB);
    const int tid = F.tid, lane = F.lane, w = F.wave, r = lane & 31, h = lane >> 5;
    const int item0 = F.wg >= 128 ? (F.wg - 128) * 4 : 0, item1 = F.wg >= 128 ? item0 + 4 : 0;
    u32x4 uv[8];
#define S5_LOAD_U(IT) do { const int b_ = (IT) >> 5, g_ = (IT) & 31; _Pragma("unroll") for (int q = 0; q < 8; ++q) { const int p = tid + q * NTHREADS, token = p >> 1, half = p & 1; \
        uv[q] = *(const u32x4*)(Z1 + ((size_t)b_ * SEQ + token) * ZC + COL_U + g_ * 16 + half * 8); } } while (0)
    if (item0 < item1) S5_LOAD_U(item0);
    for (int item = item0; item < item1; ++item) {
        const int b = item >> 5, g = item & 31;
        const bf16* WsF = (const bf16*)(F.ws + WS_S5MAT) + ((size_t)l * 32 + g) * 196608; const bf16* W3F = WsF + 65536;
        __syncthreads();
        {
#pragma unroll
          for (int q = 0; q < 8; ++q) { const int p = tid + q * NTHREADS, token = p >> 1, half = p & 1; *(LAS u32x4*)(UIMG + (token >> 4) * S5_CSTR + (token & 15) * 32 + half * 16) = uv[q]; } }
        { unsigned z = 0u; asm volatile("" : "+v"(z));
          if (tid < 16) *(LAS u32x4*)(HIMG + 1 * S5_CSTR + tid * 16) = (u32x4){z, z, z, z};
          else if (tid < 32) *(LAS u32x4*)(HIMG + 128 * S5_CSTR + 256 + (tid - 16) * 16) = (u32x4){z, z, z, z}; }
        __syncthreads();
        if (item + 1 < item1) S5_LOAD_U(item + 1);
        const int d = w >> 2, sh = (w >> 1) & 1, mh = w & 1;
        f32x16 sre[2], sim[2];
#pragma unroll
        for (int i = 0; i < 16; ++i) { sre[0][i] = 0.f; sre[1][i] = 0.f; sim[0][i] = 0.f; sim[1][i] = 0.f; }
        {
            const int qf = 16 * ((r >> 2) & 1) + 4 * (r >> 3) + (r & 3);
            const int qr = d ? 127 - (64 * mh + qf) : 64 * mh + qf;
            const bf16* bre = WsF + ((size_t)(((d * 2 + sh) * 2 + 0) * 16) * 64 + lane) * 8; const bf16* bim = bre + (size_t)16 * 64 * 8;
            const LAS unsigned char* a0 = UIMG + qr * S5_CSTR + 16 * h; const LAS unsigned char* a1 = UIMG + (d ? qr - 32 : qr + 32) * S5_CSTR + 16 * h;
            unsigned zq = 0u; asm volatile("" : "+v"(zq));
            u32x4 gre[4], gim[4], l0, l1, ore, oim, ox0, ox1;
#pragma unroll
            for (int q = 0; q < 4; ++q) { gre[q] = *(const u32x4*)(bre + q * 512); gim[q] = *(const u32x4*)(bim + q * 512); }
            l0 = *(const LAS u32x4*)(a0); l1 = *(const LAS u32x4*)(a1);
            ore = oim = ox0 = ox1 = (u32x4){0u, 0u, 0u, 0u};
#pragma unroll
            for (int ks = 0; ks < 16; ++ks) {
                asm volatile("s_nop 15\n\ts_nop 15" : "+v"(zq), "+v"(ore), "+v"(oim), "+v"(ox0), "+v"(ox1));
                ore = gre[ks & 3] ^ zq; oim = gim[ks & 3] ^ zq; ox0 = l0 ^ zq; ox1 = l1 ^ zq;
                asm volatile("" : "+v"(ore), "+v"(oim), "+v"(ox0), "+v"(ox1));
                if (ks + 4 < 16) { gre[ks & 3] = *(const u32x4*)(bre + (ks + 4) * 512); gim[ks & 3] = *(const u32x4*)(bim + (ks + 4) * 512); }
                if (ks + 1 < 16) { l0 = *(const LAS u32x4*)(a0 + (ks + 1) * 32); l1 = *(const LAS u32x4*)(a1 + (ks + 1) * 32); }
                sre[0] = MFMA32(__builtin_bit_cast(bf16x8, ox0), __builtin_bit_cast(bf16x8, ore), sre[0]); sim[0] = MFMA32(__builtin_bit_cast(bf16x8, ox0), __builtin_bit_cast(bf16x8, oim), sim[0]);
                sre[1] = MFMA32(__builtin_bit_cast(bf16x8, ox1), __builtin_bit_cast(bf16x8, ore), sre[1]); sim[1] = MFMA32(__builtin_bit_cast(bf16x8, ox1), __builtin_bit_cast(bf16x8, oim), sim[1]);
            }
            asm volatile("" : "+v"(ore), "+v"(oim), "+v"(ox0), "+v"(ox1));
        }
        __builtin_amdgcn_sched_barrier(0);
        asm volatile("s_nop 15\n\ts_nop 15\n\ts_nop 15\n\ts_nop 15\n\ts_nop 15" : "+v"(sre[0]), "+v"(sre[1]), "+v"(sim[0]), "+v"(sim[1]));
        __builtin_amdgcn_sched_barrier(0);

        const int n = sh * 32 + r;
        const f32x4 lam = *(const f32x4*)((const float*)(F.ws + WS_S5LAM) + ((((size_t)l * 32 + g) * 2 + d) * 64 + n) * 4);
        LAS float* et = ETAB + ((d * 2 + sh) * 8) * 64 + r * 2;
        const int sg0 = 4 * mh + h, sg1 = sg0 + 2;
        s5_scan_a(sre[0], sim[0], lam[0], lam[1], et + sg0 * 64); s5_scan_a(sre[1], sim[1], lam[0], lam[1], et + sg1 * 64);
        __syncthreads();
        {
            const int cs0 = 16 * sg0, cs1 = 16 * sg1, hstep = d ? -S5_CSTR : S5_CSTR;
            LAS unsigned char* hcol = HIMG + d * 256 + 4 * n;
            s5_scan_b(sre[0], sim[0], lam[0], lam[1], lam[2], lam[3], et, sg0, hcol + (d ? 127 - cs0 : cs0 + 2) * S5_CSTR, hstep);
            s5_scan_b(sre[1], sim[1], lam[0], lam[1], lam[2], lam[3], et, sg1, hcol + (d ? 127 - cs1 : cs1 + 2) * S5_CSTR, hstep);
        }
        __syncthreads();
        f32x16 acc[4];
#pragma unroll
        for (int nt = 0; nt < 4; ++nt)
#pragma unroll
            for (int i = 0; i < 16; ++i) acc[nt][i] = 0.f;
        {
            const bf16* ap = W3F + ((size_t)(w * 32) * 64 + lane) * 8;
            unsigned bxa[4], bha[4];
#pragma unroll
            for (int nt = 0; nt < 4; ++nt) { bxa[nt] = (unsigned)(S5_UIMG + (nt * 32 + r) * S5_CSTR + 16 * h); bha[nt] = (unsigned)(S5_HIMG + (nt * 32 + r + 1) * S5_CSTR + 16 * h); }
            unsigned zq = 0u; asm volatile("" : "+v"(zq));
            u32x4 ga[4], lx[4], oa, ox[4];
#pragma unroll
            for (int q = 0; q < 4; ++q) ga[q] = *(const u32x4*)(ap + q * 512);
#pragma unroll
            for (int nt = 0; nt < 4; ++nt) { lx[nt] = *(const LAS u32x4*)(F.lds + bxa[nt]); ox[nt] = (u32x4){0u, 0u, 0u, 0u}; }
            oa = (u32x4){0u, 0u, 0u, 0u};
#pragma unroll
            for (int ks = 0; ks < 32; ++ks) {
                asm volatile("s_nop 15\n\ts_nop 15" : "+v"(zq), "+v"(oa), "+v"(ox[0]), "+v"(ox[1]), "+v"(ox[2]), "+v"(ox[3]));
                oa = ga[ks & 3] ^ zq;
#pragma unroll
                for (int nt = 0; nt < 4; ++nt) ox[nt] = lx[nt] ^ zq;
                asm volatile("" : "+v"(oa), "+v"(ox[0]), "+v"(ox[1]), "+v"(ox[2]), "+v"(ox[3]));
                if (ks + 4 < 32) ga[ks & 3] = *(const u32x4*)(ap + (ks + 4) * 512);
                if (ks + 1 < 32) {
#pragma unroll
                    for (int nt = 0; nt < 4; ++nt) lx[nt] = *(const LAS u32x4*)(F.lds + ((ks + 1) < 16 ? bxa[nt] + (ks + 1) * 32 : bha[nt] + (ks + 1 - 16) * 32));
                }
#pragma unroll
                for (int nt = 0; nt < 4; ++nt) acc[nt] = MFMA32(__builtin_bit_cast(bf16x8, oa), __builtin_bit_cast(bf16x8, ox[nt]), acc[nt]);
            }
            asm volatile("" : "+v"(oa), "+v"(ox[0]), "+v"(ox[1]), "+v"(ox[2]), "+v"(ox[3]));
            asm volatile("" :: "v"(bxa[0]), "v"(bxa[1]), "v"(bxa[2]), "v"(bxa[3]), "v"(bha[0]), "v"(bha[1]), "v"(bha[2]), "v"(bha[3]));
        }
        __builtin_amdgcn_sched_barrier(0);
        asm volatile("s_nop 15\n\ts_nop 15\n\ts_nop 15\n\ts_nop 15\n\ts_nop 15" : "+v"(acc[0]), "+v"(acc[1]), "+v"(acc[2]), "+v"(acc[3]));
        __builtin_amdgcn_sched_barrier(0);
#pragma unroll
        for (int nt = 0; nt < 4; ++nt)
#pragma unroll
            for (int gq = 0; gq < 4; ++gq) { const int tau = 2 * w + (gq >> 1), cp = 8 * (gq & 1) + 4 * h, token = (32 * nt + r) * 16 + tau;
                u32x2 o; o.x = pk2hw(gelu_tanh(acc[nt][4 * gq]), gelu_tanh(acc[nt][4 * gq + 1])); o.y = pk2hw(gelu_tanh(acc[nt][4 * gq + 2]), gelu_tanh(acc[nt][4 * gq + 3]));
                *(u32x2*)(YS + ((size_t)b * SEQ + token) * BW + g * 16 + cp) = o; }
    }
#undef S5_LOAD_U
    __syncthreads();
}


#define MFMA_FENCE3(a, b, c) asm volatile("s_nop 15\n\ts_nop 15\n\ts_nop 15\n\ts_nop 15\n\ts_nop 15" : "+v"(a), "+v"(b), "+v"(c))
__device__ __forceinline__ void lru_half_scan(f32x16& aR, f32x16& aI, const f32x16& aX, float br, float bi, float lamc, LAS float* sgw) {
    float Pp = 1.f, Hh = 0.f;
#pragma unroll
    for (int i = 0; i < 16; ++i) {
        const float rg = sigmoidf_(aR[i] + br), ig = sigmoidf_(aI[i] + bi), x2 = 2.0f * lamc * rg;
        const float a = __builtin_amdgcn_exp2f(0.72134752044f * x2);
        const float om = __builtin_fmaf(-a, a, 1.0f);
        const float u = __builtin_amdgcn_sqrtf(fmaxf(om, 0.f)) * ig * aX[i];
        Hh = a * Hh + u; Pp = a * Pp; aR[i] = Hh; aI[i] = Pp;
        if ((i & 3) == 3) asm volatile("" : "+v"(Hh), "+v"(Pp));
    }
    sgw[0] = Pp; sgw[1] = Hh;
}
constexpr int LRU_TILE = 16384, LRU_TILE_BYTES = 33 * 1024;
__device__ __forceinline__ void lru_mfma(Frame& F, int l) {
    const bf16* Z1 = (const bf16*)(F.ws + WS_Z1); bf16* OL = (bf16*)(F.ws + WS_OL);
    LAS float* CW = (LAS float*)F.lds;
    LAS float* SEG = CW + 320;
    const int tid = F.tid, lane = F.lane, w = F.wave, r = lane & 31, hh = lane >> 5;
    for (int item = F.wg; item < (F.wg < 128 ? BATCH * 8 : 0); item += 128) {
        const int b = item >> 3, hb = item & 7, ch0 = hb * 64 + r;
        __syncthreads();
        if (tid < 256) CW[tid] = F.in[I_CONVW][((size_t)l * 4 + (tid >> 6)) * BW + hb * 64 + (tid & 63)];
        else if (tid < 320) CW[tid] = F.in[I_CONVB][l * BW + hb * 64 + (tid - 256)];
        const int qf = 16 * ((r >> 2) & 1) + 4 * (r >> 3) + (r & 3);
        const bf16* xrb = Z1 + (size_t)b * SEQ * ZC + COL_XR + hb * 64 + (lane & 7) * 8;
        bf16* XC = (bf16*)(F.ws + WS_OS) + (size_t)item * SEQ * 64;
        const bf16* xcb = XC + (lane & 7) * 8;
#pragma unroll 1
        for (int dir = 0; dir < 2; ++dir) {
            bf16x8 wr[2][4], wi[2][4];
#pragma unroll
            for (int nh = 0; nh < 2; ++nh) { const bf16* lf = (const bf16*)(F.ws + WS_LRUF) + ((((((size_t)l * 2 + dir) * 8 + hb) * 2 + nh) * 2) * 4 * 64 + lane) * 8;
#pragma unroll
              for (int ks = 0; ks < 4; ++ks) { wr[nh][ks] = *(const bf16x8*)(lf + (size_t)ks * 512); wi[nh][ks] = *(const bf16x8*)(lf + (size_t)(4 + ks) * 512); } }
            float br[2], bi[2], lamc[2], carry[2] = {0.f, 0.f};
#pragma unroll
            for (int nh = 0; nh < 2; ++nh) { const int ch = ch0 + 32 * nh; br[nh] = F.in[I_LBR][((size_t)l * 2 + dir) * BW + ch]; bi[nh] = F.in[I_LBI][((size_t)l * 2 + dir) * BW + ch];
                lamc[nh] = -8.0f * log1pf(expf(-F.in[I_LAM][((size_t)l * 2 + dir) * BW + ch])); }
#define LRU_STAGE(SC) do { const int tlo_ = dir ? SEQ - 256 * ((SC) + 1) : 256 * (SC); \
                for (int j_ = w; j_ < 33; j_ += NWAVES) { int t_ = tlo_ - 2 + 8 * j_ + (lane >> 3); t_ = t_ < 0 ? 0 : (t_ >= SEQ ? SEQ - 1 : t_); \
                    __builtin_amdgcn_global_load_lds((const unsigned*)(dir ? xcb + (size_t)t_ * 64 : xrb + (size_t)t_ * ZC), (LAS unsigned*)(F.lds + LRU_TILE + ((SC) & 1) * LRU_TILE_BYTES + j_ * 1024), 16, 0, 0); } } while (0)
            LRU_STAGE(0);
#pragma unroll 1
            for (int sc = 0; sc < 8; ++sc) {
                asm volatile("s_waitcnt vmcnt(0)" ::: "memory"); __syncthreads();
                if (sc + 1 < 8) LRU_STAGE(sc + 1);
                const int srow = sc * 256 + w * 32 + qf, trow = dir ? (SEQ - 1 - srow) : srow, tlo = dir ? SEQ - 256 * (sc + 1) : 256 * sc;
                const LAS unsigned char* tl = F.lds + LRU_TILE + (sc & 1) * LRU_TILE_BYTES + (trow - tlo) * 128 + 16 * hh;
                bf16x8 av[4];
                if (dir) {
#pragma unroll
                    for (int ks = 0; ks < 4; ++ks) av[ks] = *(const LAS bf16x8*)(tl + 2 * 128 + ks * 32);
                } else {
#pragma unroll
                for (int ks = 0; ks < 4; ++ks) {
                    const int c0 = 16 * ks + 8 * hh;
                    float xv[8];
#pragma unroll
                    for (int j = 0; j < 8; ++j) xv[j] = CW[256 + c0 + j];
#pragma unroll
                    for (int tap = 0; tap < 4; ++tap) { const int tt = trow + tap - 2; const float msk = (tt >= 0 && tt < SEQ) ? 1.0f : 0.0f;
                        const bf16x8 v = *(const LAS bf16x8*)(tl + tap * 128 + ks * 32);
#pragma unroll
                        for (int j = 0; j < 8; ++j) xv[j] += (CW[tap * 64 + c0 + j] * msk) * bf2f((bf16)v[j]); }
                    u32x4 pa; pa.x = pk2hw(xv[0], xv[1]); pa.y = pk2hw(xv[2], xv[3]); pa.z = pk2hw(xv[4], xv[5]); pa.w = pk2hw(xv[6], xv[7]);
                    av[ks] = __builtin_bit_cast(bf16x8, pa);
                    *(u32x4*)(XC + (size_t)trow * 64 + c0) = pa;
                }
                }
                const int st0 = sc * 256 + w * 32 + 16 * hh; const size_t tok0 = (size_t)b * SEQ + (dir ? (SEQ - 1 - st0) : st0); const long tstep = dir ? -1 : 1;
#pragma unroll
                for (int nh = 0; nh < 2; ++nh) {
                    const int ch = ch0 + 32 * nh;
                    f32x16 aR, aI, aX;
#pragma unroll
                    for (int i = 0; i < 16; ++i) { aR[i] = 0.f; aI[i] = 0.f; aX[i] = 0.f; }
                    bf16x8 idf[4];
#pragma unroll
                    for (int ks = 0; ks < 4; ++ks) { u32x4 pd_;
#pragma unroll
                        for (int jj = 0; jj < 4; ++jj) { const int k0 = 16 * ks + 8 * hh + 2 * jj; pd_[jj] = (k0 == nh * 32 + r ? 0x3f80u : 0u) | (k0 + 1 == nh * 32 + r ? 0x3f800000u : 0u); }
                        idf[ks] = __builtin_bit_cast(bf16x8, pd_); }
                    __builtin_amdgcn_sched_barrier(0);
#pragma unroll
                    for (int ks = 0; ks < 4; ++ks) { aR = MFMA32(av[ks], wr[nh][ks], aR); aI = MFMA32(av[ks], wi[nh][ks], aI); aX = MFMA32(av[ks], idf[ks], aX); }
                    __builtin_amdgcn_sched_barrier(0);
                    MFMA_FENCE3(aR, aI, aX);
                    __builtin_amdgcn_sched_barrier(0);
                    bf16 hfv[16], grv[16];
                    if (dir) {
#pragma unroll
                        for (int i = 0; i < 16; ++i) { const size_t tok = tok0 + tstep * i; hfv[i] = OL[tok * BW + ch]; grv[i] = Z1[tok * ZC + COL_GR + ch]; }
                    }
                    LAS float* sg = SEG + nh * 1024;
                    lru_half_scan(aR, aI, aX, br[nh], bi[nh], lamc[nh], sg + ((2 * w + hh) * 32 + r) * 2);
                    __syncthreads();
                    float cin = 0.f, X = carry[nh];
#pragma unroll
                    for (int sp = 0; sp < 16; ++sp) { cin = (sp == 2 * w + hh) ? X : cin; X = sg[(sp * 32 + r) * 2] * X + sg[(sp * 32 + r) * 2 + 1]; }
                    carry[nh] = X;
                    if (dir == 0) {
#pragma unroll
                        for (int i = 0; i < 16; i += 2) { const unsigned p = pk2hw(aR[i] + aI[i] * cin, aR[i + 1] + aI[i + 1] * cin);
                            OL[(tok0 + tstep * i) * BW + ch] = (bf16)(p & 0xffffu); OL[(tok0 + tstep * (i + 1)) * BW + ch] = (bf16)(p >> 16); }
                    } else {
#pragma unroll
                        for (int i = 0; i < 16; i += 2) { const unsigned p = pk2hw(gelu_tanh(bf2f(grv[i])) * (bf2f(hfv[i]) + aR[i] + aI[i] * cin), gelu_tanh(bf2f(grv[i + 1])) * (bf2f(hfv[i + 1]) + aR[i + 1] + aI[i + 1] * cin));
                            OL[(tok0 + tstep * i) * BW + ch] = (bf16)(p & 0xffffu); OL[(tok0 + tstep * (i + 1)) * BW + ch] = (bf16)(p >> 16); }
                    }
                }
            }
            asm volatile("s_waitcnt vmcnt(0)" ::: "memory"); __syncthreads();
        }
    }
    __syncthreads();
}

#ifndef ATT_LO
#define ATT_LO 1
#endif
constexpr int AT_KSTR = 144, AT_VSTR = 776, AT_K = 0, AT_V = 384 * AT_KSTR;
__device__ __forceinline__ void attn_mfma(Frame& F, int l) {
    const bf16* Z1 = (const bf16*)(F.ws + WS_Z1); bf16* OA = (bf16*)(F.ws + WS_OA);
    LAS unsigned char* KL = F.lds + AT_K; LAS unsigned char* VT = F.lds + AT_V;
    const int tid = F.tid, lane = F.lane, w = F.wave, r = lane & 31, hh = lane >> 5;
    const float LOG2E = 1.4426950408889634f;
    for (int k = 0; k < (F.wg < 128 ? ATT_LO : 4 - ATT_LO); ++k) {
        const int item = F.wg < 128 ? F.wg * ATT_LO + k : 128 * ATT_LO + (F.wg - 128) * (4 - ATT_LO) + k;
        const int b = item >> 5, nb = (item >> 1) & 15, kvh = item & 1;
        __syncthreads();
        { u32x4 kq[6], vq[6];
#pragma unroll
          for (int q = 0; q < 6; ++q) { const int p = tid + q * NTHREADS, kj = p >> 3, dc = p & 7, sp = nb * 128 - 128 + kj; const bool ok = (sp >= 0 && sp < SEQ);
              const bf16* base = Z1 + ((size_t)b * SEQ + (ok ? sp : 0)) * ZC + kvh * 64 + dc * 8; kq[q] = *(const u32x4*)(base + COL_K); vq[q] = *(const u32x4*)(base + COL_V);
              if (!ok) { kq[q] = (u32x4){0u, 0u, 0u, 0u}; vq[q] = (u32x4){0u, 0u, 0u, 0u}; } }
#pragma unroll
          for (int q = 0; q < 6; ++q) { const int p = tid + q * NTHREADS, kj = p >> 3, dc = p & 7; const u32x4 vv = vq[q];
              *(LAS u32x4*)(KL + kj * AT_KSTR + dc * 16) = kq[q];
              LAS bf16* vt = (LAS bf16*)(VT + (dc * 8) * AT_VSTR + kj * 2);
              vt[0 * (AT_VSTR / 2)] = (bf16)(vv.x & 0xffffu); vt[1 * (AT_VSTR / 2)] = (bf16)(vv.x >> 16); vt[2 * (AT_VSTR / 2)] = (bf16)(vv.y & 0xffffu); vt[3 * (AT_VSTR / 2)] = (bf16)(vv.y >> 16);
              vt[4 * (AT_VSTR / 2)] = (bf16)(vv.z & 0xffffu); vt[5 * (AT_VSTR / 2)] = (bf16)(vv.z >> 16); vt[6 * (AT_VSTR / 2)] = (bf16)(vv.w & 0xffffu); vt[7 * (AT_VSTR / 2)] = (bf16)(vv.w >> 16); } }
        __syncthreads();
#pragma unroll 1
        for (int task = w; task < 16; task += NWAVES) {
            const int g = task >> 2, qt = task & 3, hq = kvh * 4 + g;
            const size_t tokq = (size_t)b * SEQ + nb * 128 + 32 * qt + r;
            bf16x8 qf[4];
#pragma unroll
            for (int ks = 0; ks < 4; ++ks) qf[ks] = *(const bf16x8*)(Z1 + tokq * ZC + COL_Q + hq * 64 + 16 * ks + 8 * hh);
            const float slope2 = exp2f(-(float)(hq + 1)) * LOG2E, sink2 = F.in[I_SINK][l * NQ + hq] * LOG2E;
            float m = sink2, lsum = 1.0f;
            f32x16 o0, o1;
#pragma unroll
            for (int i = 0; i < 16; ++i) { o0[i] = 0.f; o1[i] = 0.f; }
            u32x4 ka[4] = {(u32x4){0u, 0u, 0u, 0u}, (u32x4){0u, 0u, 0u, 0u}, (u32x4){0u, 0u, 0u, 0u}, (u32x4){0u, 0u, 0u, 0u}};
            u32x4 pp0 = (u32x4){0u, 0u, 0u, 0u}, pp1 = pp0, va0 = pp0, va1 = pp0, va2 = pp0, va3 = pp0;
#pragma unroll 1
            for (int kt = qt; kt < qt + 9; ++kt) {
                f32x16 sc;
#pragma unroll
                for (int i = 0; i < 16; ++i) sc[i] = 0.f;
                { const LAS unsigned char* kp = KL + (32 * kt + r) * AT_KSTR + 16 * hh;
#pragma unroll
                  for (int ks = 0; ks < 4; ++ks) ka[ks] = *(const LAS u32x4*)(kp + ks * 32);
#pragma unroll
                  for (int ks = 0; ks < 4; ++ks) sc = MFMA32(__builtin_bit_cast(bf16x8, ka[ks]), qf[ks], sc); }
                __builtin_amdgcn_sched_barrier(0);
                asm volatile("s_nop 15\n\ts_nop 15\n\ts_nop 15\n\ts_nop 15\n\ts_nop 15" : "+v"(sc), "+v"(o0), "+v"(o1), "+v"(pp0), "+v"(pp1), "+v"(va0), "+v"(va1), "+v"(va2), "+v"(va3), "+v"(ka[0]), "+v"(ka[1]), "+v"(ka[2]), "+v"(ka[3]));
                __builtin_amdgcn_sched_barrier(0);
                const float fd0 = (float)(128 + 32 * qt + r - 32 * kt - 4 * hh);
                const bool inwin = (kt > qt) && (kt < qt + 8), inseq = (nb * 128 - 128 + 32 * kt >= 0) && (nb * 128 - 128 + 32 * kt + 31 < SEQ);
                float tmax = -1e30f;
                if (inwin && inseq) {
#pragma unroll
                    for (int i = 0; i < 16; ++i) { const float dd = fd0 - (float)((i & 3) + 8 * (i >> 2)); const float v = sc[i] * (0.125f * LOG2E) - slope2 * __builtin_fabsf(dd); sc[i] = v; tmax = fmaxf(tmax, v); }
                } else {
#pragma unroll
                    for (int i = 0; i < 16; ++i) { const int kj = 32 * kt + (i & 3) + 8 * (i >> 2) + 4 * hh, sp = nb * 128 - 128 + kj; const float dd = fd0 - (float)((i & 3) + 8 * (i >> 2)), ad = __builtin_fabsf(dd);
                        const bool valid = (ad <= (float)WIN) && (sp >= 0) && (sp < SEQ);
                        const float v = valid ? (sc[i] * (0.125f * LOG2E) - slope2 * ad) : -1e30f; sc[i] = v; tmax = fmaxf(tmax, v); }
                }
                { const auto sw = __builtin_amdgcn_permlane32_swap(__float_as_uint(tmax), __float_as_uint(tmax), false, false); tmax = fmaxf(__uint_as_float(sw[0]), __uint_as_float(sw[1])); }
                const float mnew = fmaxf(m, tmax), alpha = __builtin_amdgcn_exp2f(m - mnew); m = mnew;
                float psum = 0.f;
#pragma unroll
                for (int i = 0; i < 16; ++i) { const float p = __builtin_amdgcn_exp2f(sc[i] - mnew); sc[i] = p; psum += p; }
                { const auto sw = __builtin_amdgcn_permlane32_swap(__float_as_uint(psum), __float_as_uint(psum), false, false); psum = __uint_as_float(sw[0]) + __uint_as_float(sw[1]); }
                lsum = lsum * alpha + psum;
#pragma unroll
                for (int i = 0; i < 16; ++i) { o0[i] *= alpha; o1[i] *= alpha; }
                pp0.x = pk2hw(sc[0], sc[1]); pp0.y = pk2hw(sc[2], sc[3]); pp0.z = pk2hw(sc[4], sc[5]); pp0.w = pk2hw(sc[6], sc[7]);
                pp1.x = pk2hw(sc[8], sc[9]); pp1.y = pk2hw(sc[10], sc[11]); pp1.z = pk2hw(sc[12], sc[13]); pp1.w = pk2hw(sc[14], sc[15]);
                {   const LAS unsigned char* vp = VT + r * AT_VSTR + (32 * kt + 4 * hh) * 2;
#define AT_LDV(dst, off) do { const u32x2 lo_ = *(const LAS u32x2*)(vp + (off)), hi_ = *(const LAS u32x2*)(vp + (off) + 16); dst.x = lo_.x; dst.y = lo_.y; dst.z = hi_.x; dst.w = hi_.y; } while (0)
                    AT_LDV(va0, 0); AT_LDV(va1, 32 * AT_VSTR); AT_LDV(va2, 32); AT_LDV(va3, 32 * AT_VSTR + 32);
#undef AT_LDV
                    o0 = MFMA32(__builtin_bit_cast(bf16x8, va0), __builtin_bit_cast(bf16x8, pp0), o0); o1 = MFMA32(__builtin_bit_cast(bf16x8, va1), __builtin_bit_cast(bf16x8, pp0), o1);
                    o0 = MFMA32(__builtin_bit_cast(bf16x8, va2), __builtin_bit_cast(bf16x8, pp1), o0); o1 = MFMA32(__builtin_bit_cast(bf16x8, va3), __builtin_bit_cast(bf16x8, pp1), o1); }
            }
            __builtin_amdgcn_sched_barrier(0);
            asm volatile("s_nop 15\n\ts_nop 15\n\ts_nop 15\n\ts_nop 15\n\ts_nop 15" : "+v"(o0), "+v"(o1), "+v"(pp0), "+v"(pp1), "+v"(va0), "+v"(va1), "+v"(va2), "+v"(va3));
            __builtin_amdgcn_sched_barrier(0);
            const float inv = 1.0f / lsum;
            bf16* op = OA + tokq * BW + hq * 64 + 4 * hh;
#pragma unroll
            for (int gq = 0; gq < 4; ++gq) {
                u32x2 w0, w1; w0.x = pk2hw(o0[4 * gq] * inv, o0[4 * gq + 1] * inv); w0.y = pk2hw(o0[4 * gq + 2] * inv, o0[4 * gq + 3] * inv);
                w1.x = pk2hw(o1[4 * gq] * inv, o1[4 * gq + 1] * inv); w1.y = pk2hw(o1[4 * gq + 2] * inv, o1[4 * gq + 3] * inv);
                *(u32x2*)(op + 8 * gq) = w0; *(u32x2*)(op + 32 + 8 * gq) = w1; }
        }
    }
    __syncthreads();
}

__device__ __forceinline__ void p4a_router(Frame& F, int l) {
    LAS float* wl = (LAS float*)F.lds;
    LAS int* bk = (LAS int*)(F.lds + 81920);
    const float* wrt = (const float*)(F.ws + WS_WRT) + (size_t)l * 20 * D;
    for (int i = F.tid; i < 20 * D / 4; i += NTHREADS) ((LAS f32x4*)wl)[i] = ((const f32x4*)wrt)[i];
    __syncthreads();
    const float* X = F.out; float* rinv2 = (float*)(F.ws + WS_RINV2); int* BUCKET = (int*)(F.ws + WS_BUCKET); float* WTOK = (float*)(F.ws + WS_WTOK);
    const int lane = F.lane, t2 = lane >> 4, kk = lane & 15, tok0 = F.wg * 128 + F.wave * 16 + 4 * t2;
    float lg[4][20], ss[4];
#pragma unroll
    for (int i = 0; i < 4; ++i) { ss[i] = 0.f;
#pragma unroll
        for (int o = 0; o < 20; ++o) lg[i][o] = 0.f; }
    const f32x4* xr = (const f32x4*)(X + (size_t)tok0 * D) + kk;
#pragma unroll 2
    for (int jj = 0; jj < 16; ++jj) {
        f32x4 x4[4];
#pragma unroll
        for (int i = 0; i < 4; ++i) x4[i] = xr[(size_t)i * (D / 4) + 16 * jj];
#pragma unroll
        for (int i = 0; i < 4; ++i) ss[i] += (x4[i].x * x4[i].x + x4[i].y * x4[i].y) + (x4[i].z * x4[i].z + x4[i].w * x4[i].w);
#pragma unroll
        for (int o = 0; o < 20; ++o) { const f32x4 w4 = ((const LAS f32x4*)(wl + o * D))[16 * jj + kk];
#pragma unroll
            for (int i = 0; i < 4; ++i) lg[i][o] += (x4[i].x * w4.x + x4[i].y * w4.y) + (x4[i].z * w4.z + x4[i].w * w4.w); }
    }
#pragma unroll
    for (int i = 0; i < 4; ++i) {
#pragma unroll
        for (int o = 0; o < 20; ++o) { float v = lg[i][o]; v += dpp_ror<8>(v); v += dpp_ror<4>(v); v += dpp_ror<2>(v); v += dpp_ror<1>(v); lg[i][o] = v; }
        { float v = ss[i]; v += dpp_ror<8>(v); v += dpp_ror<4>(v); v += dpp_ror<2>(v); v += dpp_ror<1>(v); ss[i] = v; } }
    {
        float lgv[20], ssv = ss[0];
#pragma unroll
        for (int o = 0; o < 20; ++o) lgv[o] = lg[0][o];
#pragma unroll
        for (int i = 1; i < 4; ++i) { ssv = (kk == i) ? ss[i] : ssv;
#pragma unroll
            for (int o = 0; o < 20; ++o) lgv[o] = (kk == i) ? lg[i][o] : lgv[o]; }
        const int tok = tok0 + (kk & 3); const float ri = 1.0f / sqrtf(ssv * (1.0f / D) + NORM_EPS);
        float gl[4]; int gi = 0; float gm;
#pragma unroll
        for (int q = 0; q < 4; ++q) gl[q] = lgv[q] * ri + F.in[I_BG][l * 4 + q];
        gm = gl[0];
#pragma unroll
        for (int q = 1; q < 4; ++q) if (gl[q] > gm) { gm = gl[q]; gi = q; }
        float gs = 0.f;
#pragma unroll
        for (int q = 0; q < 4; ++q) gs += expf(gl[q] - gm);
        const float gw = 1.0f / gs;
        float el[4];
#pragma unroll
        for (int e = 0; e < 4; ++e) { float v = 0.f;
#pragma unroll
            for (int g = 0; g < 4; ++g) v = (gi == g) ? (lgv[4 + g * 4 + e] * ri + F.in[I_BE][l * 16 + g * 4 + e]) : v;
            el[e] = v; }
        int i1 = 0; float v1 = el[0];
#pragma unroll
        for (int e = 1; e < 4; ++e) if (el[e] > v1) { v1 = el[e]; i1 = e; }
        int i2 = -1; float v2 = -3.4e38f;
#pragma unroll
        for (int e = 0; e < 4; ++e) if (e != i1 && el[e] > v2) { v2 = el[e]; i2 = e; }
        const float e2 = expf(v2 - v1), w1 = gw / (1.0f + e2), w2 = gw * e2 / (1.0f + e2);
        const int ea = i1 < i2 ? i1 : i2, eb = i1 < i2 ? i2 : i1; const float wa = i1 < i2 ? w1 : w2, wb = i1 < i2 ? w2 : w1;
        const int bucket = gi * 6 + pair_index(ea, eb);
        if (kk < 4) { rinv2[tok] = ri; BUCKET[tok] = bucket; WTOK[2 * tok] = wa; WTOK[2 * tok + 1] = wb; bk[F.wave * 16 + 4 * t2 + kk] = bucket; }
    }
    __syncthreads();
    if (F.tid < 128) { const int b = bk[F.tid]; int r = 0; for (int i = 0; i < F.tid; ++i) r += (bk[i] == b) ? 1 : 0; ((int*)(F.ws + WS_RANK))[F.wg * 128 + F.tid] = r; }
    if (F.tid >= 128 && F.tid < 128 + 32) { const int b = F.tid - 128; int c = 0; if (b < NBUCKET) for (int i = 0; i < 128; ++i) c += (bk[i] == b) ? 1 : 0; ((int*)(F.ws + WS_HIST))[F.wg * 32 + b] = c; }
    __syncthreads();
}

__device__ __forceinline__ void p4b_positions(Frame& F) {
    LAS int* tot = (LAS int*)F.lds; LAS int* pre = tot + 32; LAS int* base = tot + 64;
    const int* HIST = (const int*)(F.ws + WS_HIST);
    if (F.tid < NBUCKET) { int t = 0, p = 0; for (int w = 0; w < 256; ++w) { const int h = HIST[w * 32 + F.tid]; if (w < F.wg) p += h; t += h; } tot[F.tid] = t; pre[F.tid] = p; }
    __syncthreads();
    if (F.tid == 0) { int a = 0; for (int b = 0; b < NBUCKET; ++b) { base[b] = a; a += (tot[b] + 255) & ~255; } base[NBUCKET] = a; }
    __syncthreads();
    int* IDX = (int*)(F.ws + WS_IDX); float* WSORT = (float*)(F.ws + WS_WSORT); float* RSORT = (float*)(F.ws + WS_RSORT); const float* WTOK = (const float*)(F.ws + WS_WTOK);
    if (F.tid < 128) { const int tok = F.wg * 128 + F.tid; const int b = ((const int*)(F.ws + WS_BUCKET))[tok]; const int pos = base[b] + pre[b] + ((const int*)(F.ws + WS_RANK))[tok];
        IDX[pos] = tok; *(u32x2*)(WSORT + 2 * pos) = (u32x2){__float_as_uint(WTOK[2 * tok]), __float_as_uint(WTOK[2 * tok + 1])}; RSORT[pos] = ((const float*)(F.ws + WS_RINV2))[tok]; }
    if (F.wg == 0) {
        float z = 0.f; asm volatile("" : "+v"(z));
        for (int b = 0; b < NBUCKET; ++b) for (int p = base[b] + tot[b] + F.tid; p < base[b + 1]; p += NTHREADS) { IDX[p] = -1; WSORT[2 * p] = z; WSORT[2 * p + 1] = z; RSORT[p] = z; }
        if (F.tid <= NBUCKET) ((int*)(F.ws + WS_BBASE))[F.tid] = base[F.tid];
    }
    __syncthreads();
}

__device__ __forceinline__ int build_tile_table(Frame& F, LAS int* tb) {
    const int* BB = (const int*)(F.ws + WS_BBASE);
    if (F.tid < 160) { const int r0 = F.tid * 256; int bkt = -1; for (int b = 0; b < NBUCKET; ++b) if (r0 >= BB[b] && r0 < BB[b + 1]) bkt = b; tb[1 + F.tid] = bkt; }
    if (F.tid == 0) tb[0] = BB[NBUCKET] / 256;
    __syncthreads();
    return tb[0];
}

typedef f32x4 AccT[2][2][4][2];
struct EpiZ1 { bf16* Z1; const float* rinv;
    __device__ __forceinline__ bool operator()(const AccT& acc, const pg8::Unit& u, int wr, int wc, int fr, int fq) const {
        asm volatile("" : "+v"(fr), "+v"(fq));
#pragma unroll
        for (int ai = 0; ai < 2; ++ai)
#pragma unroll
            for (int m = 0; m < 4; ++m) { const int row = u.pm * 256 + ai * 128 + wr * 64 + m * 16 + fr; const float ri = rinv[row]; bf16* rowp = Z1 + (size_t)row * ZC + u.pn * 256 + wc * 32 + 8 * fq;
#pragma unroll
                for (int bj = 0; bj < 2; ++bj) *(u32x4*)(rowp + bj * 128) = pack8(acc[ai][bj][m][0] * ri, acc[ai][bj][m][1] * ri); }
        return false; } };
__device__ __forceinline__ void p1_inproj_pg8(Frame& F, int l) {
    DenseSched S{(const char*)(F.ws + WS_XB), (const char*)(F.ws + WS_WINT) + (size_t)l * IN_COLS * D * 2, M / 256, ZC / 256, F.G, F.wg, D / 64, D * 2, D * 2};
    EpiZ1 E{(bf16*)(F.ws + WS_Z1), (const float*)(F.ws + WS_RINV1)};
    pg8::gemm_phase<EpiZ1, DenseSched, true, 0>(F.lds, S, E, F.tid);
    if (P0_LAYERS < DEPTH && l == 0 && F.wg >= 128) p0_weights(F, P0_LAYERS, DEPTH, (F.wg - 128) * NWAVES + F.wave, 128 * NWAVES);
}
struct EpiGlu { bf16* OS; const float* bg;
    __device__ __forceinline__ bool operator()(const AccT& acc, const pg8::Unit& u, int wr, int wc, int fr, int fq) const {
        asm volatile("" : "+v"(fr), "+v"(fq));
        const int col = u.pn * 128 + wc * 32 + 8 * fq;
        f32x4 bv[2], bgt[2];
#pragma unroll
        for (int n = 0; n < 2; ++n) { bv[n] = *(const f32x4*)(bg + col + 4 * n); bgt[n] = *(const f32x4*)(bg + 512 + col + 4 * n); }
#pragma unroll
        for (int ai = 0; ai < 2; ++ai)
#pragma unroll
            for (int m = 0; m < 4; ++m) { const int row = u.pm * 256 + ai * 128 + wr * 64 + m * 16 + fr; f32x4 o[2];
#pragma unroll
                for (int n = 0; n < 2; ++n) { const f32x4 v = acc[ai][0][m][n] + bv[n], g = acc[ai][1][m][n] + bgt[n];
#pragma unroll
                    for (int j = 0; j < 4; ++j) o[n][j] = v[j] * sigmoidf_(g[j]); }
                *(u32x4*)(OS + (size_t)row * BW + col) = pack8(o[0], o[1]); }
        return false; } };
__device__ __forceinline__ void p3a_glu_pg8(Frame& F, int l) {
    DenseSched S{(const char*)(F.ws + WS_YS), (const char*)(F.ws + WS_WGLUT) + (size_t)l * 1024 * BW * 2, M / 256, 4, F.G, F.wg, BW / 64, BW * 2, BW * 2};
    EpiGlu E{(bf16*)(F.ws + WS_OS), F.in[I_BGLU] + l * 1024};
    pg8::gemm_phase<EpiGlu, DenseSched, true, 0>(F.lds, S, E, F.tid);
}
struct EpiOut { const float* xin; float* X; bf16* XB;
    __device__ __forceinline__ bool operator()(const AccT& acc, const pg8::Unit& u, int wr, int wc, int fr, int fq) const {
        asm volatile("" : "+v"(fr), "+v"(fq));
#pragma unroll
        for (int ai = 0; ai < 2; ++ai) {
#pragma unroll
            for (int mp = 0; mp < 2; ++mp) {
                f32x4 xv[2][2][2];
#pragma unroll
                for (int mm = 0; mm < 2; ++mm) { const size_t row = u.pm * 256 + ai * 128 + wr * 64 + (2 * mp + mm) * 16 + fr;
#pragma unroll
                    for (int bj = 0; bj < 2; ++bj) { const size_t o = row * D + u.pn * 256 + bj * 128 + wc * 32 + 8 * fq; xv[mm][bj][0] = *(const f32x4*)(xin + o); xv[mm][bj][1] = *(const f32x4*)(xin + o + 4); } }
#pragma unroll
                for (int mm = 0; mm < 2; ++mm) { const int m = 2 * mp + mm; const size_t row = u.pm * 256 + ai * 128 + wr * 64 + m * 16 + fr;
#pragma unroll
                    for (int bj = 0; bj < 2; ++bj) { const size_t o = row * D + u.pn * 256 + bj * 128 + wc * 32 + 8 * fq;
                        const f32x4 v0 = xv[mm][bj][0] + acc[ai][bj][m][0], v1 = xv[mm][bj][1] + acc[ai][bj][m][1];
                        *(f32x4*)(X + o) = v0; *(f32x4*)(X + o + 4) = v1; *(u32x4*)(XB + o) = pack8(v0, v1); } }
                asm volatile("" ::: "memory"); } }
        return false; } };
__device__ __forceinline__ void p3c_outproj_pg8(Frame& F, int l) {
    DenseSched S{(const char*)(F.ws + WS_MIXED), (const char*)(F.ws + WS_WOUTT) + (size_t)l * D * D * 2, M / 256, 4, F.G, F.wg, D / 64, D * 2, D * 2};
    EpiOut E{(l == 0) ? F.in[I_X] : F.out, F.out, (bf16*)(F.ws + WS_XB)};
    pg8::gemm_phase<EpiOut, DenseSched, true, 0>(F.lds, S, E, F.tid);
}
struct MixSched { const char* XB; const char* WG; const char* WB; const char* ws; int G, c;
    __device__ __forceinline__ bool next(int i, pg8::Unit& u) const {
        const int sub = i % 6, L = (i / 6) * G + c; if (L >= 512) return false;
        pg8::static_tile(L, M / 256, 4, u.pm, u.pn); u.aux = sub; const int k = sub >> 1;
        if (!(sub & 1)) { u.A = XB + (size_t)u.pm * 256 * 2048; u.lda2 = 2048; u.nt = 16; u.B = WG + ((size_t)k * D + u.pn * 256) * 2048; u.ldb2 = 2048; }
        else { const char* br = ws + (k == 0 ? WS_OA : (k == 1 ? WS_OL : WS_OS)); u.A = br + (size_t)u.pm * 256 * 1024; u.lda2 = 1024; u.nt = 8; u.B = WB + ((size_t)k * D + u.pn * 256) * 1024; u.ldb2 = 1024; }
        return true; }
    __device__ __forceinline__ unsigned row_off(const pg8::Unit&, int) const { return 0u; }
};
struct EpiMix { u32x2* SIG; u32x4* MIXS; bf16* MX; const float* rinv;
    __device__ __forceinline__ bool operator()(const AccT& acc, const pg8::Unit& u, int wr, int wc, int fr, int fq) const {
        asm volatile("" : "+v"(fr), "+v"(fq));
        const int tid = (wr * 4 + wc) * 64 + fq * 16 + fr, sub = u.aux, k = sub >> 1;
        if (!(sub & 1)) {
            float ri[2][4];
#pragma unroll
            for (int ai = 0; ai < 2; ++ai)
#pragma unroll
                for (int m = 0; m < 4; ++m) ri[ai][m] = rinv[u.pm * 256 + ai * 128 + wr * 64 + m * 16 + fr];
#pragma unroll
            for (int ai = 0; ai < 2; ++ai)
#pragma unroll
                for (int m = 0; m < 4; ++m)
#pragma unroll
                    for (int bj = 0; bj < 2; ++bj) { unsigned q0 = 0u, q1 = 0u;
#pragma unroll
                        for (int j = 0; j < 4; ++j) { q0 |= (unsigned)__builtin_rintf(255.0f * sigmoidf_(acc[ai][bj][m][0][j] * ri[ai][m])) << (8 * j); q1 |= (unsigned)__builtin_rintf(255.0f * sigmoidf_(acc[ai][bj][m][1][j] * ri[ai][m])) << (8 * j); }
                        SIG[((ai * 4 + m) * 2 + bj) * 512 + tid] = (u32x2){q0, q1}; }
        } else {
#pragma unroll
            for (int ai = 0; ai < 2; ++ai)
#pragma unroll
            for (int mp = 0; mp < 2; ++mp) {
                u32x2 sv[2][2]; u32x4 mv[2][2];
#pragma unroll
                for (int mm = 0; mm < 2; ++mm)
#pragma unroll
                    for (int bj = 0; bj < 2; ++bj) { const int slot = ((ai * 4 + 2 * mp + mm) * 2 + bj) * 512 + tid; sv[mm][bj] = SIG[slot]; if (k > 0) mv[mm][bj] = MIXS[slot]; }
#pragma unroll
                for (int mm = 0; mm < 2; ++mm) { const int m = 2 * mp + mm; const size_t row = u.pm * 256 + ai * 128 + wr * 64 + m * 16 + fr;
#pragma unroll
                    for (int bj = 0; bj < 2; ++bj) { const int slot = ((ai * 4 + m) * 2 + bj) * 512 + tid; f32x4 s0, s1;
#pragma unroll
                        for (int j = 0; j < 4; ++j) { s0[j] = (float)((sv[mm][bj].x >> (8 * j)) & 255u) * (1.0f / 255.0f); s1[j] = (float)((sv[mm][bj].y >> (8 * j)) & 255u) * (1.0f / 255.0f); }
                        f32x4 v0 = acc[ai][bj][m][0] * s0, v1 = acc[ai][bj][m][1] * s1;
                        if (k > 0) { f32x4 p0, p1; unpack8(mv[mm][bj], p0, p1); v0 += p0; v1 += p1; }
                        if (k < 2) MIXS[slot] = pack8(v0, v1);
                        else *(u32x4*)(MX + row * D + u.pn * 256 + bj * 128 + wc * 32 + 8 * fq) = pack8(v0, v1); } }
                asm volatile("" ::: "memory"); }
        }
        return false; } };
__device__ __forceinline__ void p3b_mix_pg8(Frame& F, int l) {
    MixSched S{(const char*)(F.ws + WS_XB), (const char*)(F.ws + WS_WINT) + ((size_t)l * IN_COLS + COL_GATES) * D * 2, (const char*)(F.ws + WS_WBRT) + (size_t)l * 3 * D * BW * 2, (const char*)F.ws, F.G, F.wg};
    EpiMix E{(u32x2*)(F.ws + WS_P3BSCR + (size_t)F.wg * 262144), (u32x4*)(F.ws + WS_P3BSCR + (size_t)F.wg * 262144 + 131072), (bf16*)(F.ws + WS_MIXED), (const float*)(F.ws + WS_RINV1)};
    pg8::gemm_phase<EpiMix, MixSched, true, 0>(F.lds, S, E, F.tid);
}
struct Moe1Sched { const char* XB; const char* W13; const int* IDX; const LAS int* tb; int ntile, G, c;
    __device__ __forceinline__ bool next(int i, pg8::Unit& u) const {
        const int L = i * G + c; if (L >= ntile * 4) return false;
        u.pm = L >> 2; u.pn = L & 3; const int bucket = tb[1 + u.pm], g = bucket / 6; int pa, pb; pair_of(bucket % 6, pa, pb);
        u.aux = u.pn >> 1; const int e = g * 4 + (u.aux ? pb : pa);
        u.A = XB; u.lda2 = 2048; u.nt = 16; u.B = W13 + ((size_t)e * 512 + (u.pn & 1) * 256) * 2048; u.ldb2 = 2048; return true; }
    __device__ __forceinline__ unsigned row_off(const pg8::Unit& u, int r) const { int tok = IDX[u.pm * 256 + r]; tok = tok < 0 ? 0 : tok; return (unsigned)tok * 2048u; }
};
struct EpiMoe1 { bf16* HS; const float* WSORT; const float* RSORT;
    __device__ __forceinline__ bool operator()(const AccT& acc, const pg8::Unit& u, int wr, int wc, int fr, int fq) const {
        asm volatile("" : "+v"(fr), "+v"(fq));
        const int slot = u.aux, hcol = slot * 256 + (u.pn & 1) * 128 + wc * 32 + 8 * fq;
#pragma unroll
        for (int ai = 0; ai < 2; ++ai)
#pragma unroll
            for (int m = 0; m < 4; ++m) { const int row = u.pm * 256 + ai * 128 + wr * 64 + m * 16 + fr; const float wsel = WSORT[2 * row + slot], ri = RSORT[row]; f32x4 o[2];
#pragma unroll
                for (int n = 0; n < 2; ++n)
#pragma unroll
                    for (int j = 0; j < 4; ++j) { const float v1 = acc[ai][0][m][n][j] * ri, v3 = acc[ai][1][m][n][j] * ri; o[n][j] = v1 * sigmoidf_(v1) * v3 * wsel; }
                *(u32x4*)(HS + (size_t)row * 512 + hcol) = pack8(o[0], o[1]); }
        return false; } };
__device__ __forceinline__ void p4c_moe1_pg8(Frame& F, int l) {
    LAS int* tb = (LAS int*)(F.lds + TB_OFF);
    const int ntile = build_tile_table(F, tb);
    Moe1Sched S{(const char*)(F.ws + WS_XB), (const char*)(F.ws + WS_W13T) + (size_t)l * 16 * 512 * D * 2, (const int*)(F.ws + WS_IDX), tb, ntile, F.G, F.wg};
    EpiMoe1 E{(bf16*)(F.ws + WS_HS), (const float*)(F.ws + WS_WSORT), (const float*)(F.ws + WS_RSORT)};
    pg8::gemm_phase<EpiMoe1, Moe1Sched, true, 2>(F.lds, S, E, F.tid);
}
struct Moe2Sched { const char* HS; const char* W2; const LAS int* tb; int ntile, G, c;
    __device__ __forceinline__ bool next(int i, pg8::Unit& u) const {
        const int L = i * G + c; if (L >= ntile * 4) return false;
        u.pm = L >> 2; u.pn = L & 3; u.aux = 0; const int bucket = tb[1 + u.pm];
        u.A = HS + (size_t)u.pm * 256 * 1024; u.lda2 = 1024; u.nt = 8; u.B = W2 + ((size_t)bucket * D + u.pn * 256) * 1024; u.ldb2 = 1024; return true; }
    __device__ __forceinline__ unsigned row_off(const pg8::Unit&, int) const { return 0u; }
};
struct EpiMoe2 { float* X; bf16* XB; const int* IDX;
    __device__ __forceinline__ bool operator()(const AccT& acc, const pg8::Unit& u, int wr, int wc, int fr, int fq) const {
        asm volatile("" : "+v"(fr), "+v"(fq));
        int tk[2][4];
#pragma unroll
        for (int ai = 0; ai < 2; ++ai)
#pragma unroll
            for (int m = 0; m < 4; ++m) tk[ai][m] = IDX[u.pm * 256 + ai * 128 + wr * 64 + m * 16 + fr];
#pragma unroll
        for (int ai = 0; ai < 2; ++ai) {
#pragma unroll
            for (int mp = 0; mp < 2; ++mp) {
                f32x4 xv[2][2][2];
#pragma unroll
                for (int mm = 0; mm < 2; ++mm) { const int tok = tk[ai][2 * mp + mm]; const size_t rb = (size_t)(tok < 0 ? 0 : tok) * D + u.pn * 256 + wc * 32 + 8 * fq;
#pragma unroll
                    for (int bj = 0; bj < 2; ++bj) { xv[mm][bj][0] = *(const f32x4*)(X + rb + bj * 128); xv[mm][bj][1] = *(const f32x4*)(X + rb + bj * 128 + 4); } }
#pragma unroll
                for (int mm = 0; mm < 2; ++mm) { const int m = 2 * mp + mm, tok = tk[ai][m];
                    if (tok >= 0) { const size_t rb = (size_t)tok * D + u.pn * 256 + wc * 32 + 8 * fq;
#pragma unroll
                        for (int bj = 0; bj < 2; ++bj) { const f32x4 v0 = xv[mm][bj][0] + acc[ai][bj][m][0], v1 = xv[mm][bj][1] + acc[ai][bj][m][1];
                            *(f32x4*)(X + rb + bj * 128) = v0; *(f32x4*)(X + rb + bj * 128 + 4) = v1; *(u32x4*)(XB + rb + bj * 128) = pack8(v0, v1); } } }
                asm volatile("" ::: "memory"); } }
        return false; } };
__device__ __forceinline__ void p4d_moe2_pg8(Frame& F, int l) {
    LAS int* tb = (LAS int*)(F.lds + TB_OFF);
    const int ntile = build_tile_table(F, tb);
    Moe2Sched S{(const char*)(F.ws + WS_HS), (const char*)(F.ws + WS_W2TB) + (size_t)l * NBUCKET * D * 512 * 2, tb, ntile, F.G, F.wg};
    EpiMoe2 E{F.out, (bf16*)(F.ws + WS_XB), (const int*)(F.ws + WS_IDX)};
    pg8::gemm_phase<EpiMoe2, Moe2Sched, true, 0>(F.lds, S, E, F.tid);
}

__device__ __forceinline__ void p_rowstats(Frame& F) {
    const float* X = F.out; float* rinv = (float*)(F.ws + WS_RINV1);
    for (int m0 = 4 * F.gw; m0 < M; m0 += 4 * F.NGW) {
        f32x4 v[4][4];
#pragma unroll
        for (int a = 0; a < 4; ++a) { const f32x4* xr = (const f32x4*)(X + (size_t)(m0 + a) * D) + F.lane;
#pragma unroll
            for (int j = 0; j < 4; ++j) v[a][j] = xr[64 * j]; }
        float t[4];
#pragma unroll
        for (int a = 0; a < 4; ++a) { float s = 0.f;
#pragma unroll
            for (int j = 0; j < 4; ++j) s += (v[a][j].x * v[a][j].x + v[a][j].y * v[a][j].y) + (v[a][j].z * v[a][j].z + v[a][j].w * v[a][j].w);
            t[a] = wave_sum(s, F.lane); }
        if (F.lane < 4) { const float s = F.lane == 0 ? t[0] : (F.lane == 1 ? t[1] : (F.lane == 2 ? t[2] : t[3])); rinv[m0 + F.lane] = 1.0f / sqrtf(s * (1.0f / D) + NORM_EPS); }
    }
}
__device__ __forceinline__ void p_final_norm(Frame& F) {
    float* X = F.out;
    const f32x4* gp = (const f32x4*)F.in[I_FNG] + F.lane; f32x4 gv[4];
#pragma unroll
    for (int j = 0; j < 4; ++j) gv[j] = gp[64 * j];
    for (int m0 = 4 * F.gw; m0 < M; m0 += 4 * F.NGW) {
        f32x4 v[4][4];
#pragma unroll
        for (int a = 0; a < 4; ++a) { const f32x4* xr = (const f32x4*)(X + (size_t)(m0 + a) * D) + F.lane;
#pragma unroll
            for (int j = 0; j < 4; ++j) v[a][j] = xr[64 * j]; }
#pragma unroll
        for (int a = 0; a < 4; ++a) { float s = 0.f;
#pragma unroll
            for (int j = 0; j < 4; ++j) s += (v[a][j].x * v[a][j].x + v[a][j].y * v[a][j].y) + (v[a][j].z * v[a][j].z + v[a][j].w * v[a][j].w);
            s = wave_sum(s, F.lane); const float ri = 1.0f / sqrtf(s * (1.0f / D) + NORM_EPS);
            f32x4* xw = (f32x4*)(X + (size_t)(m0 + a) * D) + F.lane;
#pragma unroll
            for (int j = 0; j < 4; ++j) xw[64 * j] = v[a][j] * ri * gv[j]; }
    }
}

__device__ __forceinline__ bool fresh(Frame& F) {
    int t = threadIdx.x; asm volatile("" : "+v"(t));
    F.tid = t; F.lane = t & 63; F.wave = __builtin_amdgcn_readfirstlane(t >> 6); F.gw = F.wg * NWAVES + F.wave;
    const __attribute__((address_space(4))) Args* ap = (const __attribute__((address_space(4))) Args*)__builtin_amdgcn_kernarg_segment_ptr();
    asm volatile("" : "+s"(ap));
    F.in = ap->in; F.out = ap->out; F.ws = ap->ws;
    return true;
}
__global__ void __launch_bounds__(NTHREADS, 2) fwd(Args args) {
    extern __shared__ __attribute__((aligned(16))) unsigned char lds[];
    Frame F;
    F.lds = (LAS unsigned char*)lds;
    volatile LAS unsigned* MISC = (volatile LAS unsigned*)(F.lds + MISC_OFF);
    if (threadIdx.x < 32) MISC[threadIdx.x] = 0u;
    __syncthreads();
    F.tid = threadIdx.x; F.lane = F.tid & 63; F.wave = __builtin_amdgcn_readfirstlane(F.tid >> 6);
    F.wg = blockIdx.x; F.gw = F.wg * NWAVES + F.wave;
    F.in = nullptr; F.out = args.out; F.ws = args.ws;
    unsigned* ctl = (unsigned*)(F.ws + WS_CTL);
    XcdBarrier bar; bar.bar = ctl + CW_BAR; bar.x = 0; bar.st = nullptr;
    if (!MK_PER_PHASE) bar = xcd_barrier_post(ctl + CW_BAR, MISC + 8, F.tid == 0);
    const int lo = args.ph_lo, hi = args.ph_hi;
#define IN(k) (lo <= (k) && (k) < hi && fresh(F))
#define SEAM(k) do { if (IN(k) && IN((k) + 1)) xcd_barrier(bar, F.tid == 0); } while (0)

#ifndef DUP_MASK
#define DUP_MASK 0
#endif
#define RUN(k, body) do { int reps_ = 1 + ((DUP_MASK >> (k)) & 1); if (DUP_MASK) asm volatile("" : "+s"(reps_)); for (int rep_ = 0; rep_ < reps_; ++rep_) { body; if (DUP_MASK) __syncthreads(); } } while (0)
    if (IN(0)) { RUN(0, p0_prologue(F)); } SEAM(0);
    for (int l = 0; l < DEPTH; ++l) {
        const int pb = 1 + 10 * l;
        if (IN(pb + 0)) { RUN(1, p1_inproj_pg8(F, l)); } SEAM(pb + 0);
        if (IN(pb + 1)) { RUN(2, lru_mfma(F, l)); RUN(3, s5_mfma(F, l)); RUN(4, attn_mfma(F, l)); } SEAM(pb + 1);
        if (IN(pb + 2)) { RUN(5, p3a_glu_pg8(F, l)); } SEAM(pb + 2);
        if (IN(pb + 3)) { RUN(6, p3b_mix_pg8(F, l)); } SEAM(pb + 3);
        if (IN(pb + 4)) { p3c_outproj_pg8(F, l); } SEAM(pb + 4);
        if (IN(pb + 5)) { RUN(8, p4a_router(F, l)); } SEAM(pb + 5);
        if (IN(pb + 6)) { RUN(9, p4b_positions(F)); } SEAM(pb + 6);
        if (IN(pb + 7)) { RUN(10, p4c_moe1_pg8(F, l)); } SEAM(pb + 7);
        if (IN(pb + 8)) { p4d_moe2_pg8(F, l); } SEAM(pb + 8);
        if (IN(pb + 9)) { if (l == DEPTH - 1) p_final_norm(F); else { RUN(12, p_rowstats(F)); } }
        if (l < DEPTH - 1) SEAM(pb + 9);
    }
#undef IN
#undef SEAM
}

extern "C" void kernel_launch(void* const* d_in, const int* in_sizes, int n_in, void* d_out, int out_size, void* d_ws, size_t ws_size, hipStream_t stream) {
    static int grid = 0;
    if (grid == 0) {
        if (n_in != 32 || out_size != M * D || ws_size < WS_END) { fprintf(stderr, "kernel_launch: unexpected shapes (n_in %d, out %d, ws %zu)\n", n_in, out_size, ws_size); grid = -1; return; }
        if (hipFuncSetAttribute((const void*)fwd, hipFuncAttributeMaxDynamicSharedMemorySize, LDS_BYTES) != hipSuccess) { fprintf(stderr, "kernel_launch: hipFuncSetAttribute failed\n"); grid = -1; return; }
        int per_cu = 0;
        if (hipOccupancyMaxActiveBlocksPerMultiprocessor(&per_cu, (const void*)fwd, NTHREADS, LDS_BYTES) != hipSuccess || per_cu < 1) fprintf(stderr, "kernel_launch: occupancy query reports %d\n", per_cu);
        (void)hipGetLastError();
        grid = 256;
    }
    if (grid < 0) return;
    (void)hipMemsetAsync((char*)d_ws + WS_CTL, 0, CTL_ZERO_BYTES, stream);
    Args a{};
    for (int i = 0; i < 32; ++i) a.in[i] = (const float*)d_in[i];
    a.out = (float*)d_out; a.ws = (unsigned char*)d_ws; a.pad = 0;
#if MK_PER_PHASE
    for (int p = 0; p < NPHASE; ++p) { a.ph_lo = p; a.ph_hi = p + 1; a.li = p; hipLaunchKernelGGL(fwd, dim3(grid), dim3(NTHREADS), LDS_BYTES, stream, a); }
#else
    a.ph_lo = 0; a.ph_hi = NPHASE; a.li = 0;
    hipLaunchKernelGGL(fwd, dim3(grid), dim3(NTHREADS), LDS_BYTES, stream, a);
#endif
}
```
